# Optimizing an MI355X kernel written in HIP

```python
import math
import jax, jax.numpy as jnp
from jax import lax
import numpy as np

D_MODEL = 1024
BATCH = 2
SEQ = 8192
DEPTH = 1

CHUNK = 64
CONV_CH = 512
CONV_HEADS = 8
CONV_WIDTH = 31
SSM_CH = 512
SSM_GROUP_CH = 16
SSM_GROUPS = SSM_CH // SSM_GROUP_CH
SSM_STATE = 64
D_MIX = CONV_CH + SSM_CH
D_IN = 2 * CONV_CH + SSM_CH
N_EXPERTS = 64
TOP_K = 8
N_ROUTE_GROUPS = 8
TOPK_ROUTE_GROUPS = 4
D_EXPERT = 256
ROUTED_SCALE = 2.5
MOE_BLOCK = 128
NORM_EPS = 1e-6

kernel_name = 'hymba_conformer_s5_moe_block'


def rms_norm(x, g):
    xf = x.astype(jnp.float32)
    y = xf * lax.rsqrt(jnp.mean(xf * xf, axis=-1, keepdims=True) + NORM_EPS)
    return (y * g.astype(jnp.float32)).astype(x.dtype)


def swiglu(x, w_gate, w_up, w_down):
    return (jax.nn.silu(x @ w_gate) * (x @ w_up)) @ w_down


def conv_module(v, conv_w, conv_b, ln_g, ln_b):
    y = lax.conv_general_dilated(v, conv_w, window_strides=(1,), padding=[(CONV_WIDTH - 1, 0)],
                                 dimension_numbers=('NWC', 'WIO', 'NWC'),
                                 feature_group_count=CONV_CH) + conv_b
    yf = y.astype(jnp.float32)
    mu = jnp.mean(yf, axis=-1, keepdims=True)
    var = jnp.mean(jnp.square(yf - mu), axis=-1, keepdims=True)
    yn = (yf - mu) * lax.rsqrt(var + NORM_EPS) * ln_g.astype(jnp.float32) + ln_b.astype(jnp.float32)
    return jax.nn.silu(yn).astype(v.dtype)


def _complex_affine_combine(e1, e2):
    a1r, a1i, b1r, b1i = e1
    a2r, a2i, b2r, b2i = e2
    ar = a2r * a1r - a2i * a1i
    ai = a2r * a1i + a2i * a1r
    br = a2r * b1r - a2i * b1i + b2r
    bi = a2r * b1i + a2i * b1r + b2i
    return (ar, ai, br, bi)


def s5_layer(u, a_re, a_im, log_dt, b_re, b_im, c_re, c_im, d_skip, w_glu, b_glu):
    bsz, seq, _ = u.shape
    f32 = jnp.float32
    uf = u.astype(f32).reshape(bsz, seq, SSM_GROUPS, SSM_GROUP_CH)
    ar = a_re.astype(f32)
    ai = a_im.astype(f32)
    dt = jnp.exp(log_dt.astype(f32))[:, None]
    mag = jnp.exp(ar * dt)
    lr = mag * jnp.cos(ai * dt)
    li = mag * jnp.sin(ai * dt)
    den = ar * ar + ai * ai
    nr = lr - 1.0
    kr = (nr * ar + li * ai) / den
    ki = (li * ar - nr * ai) / den
    br_ = b_re.astype(f32)
    bi_ = b_im.astype(f32)
    bbr = kr[..., None] * br_ - ki[..., None] * bi_
    bbi = kr[..., None] * bi_ + ki[..., None] * br_
    bu_r = jnp.einsum('blgh,gph->blgp', uf, bbr)
    bu_i = jnp.einsum('blgh,gph->blgp', uf, bbi)
    lam_r = jnp.broadcast_to(lr, bu_r.shape)
    lam_i = jnp.broadcast_to(li, bu_i.shape)
    _, _, s_r, s_i = lax.associative_scan(_complex_affine_combine, (lam_r, lam_i, bu_r, bu_i), axis=1)
    y = (jnp.einsum('blgp,ghp->blgh', s_r, c_re.astype(f32))
         - jnp.einsum('blgp,ghp->blgh', s_i, c_im.astype(f32))
         + d_skip.astype(f32).reshape(SSM_GROUPS, SSM_GROUP_CH) * uf)
    g = jax.nn.gelu(y.reshape(bsz, seq, SSM_CH))
    out = g * jax.nn.sigmoid(g @ w_glu.astype(f32) + b_glu.astype(f32))
    return out.astype(u.dtype)


def dropless_experts(hf, gate_w, top_idx, we_gate, we_up, we_down):
    n_tok, d = hf.shape
    n_assign = n_tok * TOP_K
    flat_e = top_idx.reshape(-1).astype(jnp.int32)
    flat_t = jnp.repeat(jnp.arange(n_tok, dtype=jnp.int32), TOP_K)
    flat_w = gate_w.reshape(-1).astype(hf.dtype)
    order = jnp.argsort(flat_e)
    sorted_e = flat_e[order]
    counts = jnp.bincount(flat_e, length=N_EXPERTS).astype(jnp.int32)
    padded = (counts + MOE_BLOCK - 1) // MOE_BLOCK * MOE_BLOCK
    starts = jnp.cumsum(counts) - counts
    pends = jnp.cumsum(padded)
    pstarts = pends - padded
    dest = pstarts[sorted_e] + jnp.arange(n_assign, dtype=jnp.int32) - starts[sorted_e]
    n_blocks = (n_assign + N_EXPERTS * (MOE_BLOCK - 1) + MOE_BLOCK - 1) // MOE_BLOCK
    n_rows = n_blocks * MOE_BLOCK
    row_tok = jnp.full((n_rows,), n_tok, jnp.int32).at[dest].set(flat_t[order])
    row_w = jnp.zeros((n_rows,), hf.dtype).at[dest].set(flat_w[order])
    block_e = jnp.minimum(
        jnp.searchsorted(pends, jnp.arange(n_blocks, dtype=jnp.int32) * MOE_BLOCK, side='right'),
        N_EXPERTS - 1).astype(jnp.int32)
    x_pad = jnp.concatenate([hf, jnp.zeros((1, d), hf.dtype)], axis=0)

    def block_fn(args):
        tok, w, e = args
        return swiglu(x_pad[tok], we_gate[e], we_up[e], we_down[e]) * w[:, None]

    ys = lax.map(block_fn, (row_tok.reshape(n_blocks, MOE_BLOCK), row_w.reshape(n_blocks, MOE_BLOCK), block_e))
    out = jnp.zeros((n_tok + 1, d), hf.dtype).at[row_tok].add(ys.reshape(n_rows, d))
    return out[:n_tok]


def moe_ffn(h, w_router, b_router, we_gate, we_up, we_down, ws_gate, ws_up, ws_down):
    bsz, seq, d = h.shape
    n_tok = bsz * seq
    hf = h.reshape(n_tok, d)
    scores = jax.nn.sigmoid(hf.astype(jnp.float32) @ w_router.astype(jnp.float32))
    biased = scores + b_router.astype(jnp.float32)
    grp = biased.reshape(n_tok, N_ROUTE_GROUPS, N_EXPERTS // N_ROUTE_GROUPS)
    grp_score = lax.top_k(grp, 2)[0].sum(-1)
    _, top_grp = lax.top_k(grp_score, TOPK_ROUTE_GROUPS)
    grp_mask = jax.nn.one_hot(top_grp, N_ROUTE_GROUPS, dtype=jnp.float32).sum(1) > 0
    exp_mask = jnp.repeat(grp_mask, N_EXPERTS // N_ROUTE_GROUPS, axis=1)
    _, top_idx = lax.top_k(jnp.where(exp_mask, biased, -jnp.inf), TOP_K)
    sel = jnp.take_along_axis(scores, top_idx, axis=1)
    gate_w = sel / (sel.sum(-1, keepdims=True) + 1e-20) * ROUTED_SCALE
    routed = dropless_experts(hf, gate_w, top_idx, we_gate, we_up, we_down)
    shared = swiglu(hf, ws_gate, ws_up, ws_down)
    return (routed + shared).reshape(bsz, seq, d)


def setup_inputs(seed: int = 0) -> dict:
    key = jax.random.key(seed)
    ks = iter(jax.random.split(key, 40))
    f32 = jnp.float32

    def nrm(shape, scale):
        return jax.random.normal(next(ks), shape, f32) * scale

    def gain(shape):
        return 1.0 + nrm(shape, 0.05)

    L = DEPTH
    G, P, H = SSM_GROUPS, SSM_STATE, SSM_GROUP_CH
    inp = {}
    inp['x'] = nrm((BATCH, SEQ, D_MODEL), 1.0)
    inp['c'] = nrm((BATCH, D_MODEL), 1.0)
    inp['w_ada'] = nrm((L, D_MODEL, 6 * D_MODEL), D_MODEL ** -0.5)
    inp['b_ada'] = nrm((L, 6 * D_MODEL), 0.02)
    inp['g_pre_mix'] = gain((L, D_MODEL))
    inp['g_post_mix'] = gain((L, D_MODEL))
    inp['w_in'] = nrm((L, D_MODEL, D_IN), D_MODEL ** -0.5)
    inp['conv_w'] = nrm((L, CONV_WIDTH, 1, CONV_CH), CONV_WIDTH ** -0.5)
    inp['conv_b'] = nrm((L, CONV_CH), 0.02)
    inp['conv_ln_g'] = gain((L, CONV_CH))
    inp['conv_ln_b'] = nrm((L, CONV_CH), 0.02)
    inp['ssm_a_re'] = -0.5 + nrm((L, G, P), 0.01)
    inp['ssm_a_im'] = jnp.broadcast_to(jnp.pi * jnp.arange(P, dtype=f32), (L, G, P)) + nrm((L, G, P), 0.01)
    inp['ssm_log_dt'] = jax.random.uniform(next(ks), (L, G), f32, minval=math.log(0.001), maxval=math.log(0.1))
    inp['ssm_b_re'] = nrm((L, G, P, H), (2 * H) ** -0.5)
    inp['ssm_b_im'] = nrm((L, G, P, H), (2 * H) ** -0.5)
    inp['ssm_c_re'] = nrm((L, G, H, P), (2 * P) ** -0.5)
    inp['ssm_c_im'] = nrm((L, G, H, P), (2 * P) ** -0.5)
    inp['ssm_d'] = nrm((L, SSM_CH), 1.0)
    inp['ssm_w_glu'] = nrm((L, SSM_CH, SSM_CH), SSM_CH ** -0.5)
    inp['ssm_b_glu'] = nrm((L, SSM_CH), 0.02)
    inp['g_out_conv'] = gain((L, CONV_CH))
    inp['g_out_ssm'] = gain((L, SSM_CH))
    inp['w_out'] = nrm((L, D_MIX, D_MODEL), D_MIX ** -0.5)
    inp['g_pre_ffn'] = gain((L, D_MODEL))
    inp['g_post_ffn'] = gain((L, D_MODEL))
    inp['w_router'] = nrm((L, D_MODEL, N_EXPERTS), D_MODEL ** -0.5)
    inp['b_router'] = nrm((L, N_EXPERTS), 0.01)
    inp['we_gate'] = nrm((L, N_EXPERTS, D_MODEL, D_EXPERT), D_MODEL ** -0.5)
    inp['we_up'] = nrm((L, N_EXPERTS, D_MODEL, D_EXPERT), D_MODEL ** -0.5)
    inp['we_down'] = nrm((L, N_EXPERTS, D_EXPERT, D_MODEL), D_EXPERT ** -0.5)
    inp['ws_gate'] = nrm((L, D_MODEL, D_EXPERT), D_MODEL ** -0.5)
    inp['ws_up'] = nrm((L, D_MODEL, D_EXPERT), D_MODEL ** -0.5)
    inp['ws_down'] = nrm((L, D_EXPERT, D_MODEL), D_EXPERT ** -0.5)
    return inp


def reference(x, c, w_ada, b_ada, g_pre_mix, g_post_mix, w_in, conv_w, conv_b, conv_ln_g, conv_ln_b,
              ssm_a_re, ssm_a_im, ssm_log_dt, ssm_b_re, ssm_b_im, ssm_c_re, ssm_c_im, ssm_d,
              ssm_w_glu, ssm_b_glu, g_out_conv, g_out_ssm, w_out, g_pre_ffn, g_post_ffn,
              w_router, b_router, we_gate, we_up, we_down, ws_gate, ws_up, ws_down):
    for l in range(DEPTH):
        mod = jax.nn.silu(c) @ w_ada[l] + b_ada[l]
        sh_m, sc_m, gt_m, sh_f, sc_f, gt_f = [m[:, None, :] for m in jnp.split(mod, 6, axis=-1)]

        h = rms_norm(x, g_pre_mix[l]) * (1.0 + sc_m) + sh_m
        z = h @ w_in[l]
        z_val = z[..., :CONV_CH]
        z_gate = z[..., CONV_CH:2 * CONV_CH]
        z_ssm = z[..., 2 * CONV_CH:]
        a_out = conv_module(z_val * jax.nn.sigmoid(z_gate), conv_w[l], conv_b[l], conv_ln_g[l], conv_ln_b[l])
        b_out = s5_layer(z_ssm, ssm_a_re[l], ssm_a_im[l], ssm_log_dt[l], ssm_b_re[l], ssm_b_im[l],
                         ssm_c_re[l], ssm_c_im[l], ssm_d[l], ssm_w_glu[l], ssm_b_glu[l])
        mixed = jnp.concatenate([rms_norm(a_out, g_out_conv[l]), rms_norm(b_out, g_out_ssm[l])], axis=-1)
        o = mixed @ w_out[l]
        x = x + gt_m * rms_norm(o, g_post_mix[l])

        h = rms_norm(x, g_pre_ffn[l]) * (1.0 + sc_f) + sh_f
        y = moe_ffn(h, w_router[l], b_router[l], we_gate[l], we_up[l], we_down[l],
                    ws_gate[l], ws_up[l], ws_down[l])
        x = x + gt_f * rms_norm(y, g_post_ffn[l])
    return x
```

```cpp
#include <hip/hip_runtime.h>
#include <cstdio>
#include <cstdint>

#define GAS __attribute__((address_space(1)))
#define LAS __attribute__((address_space(3)))
typedef unsigned short bf16;
typedef unsigned v4u __attribute__((ext_vector_type(4)));
typedef unsigned v2u __attribute__((ext_vector_type(2)));
typedef float f32x4 __attribute__((ext_vector_type(4)));
typedef float f32x2 __attribute__((ext_vector_type(2)));
typedef short bf16x8 __attribute__((ext_vector_type(8)));
typedef int i32x8 __attribute__((ext_vector_type(8)));

constexpr int T = 16384, D = 1024, SEQL = 8192, DIN = 1536, CC = 512, NE = 64, DE = 256;
constexpr float EPS = 1e-6f;
constexpr int NTHREADS = 512, NWAVES = 8;
constexpr int LDS_BYTES = 147456;
constexpr int RING_BYTES = 131072, MISC_OFF = LDS_BYTES - 512;

constexpr size_t MiB = 1u << 20;
constexpr size_t WS_CTL = 0, CTL_ZERO_BYTES = 1 * MiB;
constexpr size_t WS_MOD = 1 * MiB;
constexpr size_t WS_LAM = WS_MOD + 64 * 1024;
constexpr size_t WS_LAM32 = WS_MOD + 80 * 1024;
constexpr size_t WS_BB = WS_MOD + 96 * 1024;
constexpr size_t WS_CT = WS_MOD + 224 * 1024;
constexpr size_t WS_WD_T = 2 * MiB;
constexpr size_t WS_LISTS = 35 * MiB;
constexpr size_t WS_ABUF = 41 * MiB;
constexpr size_t WS_ACT = 73 * MiB;
constexpr size_t WS_WGU_T = 153 * MiB;
constexpr size_t WS_W_IN_T = 218 * MiB;
constexpr size_t WS_W_OUT_T = 221 * MiB;
constexpr size_t WS_W_GLU_T = 223 * MiB;
constexpr size_t WS_W_RT_T = 223 * MiB + 512 * 1024;
constexpr size_t WS_H8 = 190 * MiB;
constexpr size_t WS_E = 224 * MiB;
constexpr size_t WS_SINIT = 232 * MiB;
constexpr size_t WS_BBUF = 240 * MiB;
constexpr size_t WS_END = 281 * MiB;
constexpr size_t WS_NAIVE = 2 * MiB;

constexpr int CW_BAR = 4096;
constexpr int PROBE_K = -1;
constexpr int PROBE_FLAGS = 0;
#define RUN(k) (p.ph_lo <= (k) && (k) < p.ph_hi)
constexpr int CW_CNT = 16384, CNT_STRIDE = 64;
constexpr size_t WS_LIST = WS_LISTS;
constexpr size_t WS_TOPIDX = WS_LISTS + 4 * MiB;
constexpr size_t WS_GATEW = WS_LISTS + 4 * MiB + 512 * 1024;

__device__ __forceinline__ float sigmoidf_(float x) { return 1.0f / (1.0f + __expf(-x)); }
__device__ __forceinline__ float siluf_(float x) { return x * sigmoidf_(x); }
__device__ __forceinline__ float gelu_tanh(float x) {
    const float u = 0.7978845608028654f * (x + 0.044715f * x * x * x);
    return x * __builtin_amdgcn_rcpf(1.0f + __expf(-2.0f * u));
}
__device__ __forceinline__ unsigned pk2(float lo, float hi) { unsigned r; asm("v_cvt_pk_bf16_f32 %0, %1, %2" : "=v"(r) : "v"(lo), "v"(hi)); return r; }
__device__ __forceinline__ unsigned f2bf(float f) { return pk2(f, f) & 0xffffu; }
__device__ __forceinline__ float bf2f(unsigned short b) { return __builtin_bit_cast(float, ((unsigned)b) << 16); }
__device__ __forceinline__ float bflo(unsigned w) { return __builtin_bit_cast(float, w << 16); }
__device__ __forceinline__ float bfhi(unsigned w) { return __builtin_bit_cast(float, w & 0xffff0000u); }
#define LDS_WAIT() asm volatile("s_waitcnt lgkmcnt(0)" ::: "memory")
#define VM_WAIT() asm volatile("s_waitcnt vmcnt(0)" ::: "memory")

__device__ __forceinline__ float wave_sum(float v) {
#pragma unroll
    for (int o = 1; o < 64; o <<= 1) v += __shfl_xor(v, o);
    return v;
}
__device__ __forceinline__ float block_sum(float v, float* red) {
    v = wave_sum(v);
    const int w = threadIdx.x >> 6, nw = blockDim.x >> 6;
    __syncthreads();
    if ((threadIdx.x & 63) == 0) red[w] = v;
    __syncthreads();
    float s = 0.f;
    for (int i = 0; i < nw; ++i) s += red[i];
    return s;
}

#define XB_TMO      128
#define XB_XCNT(j)  (256  + 64 * (j))
#define XB_XSUB(j)  (1280 + 64 * (j))
#define XB_XGEN(j)  (2304 + 64 * (j))
#define XB_TOP      3328
#define XB_TOPGEN   3392
#define XCD_BAR_WORDS 3456
#define XB_SPIN_CAP (1u << 18)
__device__ __forceinline__ unsigned xb_ld(unsigned* p)              { return __hip_atomic_load(p, __ATOMIC_RELAXED, __HIP_MEMORY_SCOPE_AGENT); }
__device__ __forceinline__ unsigned xb_add(unsigned* p, unsigned v) { return __hip_atomic_fetch_add(p, v, __ATOMIC_RELAXED, __HIP_MEMORY_SCOPE_AGENT); }
__device__ __forceinline__ unsigned xb_xcc_id() { return (unsigned)__builtin_amdgcn_s_getreg((3 << 11) | 20) & 0xFu; }
#define XB_SPIN(cond, bar) do { unsigned _sp = 0; while (cond) { __builtin_amdgcn_s_sleep(1); \
    if ((++_sp & 255u) == 0u) { if (xb_ld(&(bar)[XB_TMO])) break; if (_sp > XB_SPIN_CAP) { atomicAdd(&(bar)[XB_TMO], 1u); break; } } } } while (0)
struct XcdBarrier { unsigned* bar; unsigned x; volatile LAS unsigned* st; };
__device__ __forceinline__ XcdBarrier xcd_barrier_post(unsigned* bar, volatile LAS unsigned* st) {
    XcdBarrier b; b.bar = bar; b.x = xb_xcc_id(); b.st = st;
    if (threadIdx.x == 0) (void)xb_add(&bar[XB_XCNT(b.x)], 1u);
    return b;
}
__device__ __forceinline__ void xcd_barrier_complete(unsigned* bar, unsigned x, unsigned& nloc, unsigned& nx) {
    const unsigned G = gridDim.x * gridDim.y * gridDim.z;
    unsigned sum, cnt, mine, sp = 0u;
    for (;;) {
        sum = 0u; cnt = 0u; mine = 0u;
#pragma unroll
        for (unsigned j = 0; j < 16; ++j) { const unsigned c = xb_ld(&bar[XB_XCNT(j)]); sum += c; cnt += (c > 0u) ? 1u : 0u; mine = (j == x) ? c : mine; }
        if (sum == G) break;
        __builtin_amdgcn_s_sleep(1);
        if ((++sp & 255u) == 0u) { if (xb_ld(&bar[XB_TMO])) break; if (sp > XB_SPIN_CAP) { atomicAdd(&bar[XB_TMO], 1u); break; } }
    }
    nloc = mine > 0u ? mine : 1u; nx = cnt > 0u ? cnt : 1u;
}
__device__ __forceinline__ void xcd_barrier(const XcdBarrier& b) {
    asm volatile("s_waitcnt vmcnt(0)" ::: "memory");
    __syncthreads();
    if (threadIdx.x == 0) {
        unsigned* bar = b.bar;
        __builtin_amdgcn_s_waitcnt(0);
        unsigned nloc = b.st[0], nx = b.st[1];
        if (nloc == 0u) { xcd_barrier_complete(bar, b.x, nloc, nx); b.st[0] = nloc; b.st[1] = nx; }
        const unsigned old = xb_add(&bar[XB_XSUB(b.x)], 1u);
        const unsigned gen = old / nloc;
        if (old + 1u == (gen + 1u) * nloc) {
            __builtin_amdgcn_fence(__ATOMIC_RELEASE, "agent");
            asm volatile("s_waitcnt vmcnt(0)" ::: "memory");
            const unsigned og = xb_add(&bar[XB_TOP], 1u);
            const unsigned tg = og / nx;
            if (og + 1u == (tg + 1u) * nx) xb_add(&bar[XB_TOPGEN], 1u);
            else XB_SPIN(xb_ld(&bar[XB_TOPGEN]) == tg, bar);
            __builtin_amdgcn_fence(__ATOMIC_ACQUIRE, "agent");
            xb_add(&bar[XB_XGEN(b.x)], 1u);
            asm volatile("s_waitcnt vmcnt(0)" ::: "memory");
        } else {
            XB_SPIN(xb_ld(&bar[XB_XGEN(b.x)]) == gen, bar);
            __builtin_amdgcn_fence(__ATOMIC_ACQUIRE, "agent");
            asm volatile("s_waitcnt vmcnt(0)" ::: "memory");
        }
    }
    __syncthreads();
}

namespace pg8 {
#define PG8_LAS __attribute__((address_space(3)))
constexpr int BM = 256, BK = 64, HALF = 128, HTB = HALF * BK * 2, STAGE_BYTES = 8 * HTB, NXCD = 8, WGM = 8;
__host__ __device__ __forceinline__ int lds_byte(int r, int c) { const int st = (r >> 4) * 2 + (c >> 5), rr = r & 15, cc = c & 31, ob = rr * 64 + cc * 2; return st * 1024 + (ob ^ (((ob >> 9) & 1) << 5)); }
__host__ __device__ __forceinline__ void stage_rc(int b, int& R, int& C) { const int st = b / 1024, sb = b % 1024, swz = sb ^ (((sb >> 9) & 1) << 5); R = (st >> 1) * 16 + swz / 64; C = (st & 1) * 32 + (swz % 64) / 2; }
__host__ __device__ __forceinline__ int perm32(int rho) { const int n = rho >> 4, i = rho & 15; return 8 * (i >> 2) + 4 * n + (i & 3); }

struct Unit { const char* A; const char* B; int pm, pn, e, nvalid, slot; };

struct StaticOrder {
    const char* A; const char* B; int K;
    int nM, nN, nwg, G, c;
    __device__ void init(const void* A_, const void* B_, int M, int N, int K_, int G_, int c_) { A = (const char*)A_; B = (const char*)B_; K = K_; nM = M / BM; nN = N / BM; nwg = nM * nN; G = G_; c = c_; }
    __device__ bool next(int i, Unit& u) const {
        const long L = (long)i * G + c; if (L >= nwg) return false;
        int wgid = (int)L; { const int q = nwg / NXCD, r = nwg % NXCD, xcd = wgid % NXCD, off = wgid / NXCD; wgid = (xcd < r ? xcd * (q + 1) : r * (q + 1) + (xcd - r) * q) + off; }
        const int nig = WGM * nN, gid = wgid / nig, fm = gid * WGM, gsz = (nM - fm) < WGM ? (nM - fm) : WGM;
        u.pm = fm + ((wgid % nig) % gsz); u.pn = (wgid % nig) / gsz; u.e = 0; u.nvalid = BM; u.slot = 0;
        u.A = A + (size_t)u.pm * BM * K * 2; u.B = B + (size_t)u.pn * BM * K * 2; return true;
    }
    __device__ const PG8_LAS int* rowsA(int) const { return nullptr; }
};

__device__ __forceinline__ unsigned cvt_pk_bf16(float lo, float hi) { unsigned r; asm volatile("v_cvt_pk_bf16_f32 %0, %1, %2" : "=v"(r) : "v"(lo), "v"(hi)); return r; }

__device__ __forceinline__ f32x4 mma_bf16(v4u b, v4u a, f32x4 c) { return __builtin_amdgcn_mfma_f32_16x16x32_bf16(__builtin_bit_cast(bf16x8, b), __builtin_bit_cast(bf16x8, a), c, 0, 0, 0); }
__device__ __forceinline__ f32x4 mma_fp8(i32x8 B, i32x8 A, f32x4 c) {
    return __builtin_amdgcn_mfma_scale_f32_16x16x128_f8f6f4(B, A, c, 0, 0, 0, 0x7f7f7f7f, 0, 0x7f7f7f7f);
}
typedef int i32x4 __attribute__((ext_vector_type(4)));
template <class Epi, class Sched, bool ALIGN_EPI, bool GATHER = false, int ESZ = 2>
__device__ __forceinline__ void gemm_phase(PG8_LAS unsigned char* lds, const int K, const Sched& S, const Epi& E) {
    const int tid = threadIdx.x, wid = __builtin_amdgcn_readfirstlane(tid >> 6), lane = tid & 63, wr = wid >> 2, wc = wid & 3, fr = lane & 15, fq = lane >> 4;
    const int rb = K * ESZ; int nt = rb / (BK * 2);
    asm volatile("" : "+s"(nt));
    unsigned voffB[2]; int RA[2], CA[2];
#pragma unroll
    for (int i = 0; i < 2; ++i) { int R, C; stage_rc(tid * 16 + i * 8192, R, C); const int Rb = Epi::PERM ? ((R & ~31) + perm32(R & 31)) : R;
        RA[i] = R; CA[i] = C; voffB[i] = (unsigned)(Rb * rb + C * 2); }
    unsigned cvA0[2], cvA1[2];
#define PG8_SETVA(v0, v1, ui_) do { _Pragma("unroll") for (int _i = 0; _i < 2; ++_i) { \
        v0[_i] = (unsigned)(RA[_i] * rb + CA[_i] * 2); v1[_i] = (unsigned)((HALF + RA[_i]) * rb + CA[_i] * 2); } } while (0)
#define PG8_GVA(v, ui_, h_) do { int _t = threadIdx.x; asm volatile("" : "+v"(_t)); const PG8_LAS int* _rows = S.rowsA(ui_); _Pragma("unroll") for (int _i = 0; _i < 2; ++_i) { int _R, _C; stage_rc(_t * 16 + _i * 8192, _R, _C); \
        v[_i] = (unsigned)(_rows[(h_) * HALF + _R] * rb + _C * 2); } } while (0)
    const size_t kstep = (size_t)(BK * 2);
    const size_t hstep = (size_t)HALF * rb;
    const unsigned ldsw = (unsigned)wid * 1024u;
    const int aoff0 = lds_byte(wr * 64 + fr, ESZ == 2 ? fq * 8 : fq * 16), boff0 = lds_byte(wc * 32 + fr, ESZ == 2 ? fq * 8 : fq * 16);
    constexpr int CH1 = ESZ == 2 ? 1024 : 16;
#define PG8_SA(b, h) (((b) * 2 + (h)) * HTB)
#define PG8_SB(b, h) ((4 + (b) * 2 + (h)) * HTB)
#define PG8_STAGE(bufoff, gbase, voff) do { const char* _g = (const char*)(gbase); asm volatile("" : "+s"(_g));     \
        _Pragma("unroll") for (int _i = 0; _i < 2; ++_i) { unsigned _vo = (voff)[_i]; asm volatile("" : "+v"(_vo)); \
        __builtin_amdgcn_global_load_lds((const unsigned*)(_g + _vo), (PG8_LAS unsigned*)(lds + (bufoff) + ldsw + _i * 8192), 16, 0, 0); } } while (0)
#define PG8_LDF(lo_, hi_) __builtin_shufflevector(__builtin_bit_cast(i32x4, *(const PG8_LAS v4u*)(lo_)), __builtin_bit_cast(i32x4, *(const PG8_LAS v4u*)(hi_)), 0, 1, 2, 3, 4, 5, 6, 7)
#define PG8_LDA(dst, b, h) do { _Pragma("unroll") for (int m = 0; m < 4; ++m) dst[m] = PG8_LDF(lds + PG8_SA(b, h) + aoff0 + m * 2048, lds + PG8_SA(b, h) + aoff0 + m * 2048 + CH1); } while (0)
#define PG8_LDB(dst, b, h) do { _Pragma("unroll") for (int n = 0; n < 2; ++n) dst[n] = PG8_LDF(lds + PG8_SB(b, h) + boff0 + n * 2048, lds + PG8_SB(b, h) + boff0 + n * 2048 + CH1); } while (0)
#define PG8_LO(x) __builtin_bit_cast(v4u, __builtin_shufflevector(x, x, 0, 1, 2, 3))
#define PG8_HI(x) __builtin_bit_cast(v4u, __builtin_shufflevector(x, x, 4, 5, 6, 7))
#define PG8_MMA(ai, bj, At, Bt) do { __builtin_amdgcn_s_setprio(1); _Pragma("unroll") for (int m = 0; m < 4; ++m) _Pragma("unroll") for (int n = 0; n < 2; ++n) { \
        if constexpr (ESZ == 2) { acc[ai][bj][m][n] = mma_bf16(PG8_LO(Bt[n]), PG8_LO(At[m]), acc[ai][bj][m][n]); acc[ai][bj][m][n] = mma_bf16(PG8_HI(Bt[n]), PG8_HI(At[m]), acc[ai][bj][m][n]); } \
        else acc[ai][bj][m][n] = mma_fp8(Bt[n], At[m], acc[ai][bj][m][n]); } __builtin_amdgcn_s_setprio(0); } while (0)
#define PG8_WAIT_V(n) asm volatile("s_waitcnt vmcnt(" #n ")" ::: "memory")
#define PG8_WAIT_L(n) asm volatile("s_waitcnt lgkmcnt(" #n ")" ::: "memory")
#define PG8_BAR __builtin_amdgcn_s_barrier()
#define PG8_SCHED __builtin_amdgcn_sched_barrier(0)
    Unit cur, nxt; int ui = 0;
    if (!S.next(0, cur)) return;
    f32x4 acc[2][2][4][2];
#pragma unroll
    for (int a = 0; a < 2; ++a)
#pragma unroll
        for (int b = 0; b < 2; ++b)
#pragma unroll
            for (int m = 0; m < 4; ++m)
#pragma unroll
                for (int n = 0; n < 2; ++n) acc[a][b][m][n] = (f32x4){0.f, 0.f, 0.f, 0.f};
    i32x8 At[4], B0[2], B1[2];
    const char* cA = cur.A; const char* cB = cur.B;
    if constexpr (!GATHER) PG8_SETVA(cvA0, cvA1, 0);
#define PG8_STAGE_A(bufoff, gbase, h_, ui_) do { if constexpr (GATHER) { unsigned _v[2]; PG8_GVA(_v, ui_, h_); PG8_STAGE(bufoff, gbase, _v); } else { if ((h_) == 0) PG8_STAGE(bufoff, gbase, cvA0); else PG8_STAGE(bufoff, gbase, cvA1); } } while (0)
    PG8_STAGE(PG8_SB(0, 0), cB, voffB); PG8_STAGE(PG8_SB(0, 1), cB + hstep, voffB); PG8_STAGE_A(PG8_SA(0, 0), cA, 0, 0); PG8_STAGE_A(PG8_SA(0, 1), cA, 1, 0);
    if (wr == 1) PG8_BAR;
    PG8_WAIT_V(2); PG8_BAR;
    PG8_STAGE(PG8_SB(1, 0), cB + kstep, voffB); PG8_STAGE_A(PG8_SA(1, 0), cA + kstep, 0, 0); PG8_STAGE(PG8_SB(1, 1), cB + hstep + kstep, voffB);
    PG8_WAIT_V(6); PG8_BAR;
    for (;;) {
        const bool has_next = S.next(ui + 1, nxt);
        const char* nA = has_next ? nxt.A : cA; const char* nB = has_next ? nxt.B : cB;
#pragma unroll 1
        for (int t = 0; t < nt; t += 2) {
            const bool last = (t == nt - 2);
            const char* a1 = cA + (size_t)(t + 1) * kstep;
            const char* a2 = last ? nA : cA + (size_t)(t + 2) * kstep; const char* b2 = last ? nB : cB + (size_t)(t + 2) * kstep;
            const char* a3 = a2 + kstep; const char* b3 = b2 + kstep;
            const int un = (last && has_next) ? ui + 1 : ui;
            PG8_LDB(B0, 0, 0); PG8_LDB(B1, 0, 1); PG8_SCHED; PG8_LDA(At, 0, 0); PG8_STAGE_A(PG8_SA(1, 1), a1, 1, ui);
            PG8_WAIT_V(8); PG8_WAIT_L(0); PG8_BAR; PG8_MMA(0, 0, At, B0); PG8_MMA(0, 1, At, B1); PG8_BAR; PG8_SCHED;
            PG8_LDA(At, 0, 1); PG8_STAGE(PG8_SB(0, 0), b2, voffB); PG8_STAGE(PG8_SB(0, 1), b2 + hstep, voffB); PG8_STAGE_A(PG8_SA(0, 0), a2, 0, un);
            PG8_WAIT_V(8); PG8_WAIT_L(0); PG8_BAR; PG8_MMA(1, 0, At, B0); PG8_MMA(1, 1, At, B1); PG8_BAR; PG8_SCHED;
            PG8_LDB(B0, 1, 0); PG8_LDB(B1, 1, 1); PG8_SCHED; PG8_LDA(At, 1, 0); PG8_STAGE_A(PG8_SA(0, 1), a2, 1, un);
            PG8_WAIT_V(8); PG8_WAIT_L(0); PG8_BAR; PG8_MMA(0, 0, At, B0); PG8_MMA(0, 1, At, B1); PG8_BAR; PG8_SCHED;
            PG8_LDA(At, 1, 1); PG8_STAGE(PG8_SB(1, 0), b3, voffB); PG8_STAGE(PG8_SB(1, 1), b3 + hstep, voffB); PG8_STAGE_A(PG8_SA(1, 0), a3, 0, un);
            PG8_WAIT_V(8); PG8_WAIT_L(0); PG8_BAR; PG8_MMA(1, 0, At, B0); PG8_MMA(1, 1, At, B1); PG8_BAR; PG8_SCHED;
        }
        if constexpr (ALIGN_EPI) { if (wr == 0) PG8_BAR; }
        PG8_SCHED; asm volatile("s_nop 15\n\ts_nop 15"); PG8_SCHED;
        E(acc, cur, wr, wc, fr, fq);
        if (!has_next) break;
#pragma unroll
        for (int a = 0; a < 2; ++a)
#pragma unroll
            for (int b = 0; b < 2; ++b)
#pragma unroll
                for (int m = 0; m < 4; ++m)
#pragma unroll
                    for (int n = 0; n < 2; ++n) acc[a][b][m][n] = (f32x4){0.f, 0.f, 0.f, 0.f};
        cur = nxt; cA = nA; cB = nB; ++ui;
        if constexpr (ALIGN_EPI) { if (wr == 1) PG8_BAR; }
    }
    PG8_WAIT_V(0);
    if constexpr (!ALIGN_EPI) { if (wr == 0) PG8_BAR; }
    PG8_BAR;
#undef PG8_SETVA
#undef PG8_GVA
#undef PG8_STAGE_A
#undef PG8_SA
#undef PG8_SB
#undef PG8_STAGE
#undef PG8_LDA
#undef PG8_LDF
#undef PG8_LO
#undef PG8_HI
#undef PG8_LDB
#undef PG8_MMA
#undef PG8_WAIT_V
#undef PG8_WAIT_L
#undef PG8_BAR
#undef PG8_SCHED
}

struct EpiVU {
    static constexpr bool PERM = true;
    bf16* vu;
    __device__ __forceinline__ void operator()(const f32x4 (&acc)[2][2][4][2], const Unit& u, int wr, int wc, int fr, int fq) const {
        const int row0 = u.pm * BM + wr * 64 + fr, cw = wc * 32 + 8 * fq;
#pragma unroll
        for (int ai = 0; ai < 2; ++ai)
#pragma unroll
            for (int m = 0; m < 4; ++m) { bf16* rowp = vu + (size_t)(row0 + ai * HALF + m * 16) * D;
                if (u.pn < 4) {
                    f32x4 a0 = acc[ai][0][m][0], a1 = acc[ai][0][m][1]; const f32x4 g0 = acc[ai][1][m][0], g1 = acc[ai][1][m][1];
#pragma unroll
                    for (int j = 0; j < 4; ++j) { a0[j] *= sigmoidf_(g0[j]); a1[j] *= sigmoidf_(g1[j]); }
                    v4u w; w.x = cvt_pk_bf16(a0[0], a0[1]); w.y = cvt_pk_bf16(a0[2], a0[3]); w.z = cvt_pk_bf16(a1[0], a1[1]); w.w = cvt_pk_bf16(a1[2], a1[3]);
                    *(v4u*)(rowp + u.pn * 128 + cw) = w;
                } else {
#pragma unroll
                    for (int bj = 0; bj < 2; ++bj) { const f32x4 v0 = acc[ai][bj][m][0], v1 = acc[ai][bj][m][1];
                        v4u w; w.x = cvt_pk_bf16(v0[0], v0[1]); w.y = cvt_pk_bf16(v0[2], v0[3]); w.z = cvt_pk_bf16(v1[0], v1[1]); w.w = cvt_pk_bf16(v1[2], v1[3]);
                        *(v4u*)(rowp + 512 + (u.pn - 4) * 256 + bj * HALF + cw) = w; }
                }
            }
    }
};
struct EpiBf16Plain {
    static constexpr bool PERM = true;
    bf16* O; int ldc;
    __device__ __forceinline__ void operator()(const f32x4 (&acc)[2][2][4][2], const Unit& u, int wr, int wc, int fr, int fq) const {
        const int row0 = u.pm * BM + wr * 64 + fr, col0 = u.pn * BM + wc * 32 + 8 * fq;
#pragma unroll
        for (int ai = 0; ai < 2; ++ai)
#pragma unroll
            for (int m = 0; m < 4; ++m) { bf16* rowp = O + (size_t)(row0 + ai * HALF + m * 16) * ldc + col0;
#pragma unroll
                for (int bj = 0; bj < 2; ++bj) { const f32x4 v0 = acc[ai][bj][m][0], v1 = acc[ai][bj][m][1];
                    v4u w; w.x = cvt_pk_bf16(v0[0], v0[1]); w.y = cvt_pk_bf16(v0[2], v0[3]); w.z = cvt_pk_bf16(v1[0], v1[1]); w.w = cvt_pk_bf16(v1[2], v1[3]);
                    *(v4u*)(rowp + bj * HALF) = w; } }
    }
};

constexpr int MOE_TP_OFF = 131072, MOE_DESC_OFF = 131072 + 512, MOE_ROWS_OFF = 131072 + 1024, MOE_MAX_UNITS = 6, MOE_W_OFF = MOE_ROWS_OFF + MOE_MAX_UNITS * 1024;
struct MoeSched {
    const char* Abase; const char* Bbase; PG8_LAS unsigned char* lds; int nlocal, K, mode, esz;
    __device__ bool next(int i, Unit& u) const {
        if (i >= nlocal) return false;
        const int it = mode == 0 ? i : (i >> 1);
        const PG8_LAS int* d = (const PG8_LAS int*)(lds + MOE_DESC_OFF) + it * 8;
        u.e = __builtin_amdgcn_readfirstlane(d[0]); u.pm = __builtin_amdgcn_readfirstlane(d[1]); u.pn = __builtin_amdgcn_readfirstlane(d[2]); u.nvalid = __builtin_amdgcn_readfirstlane(d[3]); u.slot = it;
        if (mode == 0) { u.A = Abase; u.B = Bbase + ((size_t)u.e * 512 + (size_t)u.pn * 256) * 1024 * esz; }
        else { u.pn = 2 * u.pn + (i & 1); u.A = Abase + (size_t)u.pm * 256 * 256 * esz; u.B = Bbase + ((size_t)u.e * 1024 + (size_t)u.pn * 256) * 256 * esz; }
        return true;
    }
    __device__ const PG8_LAS int* rowsA(int i) const { return (const PG8_LAS int*)(lds + MOE_ROWS_OFF) + i * 256; }
};
struct EpiAct {
    static constexpr bool PERM = true;
    unsigned char* act8; float isc;
    __device__ __forceinline__ void operator()(const f32x4 (&acc)[2][2][4][2], const Unit& u, int wr, int wc, int fr, int fq) const {
        const size_t row0 = (size_t)u.pm * BM + wr * 64 + fr; const int col0 = u.pn * 128 + wc * 32 + 8 * fq;
#pragma unroll
        for (int ai = 0; ai < 2; ++ai)
#pragma unroll
            for (int m = 0; m < 4; ++m) {
                float a[8];
#pragma unroll
                for (int j = 0; j < 8; ++j) { const float g = acc[ai][0][m][j >> 2][j & 3] * isc, uu = acc[ai][1][m][j >> 2][j & 3] * (8.0f * isc);
                    a[j] = g * __builtin_amdgcn_rcpf(1.0f + __expf(-g)) * uu; }
                int lo = __builtin_amdgcn_cvt_pk_fp8_f32(a[0], a[1], 0, false); lo = __builtin_amdgcn_cvt_pk_fp8_f32(a[2], a[3], lo, true);
                int hi = __builtin_amdgcn_cvt_pk_fp8_f32(a[4], a[5], 0, false); hi = __builtin_amdgcn_cvt_pk_fp8_f32(a[6], a[7], hi, true);
                *(v2u*)(act8 + (row0 + ai * HALF + m * 16) * 256 + col0) = (v2u){(unsigned)lo, (unsigned)hi};
                asm volatile("" ::: "memory");
            }
    }
};
struct EpiDown {
    static constexpr bool PERM = true;
    unsigned char* yk8; bf16* ycomb; PG8_LAS unsigned char* lds;
    __device__ __forceinline__ void operator()(const f32x4 (&acc)[2][2][4][2], const Unit& u, int wr_, int wc_, int fr_, int fq_) const {
        int t_ = threadIdx.x; asm volatile("" : "+v"(t_));
        const int fr = t_ & 15, fq = (t_ >> 4) & 3, wc = (t_ >> 6) & 3, wr = t_ >> 8;
        const PG8_LAS int* rows = (const PG8_LAS int*)(lds + MOE_ROWS_OFF) + u.slot * 256;
        const PG8_LAS float* wts = (const PG8_LAS float*)(lds + MOE_W_OFF) + u.slot * 256;
        const int col = u.pn * 256 + wc * 32 + 8 * fq;
#pragma unroll
        for (int ai = 0; ai < 2; ++ai)
#pragma unroll
            for (int m = 0; m < 4; ++m) {
                const int id = rows[ai * HALF + wr * 64 + m * 16 + fr];
                if (id >= 0) {
                    if (u.e < 64) {
                        const float w = wts[ai * HALF + wr * 64 + m * 16 + fr] * (16.0f / 128.0f);
                        unsigned char* dst = yk8 + ((unsigned)id * 1024u + (unsigned)col);
#pragma unroll
                        for (int bj = 0; bj < 2; ++bj) { const f32x4 v0 = acc[ai][bj][m][0] * w, v1 = acc[ai][bj][m][1] * w;
                            int lo = __builtin_amdgcn_cvt_pk_fp8_f32(v0[0], v0[1], 0, false); lo = __builtin_amdgcn_cvt_pk_fp8_f32(v0[2], v0[3], lo, true);
                            int hi = __builtin_amdgcn_cvt_pk_fp8_f32(v1[0], v1[1], 0, false); hi = __builtin_amdgcn_cvt_pk_fp8_f32(v1[2], v1[3], hi, true);
                            *(v2u*)(dst + bj * HALF) = (v2u){(unsigned)lo, (unsigned)hi}; }
                    } else {
                        bf16* dst = ycomb + ((unsigned)id * 1024u + (unsigned)col);
#pragma unroll
                        for (int bj = 0; bj < 2; ++bj) { const f32x4 v0 = acc[ai][bj][m][0] * (1.0f / 128.0f), v1 = acc[ai][bj][m][1] * (1.0f / 128.0f);
                            v4u o; o.x = cvt_pk_bf16(v0[0], v0[1]); o.y = cvt_pk_bf16(v0[2], v0[3]); o.z = cvt_pk_bf16(v1[0], v1[1]); o.w = cvt_pk_bf16(v1[2], v1[3]);
                            *(v4u*)(dst + bj * HALF) = o; }
                    }
                }
            }
    }
};
}

struct Params {
    const float* in[34];
    float* out;
    unsigned char* ws;
    int ph_lo, ph_hi, li, flags;
};

__device__ __forceinline__ void transpose_item(const float* W, int ldw, bf16* WT, int ldt, LAS float* scr, int lane) {
#pragma unroll 8
    for (int i = 0; i < 32; ++i) { const int kk = 2 * i + (lane >> 5); scr[kk * 33 + (lane & 31)] = W[(size_t)kk * ldw + (lane & 31)]; }
    LDS_WAIT(); asm volatile("" ::: "memory");
    const int c = lane & 7;
#pragma unroll
    for (int j = 0; j < 4; ++j) { const int n = (lane >> 3) + 8 * j; const LAS float* s = scr + (8 * c) * 33 + n;
        v4u o; o.x = pk2(s[0 * 33], s[1 * 33]); o.y = pk2(s[2 * 33], s[3 * 33]); o.z = pk2(s[4 * 33], s[5 * 33]); o.w = pk2(s[6 * 33], s[7 * 33]);
        *(GAS v4u*)(WT + (size_t)n * ldt + 8 * c) = o; }
    LDS_WAIT(); asm volatile("" ::: "memory");
}

__device__ __forceinline__ void transpose_item_glu(const float* W, int k0, int n0, bf16* WF, LAS float* scr, int lane) {
#pragma unroll 8
    for (int i = 0; i < 32; ++i) { const int kk = 2 * i + (lane >> 5); scr[kk * 33 + (lane & 31)] = W[(size_t)(k0 + kk) * CC + n0 + (lane & 31)]; }
    LDS_WAIT(); asm volatile("" ::: "memory");
    const int c = lane & 7;
#pragma unroll
    for (int j = 0; j < 4; ++j) { const int nl = (lane >> 3) + 8 * j; const LAS float* s = scr + (8 * c) * 33 + nl;
        v4u o; o.x = pk2(s[0 * 33], s[1 * 33]); o.y = pk2(s[2 * 33], s[3 * 33]); o.z = pk2(s[4 * 33], s[5 * 33]); o.w = pk2(s[6 * 33], s[7 * 33]);
        const int n = n0 + nl, k = k0 + 8 * c;
        const int blk = (((n >> 6) * 16 + (k >> 5)) * 4 + ((n >> 4) & 3)), ln = ((k >> 3) & 3) * 16 + (n & 15);
        *(GAS v4u*)(WF + (size_t)blk * 512 + ln * 8) = o; }
    LDS_WAIT(); asm volatile("" ::: "memory");
}

__device__ __forceinline__ void transpose_item8(const float* W, int ldw, unsigned char* WT8, int ldt, float sc, LAS float* scr, int lane) {
#pragma unroll 8
    for (int i = 0; i < 32; ++i) { const int kk = 2 * i + (lane >> 5); scr[kk * 33 + (lane & 31)] = W[(size_t)kk * ldw + (lane & 31)]; }
    LDS_WAIT(); asm volatile("" ::: "memory");
    const int n = lane >> 1, h = lane & 1;
    const LAS float* s = scr + (32 * h) * 33 + n;
    unsigned w[8];
#pragma unroll
    for (int d = 0; d < 8; ++d) { int v = __builtin_amdgcn_cvt_pk_fp8_f32(s[(4 * d) * 33] * sc, s[(4 * d + 1) * 33] * sc, 0, false);
        v = __builtin_amdgcn_cvt_pk_fp8_f32(s[(4 * d + 2) * 33] * sc, s[(4 * d + 3) * 33] * sc, v, true); w[d] = (unsigned)v; }
    *(GAS v4u*)(WT8 + (size_t)n * ldt + 32 * h) = (v4u){w[0], w[1], w[2], w[3]};
    *(GAS v4u*)(WT8 + (size_t)n * ldt + 32 * h + 16) = (v4u){w[4], w[5], w[6], w[7]};
    LDS_WAIT(); asm volatile("" ::: "memory");
}
constexpr int IT_EG = 64 * 128, IT_EU = 64 * 128, IT_ED = 64 * 128, IT_SG = 128, IT_SU = 128, IT_SD = 128, IT_IN = 16 * 48, IT_OUT = 16 * 32, IT_GLU = 8 * 16, IT_RT = 16 * 2;
constexpr int NITEMS_T = IT_EG + IT_EU + IT_ED + IT_SG + IT_SU + IT_SD + IT_IN + IT_OUT + IT_GLU + IT_RT;

__device__ __forceinline__ void p0_convert_item(const Params& p, int it, LAS float* scr, int lane) {
    unsigned char* ws = p.ws;
    bf16* Wgu = (bf16*)(ws + WS_WGU_T); bf16* Wd = (bf16*)(ws + WS_WD_T);
    int r = it;
    if (r < IT_EG + IT_EU) {
        const int up = r >= IT_EG; if (up) r -= IT_EG;
        const int e = r >> 7, q = r & 127, kb = q >> 3, nb = q & 7, k0 = 64 * kb, n0 = 32 * nb;
        const float* src = (up ? p.in[29] : p.in[28]) + (size_t)e * D * DE + (size_t)k0 * DE + n0;
        const int drow = 256 * (n0 >> 7) + (n0 & 127) + (up ? 128 : 0);
        transpose_item8(src, DE, (unsigned char*)Wgu + (size_t)e * 512 * D + (size_t)drow * D + k0, D, 32.0f, scr, lane); return; }
    r -= IT_EG + IT_EU;
    if (r < IT_ED) {
        const int e = r >> 7, q = r & 127, kb = q >> 5, nb = q & 31, k0 = 64 * kb, n0 = 32 * nb;
        transpose_item8(p.in[30] + (size_t)e * DE * D + (size_t)k0 * D + n0, D, (unsigned char*)Wd + (size_t)e * D * DE + (size_t)n0 * DE + k0, DE, 16.0f, scr, lane); return; }
    r -= IT_ED;
    if (r < IT_SG + IT_SU) {
        const int up = r >= IT_SG; if (up) r -= IT_SG;
        const int kb = r >> 3, nb = r & 7, k0 = 64 * kb, n0 = 32 * nb;
        const float* src = (up ? p.in[32] : p.in[31]) + (size_t)k0 * DE + n0;
        const int drow = 256 * (n0 >> 7) + (n0 & 127) + (up ? 128 : 0);
        transpose_item8(src, DE, (unsigned char*)Wgu + (size_t)64 * 512 * D + (size_t)drow * D + k0, D, 32.0f, scr, lane); return; }
    r -= IT_SG + IT_SU;
    if (r < IT_SD) { const int kb = r >> 5, nb = r & 31, k0 = 64 * kb, n0 = 32 * nb;
        transpose_item8(p.in[33] + (size_t)k0 * D + n0, D, (unsigned char*)Wd + (size_t)64 * D * DE + (size_t)n0 * DE + k0, DE, 16.0f, scr, lane); return; }
    r -= IT_SD;
    if (r < IT_IN) { const int kb = r / 48, nb = r % 48, k0 = 64 * kb, n0 = 32 * nb;
        int drow; if (n0 < 512) drow = 256 * (n0 >> 7) + (n0 & 127); else if (n0 < 1024) { const int c = n0 - 512; drow = 256 * (c >> 7) + 128 + (c & 127); } else drow = n0;
        transpose_item(p.in[6] + (size_t)k0 * DIN + n0, DIN, (bf16*)(ws + WS_W_IN_T) + (size_t)drow * D + k0, D, scr, lane); return; }
    r -= IT_IN;
    if (r < IT_OUT) { const int kb = r >> 5, nb = r & 31, k0 = 64 * kb, n0 = 32 * nb;
        transpose_item(p.in[23] + (size_t)k0 * D + n0, D, (bf16*)(ws + WS_W_OUT_T) + (size_t)n0 * D + k0, D, scr, lane); return; }
    r -= IT_OUT;
    if (r < IT_GLU) { const int kb = r >> 4, nb = r & 15, k0 = 64 * kb, n0 = 32 * nb;
        transpose_item_glu(p.in[19], k0, n0, (bf16*)(ws + WS_W_GLU_T), scr, lane); return; }
    r -= IT_GLU;
    { const int kb = r >> 1, nb = r & 1, k0 = 64 * kb, n0 = 32 * nb;
      transpose_item(p.in[26] + (size_t)k0 * NE + n0, NE, (bf16*)(ws + WS_W_RT_T) + (size_t)n0 * D + k0, D, scr, lane); }
}

__device__ __forceinline__ void p0_mod_item(const Params& p, int item, LAS float* red, int tid) {
    const int cg = tid & 7, kr = tid >> 3, j0 = item * 32 + cg * 4;
    const float* c = p.in[1]; const float* w = p.in[2];
    f32x4 a0 = {0.f, 0.f, 0.f, 0.f}, a1 = {0.f, 0.f, 0.f, 0.f};
#pragma unroll 4
    for (int ps = 0; ps < 16; ++ps) { const int k = ps * 64 + kr;
        const f32x4 w4 = *(const f32x4*)(w + (size_t)k * 6 * D + j0);
        const float s0 = siluf_(c[k]), s1 = siluf_(c[D + k]);
        a0 += w4 * s0; a1 += w4 * s1; }
    LAS float* my = red + (kr * 8 + cg) * 8;
    my[0] = a0[0]; my[1] = a0[1]; my[2] = a0[2]; my[3] = a0[3]; my[4] = a1[0]; my[5] = a1[1]; my[6] = a1[2]; my[7] = a1[3];
    __syncthreads();
    if (tid < 64) { const int g = tid >> 3, q = tid & 7; float s = 0.f;
        for (int k2 = 0; k2 < 64; ++k2) s += red[(k2 * 8 + g) * 8 + q];
        const int b = q >> 2, j = item * 32 + g * 4 + (q & 3);
        ((float*)(p.ws + WS_MOD))[b * 6 * D + j] = s + p.in[3][j]; }
    __syncthreads();
}

__device__ __forceinline__ void p1_row(const Params& p, int m, int lane) {
    const int b = m / SEQL;
    const float* mod = (const float*)(p.ws + WS_MOD) + b * 6 * D;
    const GAS f32x4* xr = (const GAS f32x4*)(p.in[0] + (size_t)m * D) + lane;
    f32x4 v[4]; float s = 0.f;
#pragma unroll
    for (int j = 0; j < 4; ++j) { v[j] = xr[64 * j]; s += (v[j].x * v[j].x + v[j].y * v[j].y) + (v[j].z * v[j].z + v[j].w * v[j].w); }
    const float rstd = rsqrtf(wave_sum(s) * (1.f / D) + EPS);
    GAS unsigned long long* o8 = (GAS unsigned long long*)((bf16*)(p.ws + WS_ABUF) + (size_t)m * D) + lane;
#pragma unroll
    for (int j = 0; j < 4; ++j) { const int n = 4 * lane + 256 * j;
        const f32x4 g = *(const f32x4*)(p.in[4] + n), sc = *(const f32x4*)(mod + D + n), sh = *(const f32x4*)(mod + n);
        const f32x4 o = v[j] * rstd * g * (sc + 1.0f) + sh;
        o8[64 * j] = (unsigned long long)pk2(o.x, o.y) | ((unsigned long long)pk2(o.z, o.w) << 32); }
}

typedef float f32x16 __attribute__((ext_vector_type(16)));
__device__ __forceinline__ void p0_ssm_tables_gp(const Params& p, int q  ) {
    const int g = q >> 6;
    const double ar = p.in[11][q], ai = p.in[12][q], dt = exp((double)p.in[13][g]);
    const double mag = exp(ar * dt), lr = mag * cos(ai * dt), li = mag * sin(ai * dt);
    const double den = ar * ar + ai * ai, nr = lr - 1.0;
    const double kr = (nr * ar + li * ai) / den, ki = (li * ar - nr * ai) / den;
    ((f32x2*)(p.ws + WS_LAM))[q] = (f32x2){(float)lr, (float)li};
    double pr = lr, pi = li;
#pragma unroll
    for (int s = 0; s < 5; ++s) { const double nr2 = pr * pr - pi * pi, ni2 = 2.0 * pr * pi; pr = nr2; pi = ni2; }
    ((f32x2*)(p.ws + WS_LAM32))[q] = (f32x2){(float)pr, (float)pi};
    bf16* Bb = (bf16*)(p.ws + WS_BB);
    const int pp = q & 63;
    for (int h = 0; h < 16; ++h) { const double br = p.in[14][q * 16 + h], bi = p.in[15][q * 16 + h];
        Bb[((g * 2 + 0) * 64 + pp) * 16 + h] = (bf16)f2bf((float)(kr * br - ki * bi));
        Bb[((g * 2 + 1) * 64 + pp) * 16 + h] = (bf16)f2bf((float)(kr * bi + ki * br)); }
}
__device__ __forceinline__ void p0_ssm_tables_ct(const Params& p, int idx  ) {
    const int k = idx & 127, gh = idx >> 7;
    const float v = (k < 64) ? p.in[16][gh * 64 + k] : -p.in[17][gh * 64 + (k - 64)];
    ((bf16*)(p.ws + WS_CT))[idx] = (bf16)f2bf(v);
}

__device__ __forceinline__ bf16x8 ssm_load_u(const bf16* vu, int tokA, int tokB, int g, int lane) {
    const int i = lane & 31, kh = lane >> 5;
    const int hf = (i >> 2) & 1, r = (i & 3) + 4 * (i >> 3);
    const int tok = (hf ? tokB : tokA) + r;
    return *(const bf16x8*)(vu + (size_t)tok * D + CC + g * 16 + 8 * kh);
}
#define KEEP_V(x) asm volatile("" :: "v"(x))
#define MFMA_SETTLE1(x) asm volatile("s_nop 15\n\ts_nop 7" : "+v"(x))
#define MFMA_SETTLE_ALL() do { __builtin_amdgcn_sched_barrier(0); asm volatile("s_nop 15\n\ts_nop 15\n\ts_nop 15\n\ts_nop 15"); __builtin_amdgcn_sched_barrier(0); } while (0)
#define MFMA_SETTLE2(x, y) asm volatile("s_nop 15\n\ts_nop 7" : "+v"(x), "+v"(y))
__device__ __forceinline__ f32x16 mfma32(bf16x8 a, bf16x8 b, f32x16 c) { return __builtin_amdgcn_mfma_f32_32x32x16_bf16(a, b, c, 0, 0, 0); }
__device__ __forceinline__ void mfma_roundtrip2(f32x16& x, f32x16& y, LAS float* scr, int lane) {
#pragma unroll
    for (int k = 0; k < 16; ++k) { scr[k * 64 + lane] = x[k]; scr[(16 + k) * 64 + lane] = y[k]; }
    LDS_WAIT(); asm volatile("" ::: "memory");
#pragma unroll
    for (int k = 0; k < 16; ++k) { x[k] = scr[k * 64 + lane]; y[k] = scr[(16 + k) * 64 + lane]; }
    LDS_WAIT(); asm volatile("" ::: "memory");
}
__device__ __forceinline__ void mfma_roundtrip1(f32x16& x, LAS float* scr, int lane) {
#pragma unroll
    for (int k = 0; k < 16; ++k) scr[k * 64 + lane] = x[k];
    LDS_WAIT(); asm volatile("" ::: "memory");
#pragma unroll
    for (int k = 0; k < 16; ++k) x[k] = scr[k * 64 + lane];
    LDS_WAIT(); asm volatile("" ::: "memory");
}
struct SsmGroup { bf16x8 bb[2][2]; f32x2 lam[2]; };
__device__ __forceinline__ void ssm_group_load(const unsigned char* ws, int g, int lane, SsmGroup& G) {
    const bf16* Bb = (const bf16*)(ws + WS_BB);
#pragma unroll
    for (int ri = 0; ri < 2; ++ri)
#pragma unroll
        for (int pb = 0; pb < 2; ++pb) G.bb[ri][pb] = *(const bf16x8*)(Bb + ((g * 2 + ri) * 64 + pb * 32 + (lane & 31)) * 16 + 8 * (lane >> 5));
#pragma unroll
    for (int pb = 0; pb < 2; ++pb) G.lam[pb] = ((const f32x2*)(ws + WS_LAM))[g * 64 + pb * 32 + (lane & 31)];
}

__device__ __forceinline__ void p3a_items(const Params& p, int gw0, int NGW, int lane) {
    const int g = gw0 & 31;
    const bf16* vu = (const bf16*)(p.ws + WS_BBUF);
    SsmGroup G; ssm_group_load(p.ws, g, lane, G);
    const f32x16 z16 = {0.f, 0.f, 0.f, 0.f, 0.f, 0.f, 0.f, 0.f, 0.f, 0.f, 0.f, 0.f, 0.f, 0.f, 0.f, 0.f};
    f32x2* E = (f32x2*)(p.ws + WS_E);
    bf16x8 an[2];
    { const int i0 = gw0 >> 5; an[0] = ssm_load_u(vu, 64 * i0, 64 * i0 + 32, g, lane); an[1] = ssm_load_u(vu, 64 * i0 + 16, 64 * i0 + 48, g, lane); }
    for (int item = gw0; item < 256 * 32; item += NGW) {
        const int i = item >> 5;
        bf16x8 a[2] = {an[0], an[1]};
        if (item + NGW < 256 * 32) { const int i1 = (item + NGW) >> 5; an[0] = ssm_load_u(vu, 64 * i1, 64 * i1 + 32, g, lane); an[1] = ssm_load_u(vu, 64 * i1 + 16, 64 * i1 + 48, g, lane); }
        float sr[2] = {0.f, 0.f}, si[2] = {0.f, 0.f};
#pragma unroll
        for (int blk = 0; blk < 2; ++blk) {
#pragma unroll
            for (int pb = 0; pb < 2; ++pb) {
                f32x16 bur = mfma32(a[blk], G.bb[0][pb], z16);
                f32x16 bui = mfma32(a[blk], G.bb[1][pb], z16);
                MFMA_SETTLE2(bur, bui);
                const float lr = G.lam[pb].x, li = G.lam[pb].y;
#pragma unroll
                for (int r = 0; r < 16; ++r) { float nsr = fmaf(lr, sr[pb], fmaf(-li, si[pb], bur[r])), nsi = fmaf(lr, si[pb], fmaf(li, sr[pb], bui[r])); asm volatile("" : "+v"(nsr)); asm volatile("" : "+v"(nsi)); sr[pb] = nsr; si[pb] = nsi; }
            }
        }
        const int sc = 2 * i + (lane >> 5);
#pragma unroll
        for (int pb = 0; pb < 2; ++pb) E[(size_t)sc * 2048 + g * 64 + pb * 32 + (lane & 31)] = (f32x2){sr[pb], si[pb]};
        asm volatile("" :: "v"(a[0]), "v"(a[1]) : "memory");
    }
    asm volatile("" :: "v"(G.bb[0][0]), "v"(G.bb[0][1]), "v"(G.bb[1][0]), "v"(G.bb[1][1]) : "memory");
}

__device__ __forceinline__ float wave_reduce_scatter16(const float (&v)[16], int lane) {
    float a[8], b[4], c[2], d;
    const bool s5 = (lane & 32) != 0, s4 = (lane & 16) != 0, s3 = (lane & 8) != 0, s2 = (lane & 4) != 0;
#pragma unroll
    for (int i = 0; i < 8; ++i) { const float mine = s5 ? v[8 + i] : v[i], theirs = s5 ? v[i] : v[8 + i]; a[i] = mine + __shfl_xor(theirs, 32); }
#pragma unroll
    for (int i = 0; i < 4; ++i) { const float mine = s4 ? a[4 + i] : a[i], theirs = s4 ? a[i] : a[4 + i]; b[i] = mine + __shfl_xor(theirs, 16); }
#pragma unroll
    for (int i = 0; i < 2; ++i) { const float mine = s3 ? b[2 + i] : b[i], theirs = s3 ? b[i] : b[2 + i]; c[i] = mine + __shfl_xor(theirs, 8); }
    { const float mine = s2 ? c[1] : c[0], theirs = s2 ? c[0] : c[1]; d = mine + __shfl_xor(theirs, 4); }
    d += __shfl_xor(d, 2); d += __shfl_xor(d, 1);
    return d;
}
__device__ __forceinline__ int rs16_token(int lane) { return ((lane >> 5) & 1) * 8 + ((lane >> 4) & 1) * 4 + ((lane >> 3) & 1) * 2 + ((lane >> 2) & 1); }

constexpr int CONV_ROWS = 62, CONV_RED_OFF = CONV_ROWS * 1024, CONV_STAT_OFF = CONV_RED_OFF + 1024, CONV_PART_OFF = CONV_STAT_OFF + 256;
__device__ __forceinline__ void p3_conv_tile(const Params& p, int tile, LAS unsigned char* lds, int tid) {
    const int lane = tid & 63, wave = tid >> 6, cp = tid & 255, th = tid >> 8;
    const int t0 = tile * 32, tl0 = t0 % SEQL;
    const bf16* vu = (const bf16*)(p.ws + WS_BBUF);
    LAS unsigned char* vt = lds;
    LAS float* red = (LAS float*)(lds + CONV_RED_OFF);
    LAS float* stat = (LAS float*)(lds + CONV_STAT_OFF);
    for (int r = wave; r < CONV_ROWS; r += NWAVES) {
        v4u val = {0u, 0u, 0u, 0u};
        if (tl0 + r - 30 >= 0) val = *(const v4u*)(vu + (size_t)(t0 + r - 30) * D + lane * 8);
        *(LAS v4u*)(vt + r * 1024 + lane * 16) = val;
    }
    f32x2 w[31];
#pragma unroll
    for (int j = 0; j < 31; ++j) w[j] = *(const f32x2*)(p.in[7] + j * CC + 2 * cp);
    const f32x2 bias = *(const f32x2*)(p.in[8] + 2 * cp);
    __syncthreads();
    f32x2 acc[16];
#pragma unroll
    for (int o = 0; o < 16; ++o) acc[o] = bias;
#pragma unroll
    for (int s = 0; s < 46; ++s) {
        const unsigned pr = *(const LAS unsigned*)(vt + (16 * th + s) * 1024 + cp * 4);
        const f32x2 v = {bflo(pr), bfhi(pr)};
#pragma unroll
        for (int o = 0; o < 16; ++o) { const int j = s - o; if (j >= 0 && j <= 30) acc[o] += v * w[j]; }
    }
    LAS f32x2* part = (LAS f32x2*)(lds + CONV_PART_OFF);
#pragma unroll
    for (int o = 0; o < 16; ++o) part[(16 * th + o) * 257 + cp] = (f32x2){acc[o].x + acc[o].y, acc[o].x * acc[o].x + acc[o].y * acc[o].y};
    __syncthreads();
    { const int tk = tid >> 4, sub = tid & 15; float s = 0.f, q = 0.f;
#pragma unroll
      for (int i = 0; i < 16; ++i) { const f32x2 v = part[tk * 257 + sub + 16 * i]; s += v.x; q += v.y; }
#pragma unroll
      for (int o = 1; o < 16; o <<= 1) { s += __shfl_xor(s, o); q += __shfl_xor(q, o); }
      if (sub == 0) { const float mu = s * (1.f / CC), var = q * (1.f / CC) - mu * mu; stat[tk * 2] = mu; stat[tk * 2 + 1] = rsqrtf(var + EPS); } }
    __syncthreads();
    const f32x2 lg = *(const f32x2*)(p.in[9] + 2 * cp), lb = *(const f32x2*)(p.in[10] + 2 * cp);
#pragma unroll
    for (int o = 0; o < 16; ++o) { const float mu = stat[(16 * th + o) * 2], rs = stat[(16 * th + o) * 2 + 1];
        f32x2 y = (acc[o] - mu) * rs * lg + lb; y.x = siluf_(y.x); y.y = siluf_(y.y); acc[o] = y;
        part[(16 * th + o) * 257 + cp].x = y.x * y.x + y.y * y.y; }
    __syncthreads();
    { const int tk = tid >> 4, sub = tid & 15; float q = 0.f;
#pragma unroll
      for (int i = 0; i < 16; ++i) q += part[tk * 257 + sub + 16 * i].x;
#pragma unroll
      for (int o = 1; o < 16; o <<= 1) q += __shfl_xor(q, o);
      if (sub == 0) stat[tk * 2] = rsqrtf(q * (1.f / CC) + EPS); }
    __syncthreads();
    const f32x2 go = *(const f32x2*)(p.in[21] + 2 * cp);
    bf16* mixed = (bf16*)(p.ws + WS_ABUF);
#pragma unroll
    for (int o = 0; o < 16; ++o) { const float rs = stat[(16 * th + o) * 2]; const f32x2 y = acc[o] * rs * go;
        *(unsigned*)(mixed + (size_t)(t0 + 16 * th + o) * D + 2 * cp) = pk2(y.x, y.y); }
    __syncthreads();
}

__device__ __forceinline__ void p3b_carry(const Params& p, int idx  ) {
    const int b = idx >> 11, q = idx & 2047;
    const f32x2 L = ((const f32x2*)(p.ws + WS_LAM32))[q];
    const f32x2* E = (const f32x2*)(p.ws + WS_E) + (size_t)b * 256 * 2048 + q;
    f32x2* S = (f32x2*)(p.ws + WS_SINIT) + (size_t)b * 256 * 2048 + q;
    float sr = 0.f, si = 0.f;
    f32x2 ea[16], eb[16];
#pragma unroll
    for (int j = 0; j < 16; ++j) ea[j] = E[(size_t)j * 2048];
    for (int c0 = 0; c0 < 256; c0 += 32) {
#pragma unroll
        for (int j = 0; j < 16; ++j) eb[j] = E[(size_t)(c0 + 16 + j) * 2048];
#pragma unroll
        for (int j = 0; j < 16; ++j) { S[(size_t)(c0 + j) * 2048] = (f32x2){sr, si};
            const float nsr = L.x * sr - L.y * si + ea[j].x, nsi = L.x * si + L.y * sr + ea[j].y; sr = nsr; si = nsi; }
        if (c0 + 32 < 256) {
#pragma unroll
            for (int j = 0; j < 16; ++j) ea[j] = E[(size_t)(c0 + 32 + j) * 2048]; }
#pragma unroll
        for (int j = 0; j < 16; ++j) { S[(size_t)(c0 + 16 + j) * 2048] = (f32x2){sr, si};
            const float nsr = L.x * sr - L.y * si + eb[j].x, nsi = L.x * si + L.y * sr + eb[j].y; sr = nsr; si = nsi; }
    }
}

constexpr int P3C_STILE = 32 * 272, P3C_G_OFF = 8 * P3C_STILE, P3C_G_STRIDE = 1040, P3C_RED_OFF = P3C_G_OFF + 64 * P3C_G_STRIDE;
__device__ __forceinline__ void p3c_chunk(const Params& p, int chunk, LAS unsigned char* lds, int tid) {
    const int lane = tid & 63, wave = __builtin_amdgcn_readfirstlane(tid >> 6);
    const int t0 = chunk * 64;
    const bf16* vu = (const bf16*)(p.ws + WS_BBUF);
    LAS unsigned char* st = lds + wave * P3C_STILE;
    LAS unsigned char* gt = lds + P3C_G_OFF;
    const int hf = lane >> 5, j = lane & 31;
    const f32x16 z16 = {0.f, 0.f, 0.f, 0.f, 0.f, 0.f, 0.f, 0.f, 0.f, 0.f, 0.f, 0.f, 0.f, 0.f, 0.f, 0.f};
    const bf16* Ct = (const bf16*)(p.ws + WS_CT);
    for (int gi = 0; gi < ((p.flags & 2) ? 0 : 4); ++gi) {
        const int g = wave * 4 + gi;
        SsmGroup G; ssm_group_load(p.ws, g, lane, G);
        float sr[2], si[2];
        { const f32x2* S0 = (const f32x2*)(p.ws + WS_SINIT) + (size_t)(2 * chunk + hf) * 2048 + g * 64 + j;
          const f32x2 s0 = S0[0], s1 = S0[32]; sr[0] = s0.x; si[0] = s0.y; sr[1] = s1.x; si[1] = s1.y; }
        bf16x8 cb[8];
#pragma unroll
        for (int ks = 0; ks < 8; ++ks) { bf16x8 v = {0, 0, 0, 0, 0, 0, 0, 0}; if (j < 16) v = *(const bf16x8*)(Ct + (size_t)(g * 16 + j) * 128 + ks * 16 + 8 * hf); cb[ks] = v; }
        bf16x8 db = {0, 0, 0, 0, 0, 0, 0, 0};
        if (j < 16 && (j >> 3) == hf) { const unsigned short dv = (unsigned short)f2bf(p.in[18][g * 16 + j]);
#pragma unroll
            for (int e = 0; e < 8; ++e) if ((j & 7) == e) db[e] = (short)dv; }
#pragma unroll
        for (int blk = 0; blk < 2; ++blk) {
            const bf16x8 a = ssm_load_u(vu, t0 + 16 * blk, t0 + 32 + 16 * blk, g, lane);
            f32x16 bur[2], bui[2];
#pragma unroll
            for (int pb = 0; pb < 2; ++pb) {
                bur[pb] = mfma32(a, G.bb[0][pb], z16);
                bui[pb] = mfma32(a, G.bb[1][pb], z16);
                MFMA_SETTLE2(bur[pb], bui[pb]);
            }
#pragma unroll
            for (int pb = 0; pb < 2; ++pb) {
                const float lr = G.lam[pb].x, li = G.lam[pb].y;
#pragma unroll
                for (int r = 0; r < 16; ++r) {
                    float nsr = fmaf(lr, sr[pb], fmaf(-li, si[pb], bur[pb][r])), nsi = fmaf(lr, si[pb], fmaf(li, sr[pb], bui[pb][r])); asm volatile("" : "+v"(nsr)); asm volatile("" : "+v"(nsi)); sr[pb] = nsr; si[pb] = nsi;
                    const int row = (r & 3) + 8 * (r >> 2) + 4 * hf;
                    const unsigned wri = pk2(nsr, nsi);
                    *(LAS unsigned short*)(st + row * 272 + (pb * 32 + j) * 2) = (unsigned short)wri;
                    *(LAS unsigned short*)(st + row * 272 + (64 + pb * 32 + j) * 2) = (unsigned short)(wri >> 16);
                }
            }
            LDS_WAIT(); asm volatile("" ::: "memory");
            f32x16 y = mfma32(a, db, z16);
#pragma unroll
            for (int ks = 0; ks < 8; ++ks) { const bf16x8 sa = *(const LAS bf16x8*)(st + j * 272 + (ks * 16 + 8 * hf) * 2); y = mfma32(sa, cb[ks], y); KEEP_V(sa); }
            MFMA_SETTLE1(y);
            LDS_WAIT(); asm volatile("" ::: "memory");
#pragma unroll
            for (int r = 0; r < 16; ++r) { float yr = y[r]; asm volatile("" : "+v"(yr)); y[r] = yr; }
            KEEP_V(a);
            if (j < 16) {
#pragma unroll
                for (int r = 0; r < 16; r += 2) { const int tokl = 32 * hf + 16 * blk + r; const unsigned w2 = pk2(gelu_tanh(y[r]), gelu_tanh(y[r + 1]));
                    *(LAS unsigned short*)(gt + tokl * P3C_G_STRIDE + (g * 16 + j) * 2) = (unsigned short)w2;
                    *(LAS unsigned short*)(gt + (tokl + 1) * P3C_G_STRIDE + (g * 16 + j) * 2) = (unsigned short)(w2 >> 16); }
            }
            LDS_WAIT(); asm volatile("" ::: "memory");
        }
        KEEP_V(db); KEEP_V(G.bb[0][0]); KEEP_V(G.bb[0][1]); KEEP_V(G.bb[1][0]); KEEP_V(G.bb[1][1]);
#pragma unroll
        for (int ks = 0; ks < 8; ++ks) KEEP_V(cb[ks]);
    }
    __syncthreads();
    if (p.flags & 4) return;
    const int fr = lane & 15, fq = lane >> 4;
    f32x4 acc[4][4];
#pragma unroll
    for (int mf = 0; mf < 4; ++mf)
#pragma unroll
        for (int nf = 0; nf < 4; ++nf) acc[mf][nf] = (f32x4){0.f, 0.f, 0.f, 0.f};
    const bf16* Wg = (const bf16*)(p.ws + WS_W_GLU_T);
#pragma unroll 4
    for (int ks = 0; ks < 16; ++ks) {
        bf16x8 af[4], bfr[4];
#pragma unroll
        for (int nf = 0; nf < 4; ++nf) bfr[nf] = *(const bf16x8*)(Wg + (size_t)((wave * 16 + ks) * 4 + nf) * 512 + lane * 8);
#pragma unroll
        for (int mf = 0; mf < 4; ++mf) af[mf] = *(const LAS bf16x8*)(gt + (16 * mf + fr) * P3C_G_STRIDE + (32 * ks + 8 * fq) * 2);
#pragma unroll
        for (int mf = 0; mf < 4; ++mf)
#pragma unroll
            for (int nf = 0; nf < 4; ++nf) acc[mf][nf] = __builtin_amdgcn_mfma_f32_16x16x32_bf16(bfr[nf], af[mf], acc[mf][nf], 0, 0, 0);
    }
    MFMA_SETTLE_ALL();
    float ssq[4] = {0.f, 0.f, 0.f, 0.f};
#pragma unroll
    for (int nf = 0; nf < 4; ++nf) { const int n0 = 64 * wave + 16 * nf + 4 * fq; const f32x4 bg = *(const f32x4*)(p.in[20] + n0);
#pragma unroll
        for (int mf = 0; mf < 4; ++mf) { const v2u gw = *(const LAS v2u*)(gt + (16 * mf + fr) * P3C_G_STRIDE + n0 * 2);
            const f32x4 gv = {bflo(gw.x), bfhi(gw.x), bflo(gw.y), bfhi(gw.y)}; f32x4 o;
#pragma unroll
            for (int e = 0; e < 4; ++e) { o[e] = gv[e] * sigmoidf_(acc[mf][nf][e] + bg[e]); ssq[mf] += o[e] * o[e]; }
            acc[mf][nf] = o; } }
    LAS float* red = (LAS float*)(lds + P3C_RED_OFF);
#pragma unroll
    for (int mf = 0; mf < 4; ++mf) { float s = ssq[mf]; s += __shfl_xor(s, 16); s += __shfl_xor(s, 32); if (fq == 0) red[wave * 64 + 16 * mf + fr] = s; }
    __syncthreads();
    float rs[4];
#pragma unroll
    for (int mf = 0; mf < 4; ++mf) { float s = 0.f;
#pragma unroll
        for (int wv = 0; wv < 8; ++wv) s += red[wv * 64 + 16 * mf + fr];
        rs[mf] = rsqrtf(s * (1.f / CC) + EPS); }
    bf16* mixed = (bf16*)(p.ws + WS_ABUF);
#pragma unroll
    for (int nf = 0; nf < 4; ++nf) { const int n0 = 64 * wave + 16 * nf + 4 * fq; const f32x4 go = *(const f32x4*)(p.in[22] + n0);
#pragma unroll
        for (int mf = 0; mf < 4; ++mf) { const f32x4 o = acc[mf][nf] * rs[mf] * go;
            v2u w; w.x = pk2(o[0], o[1]); w.y = pk2(o[2], o[3]);
            *(v2u*)(mixed + (size_t)(t0 + 16 * mf + fr) * D + CC + n0) = w; } }
    __syncthreads();
}


constexpr int P4B_HSTRIDE = 2064, P4B_LOGIT_OFF = 32 * P4B_HSTRIDE;
__device__ __forceinline__ float wave_max(float v) {
#pragma unroll
    for (int o = 1; o < 64; o <<= 1) v = fmaxf(v, __shfl_xor(v, o));
    return v;
}
__device__ __forceinline__ void p4b_tile(const Params& p, int tile, LAS unsigned char* lds, int tid) {
    const int lane = tid & 63, wave = __builtin_amdgcn_readfirstlane(tid >> 6);
    const int t0 = tile * 32, b = t0 / SEQL;
    const float* mod = (const float*)(p.ws + WS_MOD) + b * 6 * D;
    const bf16* obuf = (const bf16*)(p.ws + WS_BBUF);
    bf16* h2 = (bf16*)(p.ws + WS_ABUF);
    LAS unsigned char* ht = lds;
    LAS float* logits = (LAS float*)(lds + P4B_LOGIT_OFF);
    const int n0 = 8 * lane, n1 = 512 + 8 * lane;
    {
        f32x4 gp[4], gt[4], gq[4], sc[4], sh[4];
#pragma unroll
        for (int q = 0; q < 4; ++q) { const int n = (q < 2 ? n0 : n1) + 4 * (q & 1);
            gp[q] = *(const f32x4*)(p.in[5] + n); gt[q] = *(const f32x4*)(mod + 2 * D + n); gq[q] = *(const f32x4*)(p.in[24] + n);
            sc[q] = *(const f32x4*)(mod + 4 * D + n) + 1.0f; sh[q] = *(const f32x4*)(mod + 3 * D + n); }
        for (int rr = 0; rr < 4; ++rr) {
            const int row = 4 * wave + rr; const size_t t = (size_t)(t0 + row);
            const v4u o0 = *(const v4u*)(obuf + t * D + n0), o1 = *(const v4u*)(obuf + t * D + n1);
            f32x4 ov[4] = {{bflo(o0.x), bfhi(o0.x), bflo(o0.y), bfhi(o0.y)}, {bflo(o0.z), bfhi(o0.z), bflo(o0.w), bfhi(o0.w)},
                           {bflo(o1.x), bfhi(o1.x), bflo(o1.y), bfhi(o1.y)}, {bflo(o1.z), bfhi(o1.z), bflo(o1.w), bfhi(o1.w)}};
            f32x4 xv[4];
#pragma unroll
            for (int q = 0; q < 4; ++q) xv[q] = *(const f32x4*)(p.in[0] + t * D + (q < 2 ? n0 : n1) + 4 * (q & 1));
            float ss = 0.f;
#pragma unroll
            for (int q = 0; q < 4; ++q) ss += (ov[q].x * ov[q].x + ov[q].y * ov[q].y) + (ov[q].z * ov[q].z + ov[q].w * ov[q].w);
            const float rstd = rsqrtf(wave_sum(ss) * (1.f / D) + EPS);
            float s2 = 0.f;
#pragma unroll
            for (int q = 0; q < 4; ++q) { xv[q] = xv[q] + gt[q] * (ov[q] * rstd * gp[q]); s2 += (xv[q].x * xv[q].x + xv[q].y * xv[q].y) + (xv[q].z * xv[q].z + xv[q].w * xv[q].w);
                *(f32x4*)(p.out + t * D + (q < 2 ? n0 : n1) + 4 * (q & 1)) = xv[q]; }
            const float r2 = rsqrtf(wave_sum(s2) * (1.f / D) + EPS);
            f32x4 hv[4];
#pragma unroll
            for (int q = 0; q < 4; ++q) hv[q] = xv[q] * r2 * gq[q] * sc[q] + sh[q];
            v4u w0, w1;
            w0.x = pk2(hv[0].x, hv[0].y); w0.y = pk2(hv[0].z, hv[0].w); w0.z = pk2(hv[1].x, hv[1].y); w0.w = pk2(hv[1].z, hv[1].w);
            w1.x = pk2(hv[2].x, hv[2].y); w1.y = pk2(hv[2].z, hv[2].w); w1.z = pk2(hv[3].x, hv[3].y); w1.w = pk2(hv[3].z, hv[3].w);
            *(v4u*)(h2 + t * D + n0) = w0; *(v4u*)(h2 + t * D + n1) = w1;
            { unsigned char* h8 = p.ws + WS_H8 + t * D;
              int a0 = __builtin_amdgcn_cvt_pk_fp8_f32(hv[0].x, hv[0].y, 0, false); a0 = __builtin_amdgcn_cvt_pk_fp8_f32(hv[0].z, hv[0].w, a0, true);
              int a1 = __builtin_amdgcn_cvt_pk_fp8_f32(hv[1].x, hv[1].y, 0, false); a1 = __builtin_amdgcn_cvt_pk_fp8_f32(hv[1].z, hv[1].w, a1, true);
              int b0 = __builtin_amdgcn_cvt_pk_fp8_f32(hv[2].x, hv[2].y, 0, false); b0 = __builtin_amdgcn_cvt_pk_fp8_f32(hv[2].z, hv[2].w, b0, true);
              int b1 = __builtin_amdgcn_cvt_pk_fp8_f32(hv[3].x, hv[3].y, 0, false); b1 = __builtin_amdgcn_cvt_pk_fp8_f32(hv[3].z, hv[3].w, b1, true);
              *(v2u*)(h8 + n0) = (v2u){(unsigned)a0, (unsigned)a1}; *(v2u*)(h8 + n1) = (v2u){(unsigned)b0, (unsigned)b1}; }
            *(LAS v4u*)(ht + row * P4B_HSTRIDE + n0 * 2) = w0; *(LAS v4u*)(ht + row * P4B_HSTRIDE + n1 * 2) = w1;
        }
    }
    __syncthreads();
    {
        const int fr = lane & 15, fq = lane >> 4, mf = wave & 1, nf = wave >> 1;
        const bf16* Wr = (const bf16*)(p.ws + WS_W_RT_T);
        f32x4 acc = {0.f, 0.f, 0.f, 0.f};
#pragma unroll 8
        for (int ks = 0; ks < 32; ++ks) {
            const bf16x8 a = *(const LAS bf16x8*)(ht + (16 * mf + fr) * P4B_HSTRIDE + (32 * ks + 8 * fq) * 2);
            const bf16x8 bb = *(const bf16x8*)(Wr + (size_t)(16 * nf + fr) * D + 32 * ks + 8 * fq);
            acc = __builtin_amdgcn_mfma_f32_16x16x32_bf16(a, bb, acc, 0, 0, 0);
        }
        MFMA_SETTLE1(acc);
#pragma unroll
        for (int r = 0; r < 4; ++r) logits[(16 * mf + 4 * fq + r) * 64 + 16 * nf + fr] = acc[r];
    }
    __syncthreads();
    {
        unsigned* cnt = (unsigned*)(p.ws + WS_CTL) + CW_CNT;
        int* list = (int*)(p.ws + WS_LIST);
        int* top_idx = (int*)(p.ws + WS_TOPIDX); float* gate_w = (float*)(p.ws + WS_GATEW);
        LAS unsigned* lcnt = (LAS unsigned*)(lds + P4B_LOGIT_OFF + 8192);
        LAS int* lsel = (LAS int*)(lds + P4B_LOGIT_OFF + 8192 + 256);
        if (tid < 64) lcnt[tid] = 0u;
        __syncthreads();
        const float brt = p.in[27][lane];
        const float NEG = -3.0e38f;
        {
            float s[4], bsc[4], gs[4], masked[4], mysel[4], ssum[4]; int myidx[4];
            const int g = lane >> 3;
#pragma unroll
            for (int rr = 0; rr < 4; ++rr) { s[rr] = sigmoidf_(logits[(4 * wave + rr) * 64 + lane]); bsc[rr] = s[rr] + brt; myidx[rr] = 0; mysel[rr] = 0.f; ssum[rr] = 0.f; }
            float m1[4], m2[4];
#pragma unroll
            for (int rr = 0; rr < 4; ++rr) m1[rr] = bsc[rr];
#pragma unroll
            for (int o = 1; o < 8; o <<= 1) {
#pragma unroll
                for (int rr = 0; rr < 4; ++rr) m1[rr] = fmaxf(m1[rr], __shfl_xor(m1[rr], o)); }
#pragma unroll
            for (int rr = 0; rr < 4; ++rr) { const unsigned long long eq = __ballot(bsc[rr] == m1[rr]);
                const int first = __ffsll((long long)(eq & (0xFFull << (8 * g)))) - 1; m2[rr] = (lane == first) ? NEG : bsc[rr]; }
#pragma unroll
            for (int o = 1; o < 8; o <<= 1) {
#pragma unroll
                for (int rr = 0; rr < 4; ++rr) m2[rr] = fmaxf(m2[rr], __shfl_xor(m2[rr], o)); }
#pragma unroll
            for (int rr = 0; rr < 4; ++rr) gs[rr] = m1[rr] + m2[rr];
            int rank[4] = {0, 0, 0, 0};
#pragma unroll
            for (int j = 0; j < 8; ++j) {
#pragma unroll
                for (int rr = 0; rr < 4; ++rr) { const float gj = __shfl(gs[rr], 8 * j); rank[rr] += (gj > gs[rr] || (gj == gs[rr] && j < g)) ? 1 : 0; } }
#pragma unroll
            for (int rr = 0; rr < 4; ++rr) masked[rr] = (rank[rr] < 4) ? bsc[rr] : NEG;
#pragma unroll
            for (int r = 0; r < 8; ++r) {
                float m[4];
#pragma unroll
                for (int rr = 0; rr < 4; ++rr) m[rr] = masked[rr];
#pragma unroll
                for (int o = 1; o < 64; o <<= 1) {
#pragma unroll
                    for (int rr = 0; rr < 4; ++rr) m[rr] = fmaxf(m[rr], __shfl_xor(m[rr], o)); }
#pragma unroll
                for (int rr = 0; rr < 4; ++rr) {
                    const unsigned long long eb = __ballot(masked[rr] == m[rr]);
                    const int idx = __ffsll((long long)eb) - 1;
                    const float sv = __shfl(s[rr], idx);
                    ssum[rr] += sv;
                    if (lane == r) { myidx[rr] = idx; mysel[rr] = sv; }
                    if (lane == idx) masked[rr] = NEG;
                }
            }
            if (lane < 8) {
#pragma unroll
                for (int rr = 0; rr < 4; ++rr) { const int row = 4 * wave + rr, t = t0 + row;
                    const float w = mysel[rr] / (ssum[rr] + 1e-20f) * 2.5f;
                    top_idx[t * 8 + lane] = myidx[rr]; gate_w[t * 8 + lane] = w;
                    const unsigned lp = __hip_atomic_fetch_add(&lcnt[myidx[rr]], 1u, __ATOMIC_RELAXED, __HIP_MEMORY_SCOPE_WORKGROUP);
                    lsel[row * 8 + lane] = myidx[rr] | ((int)lp << 8); }
            }
        }
        __syncthreads();
        if (tid < 64) { const unsigned c = lcnt[tid]; unsigned base = 0u; if (c) base = atomicAdd(&cnt[tid * CNT_STRIDE], c); lcnt[tid] = base; }
        __syncthreads();
        if (tid < 256) { const int v = lsel[tid], e = v & 255, lp = v >> 8; list[(size_t)e * T + lcnt[e] + lp] = (t0 + (tid >> 3)) * 8 + (tid & 7); }
    }
    __syncthreads();
}


__device__ __forceinline__ int moe_build_units(const Params& p, LAS unsigned char* lds, int tid, int bid, int G, int mode) {
    LAS int* tp = (LAS int*)(lds + pg8::MOE_TP_OFF);
    LAS int* desc = (LAS int*)(lds + pg8::MOE_DESC_OFF);
    LAS int* rows = (LAS int*)(lds + pg8::MOE_ROWS_OFF);
    const unsigned* cnt = (const unsigned*)(p.ws + WS_CTL) + CW_CNT;
    if (tid < 64) {
        const int nt_e = ((int)cnt[tid * CNT_STRIDE] + 255) >> 8; int s = nt_e;
#pragma unroll
        for (int o = 1; o < 64; o <<= 1) { const int v = __shfl_up(s, o); if (tid >= o) s += v; }
        tp[tid] = s - nt_e; if (tid == 63) { tp[64] = s; tp[65] = s + 64; } }
    __syncthreads();
    const int NU = tp[65] * 2;
    int nlocal = 0; for (int u = bid; u < NU; u += G) ++nlocal;
    if (nlocal > pg8::MOE_MAX_UNITS) nlocal = pg8::MOE_MAX_UNITS;
    if (tid < nlocal) { const int u = bid + tid * G, ti = u >> 1, pn = u & 1;
        int e = 0; for (int q = 1; q <= 64; ++q) if (tp[q] <= ti) e = q;
        const int tile = ti - tp[e], n = (e < 64) ? (int)cnt[e * CNT_STRIDE] : T, nv = n - tile * 256;
        desc[tid * 8 + 0] = e; desc[tid * 8 + 1] = ti; desc[tid * 8 + 2] = pn; desc[tid * 8 + 3] = nv > 256 ? 256 : nv; desc[tid * 8 + 4] = tile; }
    __syncthreads();
    const int* list = (const int*)(p.ws + WS_LIST);
    for (int q = tid; q < nlocal * 256; q += NTHREADS) { const int s = q >> 8, r = q & 255;
        const int e = desc[s * 8], tile = desc[s * 8 + 4], nv = desc[s * 8 + 3];
        int id = -1;
        if (r < nv) id = (e < 64) ? list[(size_t)e * T + tile * 256 + r] : tile * 256 + r;
        rows[q] = (mode == 0) ? (id < 0 ? 0 : (e < 64 ? (id >> 3) : id)) : id;
        if (mode == 1) ((LAS float*)(lds + pg8::MOE_W_OFF))[q] = (id >= 0 && e < 64) ? ((const float*)(p.ws + WS_GATEW))[id] : 1.0f; }
    __syncthreads();
    return nlocal;
}

__device__ __forceinline__ void moe_combine_row(const Params& p, int t, int lane) {
    const unsigned char* yk8 = p.ws + WS_WGU_T;
    const bf16* ycomb = (const bf16*)(p.ws + WS_ABUF);
    const int c0 = 16 * lane;
    float a[16];
    { const v4u w0 = *(const v4u*)(ycomb + (size_t)t * D + c0), w1 = *(const v4u*)(ycomb + (size_t)t * D + c0 + 8);
      a[0] = bflo(w0.x); a[1] = bfhi(w0.x); a[2] = bflo(w0.y); a[3] = bfhi(w0.y); a[4] = bflo(w0.z); a[5] = bfhi(w0.z); a[6] = bflo(w0.w); a[7] = bfhi(w0.w);
      a[8] = bflo(w1.x); a[9] = bfhi(w1.x); a[10] = bflo(w1.y); a[11] = bfhi(w1.y); a[12] = bflo(w1.z); a[13] = bfhi(w1.z); a[14] = bflo(w1.w); a[15] = bfhi(w1.w); }
    v4u q[8];
#pragma unroll
    for (int k = 0; k < 8; ++k) q[k] = *(const v4u*)(yk8 + ((size_t)t * 8 + k) * 1024 + c0);
    float r[16];
#pragma unroll
    for (int j = 0; j < 16; ++j) r[j] = 0.f;
#pragma unroll
    for (int k = 0; k < 8; ++k) {
        const unsigned w4[4] = {q[k].x, q[k].y, q[k].z, q[k].w};
#pragma unroll
        for (int d = 0; d < 4; ++d) { const f32x2 lo = __builtin_amdgcn_cvt_pk_f32_fp8((int)w4[d], false), hi = __builtin_amdgcn_cvt_pk_f32_fp8((int)w4[d], true);
            r[4 * d + 0] += lo.x; r[4 * d + 1] += lo.y; r[4 * d + 2] += hi.x; r[4 * d + 3] += hi.y; }
    }
    float ss = 0.f;
#pragma unroll
    for (int j = 0; j < 16; ++j) { a[j] += r[j] * (1.0f / 16.0f); ss += a[j] * a[j]; }
    const float rstd = rsqrtf(wave_sum(ss) * (1.f / D) + EPS);
    const int b = t / SEQL;
    const float* gtf = (const float*)(p.ws + WS_MOD) + b * 6 * D + 5 * D;
    float* o = p.out + (size_t)t * D + c0;
#pragma unroll
    for (int qd = 0; qd < 4; ++qd) { const f32x4 g = *(const f32x4*)(p.in[25] + c0 + 4 * qd), gt = *(const f32x4*)(gtf + c0 + 4 * qd); f32x4 x1 = *(const f32x4*)(o + 4 * qd);
        x1.x += gt.x * (a[4 * qd + 0] * rstd * g.x); x1.y += gt.y * (a[4 * qd + 1] * rstd * g.y); x1.z += gt.z * (a[4 * qd + 2] * rstd * g.z); x1.w += gt.w * (a[4 * qd + 3] * rstd * g.w);
        *(f32x4*)(o + 4 * qd) = x1; }
}

__global__ void __launch_bounds__(NTHREADS, 2) mega(Params p) {
    extern __shared__ __attribute__((aligned(16))) unsigned char lds_raw[];
    LAS unsigned char* lds = (LAS unsigned char*)lds_raw;
    volatile LAS unsigned* MISC = (volatile LAS unsigned*)(lds + MISC_OFF);
    const int tid = threadIdx.x, lane = tid & 63, wave = __builtin_amdgcn_readfirstlane(tid >> 6);
    const int G = gridDim.x, bid = blockIdx.x;
    if (tid < 32) MISC[tid] = 0u;
    __syncthreads();
    unsigned* ctl = (unsigned*)(p.ws + WS_CTL);
    XcdBarrier bar = xcd_barrier_post(ctl + CW_BAR + p.li * XCD_BAR_WORDS, MISC + 8);
    const int gw = bid * NWAVES + wave, NGW = G * NWAVES;

    if (RUN(0)) {
    if (bid < 192) p0_mod_item(p, bid, (LAS float*)lds, tid);
    else if (bid < 196) p0_ssm_tables_gp(p, (bid - 192) * NTHREADS + tid);
    else if (bid < 200) { for (int i = 0; i < 32; ++i) p0_ssm_tables_ct(p, ((bid - 196) * NTHREADS + tid) * 32 + i); }
    {
        LAS float* scr = (LAS float*)(lds + wave * 16384);
        for (int it = gw; it < NITEMS_T; it += NGW) p0_convert_item(p, it, scr, lane);
    }
    }
    xcd_barrier(bar);
    if (RUN(1)) for (int m = gw; m < T; m += NGW) p1_row(p, m, lane);
    xcd_barrier(bar);
    if (RUN(2)) {
        pg8::StaticOrder S; S.init(p.ws + WS_ABUF, p.ws + WS_W_IN_T, T, DIN, D, G, bid);
        pg8::EpiVU E{(bf16*)(p.ws + WS_BBUF)};
        pg8::gemm_phase<pg8::EpiVU, pg8::StaticOrder, true>(lds, D, S, E);
    }
    xcd_barrier(bar);
    if (RUN(3)) {
    p3a_items(p, gw, NGW, lane);
    __syncthreads();
    if (!(p.flags & 8)) for (int tile = bid; tile < T / 32; tile += G) p3_conv_tile(p, tile, lds, tid);
    }
    xcd_barrier(bar);
    if (RUN(4) && bid < 8) p3b_carry(p, bid * NTHREADS + tid);
    xcd_barrier(bar);
    if (RUN(5)) for (int c = bid; c < T / 64; c += G) p3c_chunk(p, c, lds, tid);
    xcd_barrier(bar);
    if (RUN(6)) {
        pg8::StaticOrder S; S.init(p.ws + WS_ABUF, p.ws + WS_W_OUT_T, T, D, D, G, bid);
        pg8::EpiBf16Plain E{(bf16*)(p.ws + WS_BBUF), D};
        pg8::gemm_phase<pg8::EpiBf16Plain, pg8::StaticOrder, true>(lds, D, S, E);
    }
    xcd_barrier(bar);
    if (RUN(7)) for (int tile = bid; tile < T / 32; tile += G) p4b_tile(p, tile, lds, tid);
    xcd_barrier(bar);
    if (RUN(8)) {
        const int nl = moe_build_units(p, lds, tid, bid, G, 0);
        pg8::MoeSched S{(const char*)(p.ws + WS_H8), (const char*)(p.ws + WS_WGU_T), lds, nl, D, 0, 1};
        pg8::EpiAct E{p.ws + WS_ACT, 1.0f / 32.0f};
        pg8::gemm_phase<pg8::EpiAct, pg8::MoeSched, true, true, 1>(lds, D, S, E);
    }
    xcd_barrier(bar);
    if (RUN(9)) {
        const int nl = moe_build_units(p, lds, tid, bid, G, 1);
        pg8::MoeSched S{(const char*)(p.ws + WS_ACT), (const char*)(p.ws + WS_WD_T), lds, 2 * nl, DE, 1, 1};
        pg8::EpiDown E{p.ws + WS_WGU_T, (bf16*)(p.ws + WS_ABUF), lds};
        pg8::gemm_phase<pg8::EpiDown, pg8::MoeSched, true, false, 1>(lds, DE, S, E);
    }
    xcd_barrier(bar);
    if (RUN(10)) { int l10 = lane; asm volatile("" : "+v"(l10));
        for (int t = gw; t < T; t += NGW) moe_combine_row(p, t, l10); }
}

extern "C" void kernel_launch(void* const* d_in, const int* in_sizes, int n_in, void* d_out, int out_size, void* d_ws, size_t ws_size, hipStream_t stream) {
    static int grid = 0;
    if (grid == 0) {
        int dev = 0, cus = 0;
        if (n_in != 34 || out_size != T * D || ws_size < WS_END) { grid = -1; return; }
        if (hipGetDevice(&dev) != hipSuccess || hipDeviceGetAttribute(&cus, hipDeviceAttributeMultiprocessorCount, dev) != hipSuccess) { grid = -1; return; }
        if (hipFuncSetAttribute((const void*)mega, hipFuncAttributeMaxDynamicSharedMemorySize, LDS_BYTES) != hipSuccess) { grid = -1; return; }
        (void)hipGetLastError();
        grid = cus;
    }
    if (grid < 0) return;
    (void)hipMemsetAsync((char*)d_ws + WS_CTL, 0, CTL_ZERO_BYTES, stream);
    Params p{};
    for (int i = 0; i < 34; ++i) p.in[i] = (const float*)d_in[i];
    p.out = (float*)d_out; p.ws = (unsigned char*)d_ws; p.ph_lo = 0; p.ph_hi = 99;
    hipLaunchKernelGGL(mega, dim3(grid), dim3(NTHREADS), LDS_BYTES, stream, p);
    if (PROBE_K >= 0 && PROBE_K < 60) { Params q = p; q.ph_lo = PROBE_K; q.ph_hi = PROBE_K + 1; q.li = 1; q.flags = PROBE_FLAGS; hipLaunchKernelGGL(mega, dim3(grid), dim3(NTHREADS), LDS_BYTES, stream, q); }

}
```

```cpp
#include <hip/hip_runtime.h>
#include <cstdio>
#include <cstdint>

#define GAS __attribute__((address_space(1)))
#define LAS __attribute__((address_space(3)))
typedef unsigned short bf16;
typedef unsigned v4u __attribute__((ext_vector_type(4)));
typedef unsigned v2u __attribute__((ext_vector_type(2)));
typedef float f32x4 __attribute__((ext_vector_type(4)));
typedef float f32x2 __attribute__((ext_vector_type(2)));
typedef short bf16x8 __attribute__((ext_vector_type(8)));
typedef int i32x8 __attribute__((ext_vector_type(8)));

constexpr int T = 16384, D = 1024, SEQL = 8192, DIN = 1536, CC = 512, NE = 64, DE = 256;
constexpr float EPS = 1e-6f;
constexpr int NTHREADS = 512, NWAVES = 8;
constexpr int LDS_BYTES = 147456;
constexpr int RING_BYTES = 131072, MISC_OFF = LDS_BYTES - 512;

constexpr size_t MiB = 1u << 20;
constexpr size_t WS_CTL = 0, CTL_ZERO_BYTES = 1 * MiB;
constexpr size_t WS_MOD = 1 * MiB;
constexpr size_t WS_LAM = WS_MOD + 64 * 1024;
constexpr size_t WS_LAM32 = WS_MOD + 80 * 1024;
constexpr size_t WS_BB = WS_MOD + 96 * 1024;
constexpr size_t WS_CT = WS_MOD + 224 * 1024;
constexpr size_t WS_WD_T = 2 * MiB;
constexpr size_t WS_LISTS = 35 * MiB;
constexpr size_t WS_ABUF = 41 * MiB;
constexpr size_t WS_ACT = 73 * MiB;
constexpr size_t WS_WGU_T = 153 * MiB;
constexpr size_t WS_W_IN_T = 218 * MiB;
constexpr size_t WS_W_OUT_T = 221 * MiB;
constexpr size_t WS_W_GLU_T = 223 * MiB;
constexpr size_t WS_W_RT_T = 223 * MiB + 512 * 1024;
constexpr size_t WS_H8 = 190 * MiB;
constexpr size_t WS_E = 224 * MiB;
constexpr size_t WS_SINIT = 232 * MiB;
constexpr size_t WS_BBUF = 240 * MiB;
constexpr size_t WS_END = 281 * MiB;
constexpr size_t WS_NAIVE = 2 * MiB;

constexpr int CW_BAR = 4096;
constexpr int PROBE_K = -1;
constexpr int PROBE_FLAGS = 0;
#define RUN(k) (p.ph_lo <= (k) && (k) < p.ph_hi)
constexpr int CW_CNT = 16384, CNT_STRIDE = 64;
constexpr size_t WS_LIST = WS_LISTS;
constexpr size_t WS_TOPIDX = WS_LISTS + 4 * MiB;
constexpr size_t WS_GATEW = WS_LISTS + 4 * MiB + 512 * 1024;

__device__ __forceinline__ float sigmoidf_(float x) { return 1.0f / (1.0f + __expf(-x)); }
__device__ __forceinline__ float siluf_(float x) { return x * sigmoidf_(x); }
__device__ __forceinline__ float gelu_tanh(float x) {
    const float u = 0.7978845608028654f * (x + 0.044715f * x * x * x);
    return x * __builtin_amdgcn_rcpf(1.0f + __expf(-2.0f * u));
}
__device__ __forceinline__ unsigned pk2(float lo, float hi) { unsigned r; asm("v_cvt_pk_bf16_f32 %0, %1, %2" : "=v"(r) : "v"(lo), "v"(hi)); return r; }
__device__ __forceinline__ unsigned f2bf(float f) { return pk2(f, f) & 0xffffu; }
__device__ __forceinline__ float bf2f(unsigned short b) { return __builtin_bit_cast(float, ((unsigned)b) << 16); }
__device__ __forceinline__ float bflo(unsigned w) { return __builtin_bit_cast(float, w << 16); }
__device__ __forceinline__ float bfhi(unsigned w) { return __builtin_bit_cast(float, w & 0xffff0000u); }
#define LDS_WAIT() asm volatile("s_waitcnt lgkmcnt(0)" ::: "memory")
#define VM_WAIT() asm volatile("s_waitcnt vmcnt(0)" ::: "memory")

__device__ __forceinline__ float wave_sum(float v) {
#pragma unroll
    for (int o = 1; o < 64; o <<= 1) v += __shfl_xor(v, o);
    return v;
}
__device__ __forceinline__ float block_sum(float v, float* red) {
    v = wave_sum(v);
    const int w = threadIdx.x >> 6, nw = blockDim.x >> 6;
    __syncthreads();
    if ((threadIdx.x & 63) == 0) red[w] = v;
    __syncthreads();
    float s = 0.f;
    for (int i = 0; i < nw; ++i) s += red[i];
    return s;
}

#define XB_TMO      128
#define XB_XCNT(j)  (256  + 64 * (j))
#define XB_XSUB(j)  (1280 + 64 * (j))
#define XB_XGEN(j)  (2304 + 64 * (j))
#define XB_TOP      3328
#define XB_TOPGEN   3392
#define XCD_BAR_WORDS 3456
#define XB_SPIN_CAP (1u << 18)
__device__ __forceinline__ unsigned xb_ld(unsigned* p)              { return __hip_atomic_load(p, __ATOMIC_RELAXED, __HIP_MEMORY_SCOPE_AGENT); }
__device__ __forceinline__ unsigned xb_add(unsigned* p, unsigned v) { return __hip_atomic_fetch_add(p, v, __ATOMIC_RELAXED, __HIP_MEMORY_SCOPE_AGENT); }
__device__ __forceinline__ unsigned xb_xcc_id() { return (unsigned)__builtin_amdgcn_s_getreg((3 << 11) | 20) & 0xFu; }
#define XB_SPIN(cond, bar) do { unsigned _sp = 0; while (cond) { __builtin_amdgcn_s_sleep(1); \
    if ((++_sp & 255u) == 0u) { if (xb_ld(&(bar)[XB_TMO])) break; if (_sp > XB_SPIN_CAP) { atomicAdd(&(bar)[XB_TMO], 1u); break; } } } } while (0)
struct XcdBarrier { unsigned* bar; unsigned x; volatile LAS unsigned* st; };
__device__ __forceinline__ XcdBarrier xcd_barrier_post(unsigned* bar, volatile LAS unsigned* st) {
    XcdBarrier b; b.bar = bar; b.x = xb_xcc_id(); b.st = st;
    if (threadIdx.x == 0) (void)xb_add(&bar[XB_XCNT(b.x)], 1u);
    return b;
}
__device__ __forceinline__ void xcd_barrier_complete(unsigned* bar, unsigned x, unsigned& nloc, unsigned& nx) {
    const unsigned G = gridDim.x * gridDim.y * gridDim.z;
    unsigned sum, cnt, mine, sp = 0u;
    for (;;) {
        sum = 0u; cnt = 0u; mine = 0u;
#pragma unroll
        for (unsigned j = 0; j < 16; ++j) { const unsigned c = xb_ld(&bar[XB_XCNT(j)]); sum += c; cnt += (c > 0u) ? 1u : 0u; mine = (j == x) ? c : mine; }
        if (sum == G) break;
        __builtin_amdgcn_s_sleep(1);
        if ((++sp & 255u) == 0u) { if (xb_ld(&bar[XB_TMO])) break; if (sp > XB_SPIN_CAP) { atomicAdd(&bar[XB_TMO], 1u); break; } }
    }
    nloc = mine > 0u ? mine : 1u; nx = cnt > 0u ? cnt : 1u;
}
__device__ __forceinline__ void xcd_barrier(const XcdBarrier& b) {
    asm volatile("s_waitcnt vmcnt(0)" ::: "memory");
    __syncthreads();
    if (threadIdx.x == 0) {
        unsigned* bar = b.bar;
        __builtin_amdgcn_s_waitcnt(0);
        unsigned nloc = b.st[0], nx = b.st[1];
        if (nloc == 0u) { xcd_barrier_complete(bar, b.x, nloc, nx); b.st[0] = nloc; b.st[1] = nx; }
        const unsigned old = xb_add(&bar[XB_XSUB(b.x)], 1u);
        const unsigned gen = old / nloc;
        if (old + 1u == (gen + 1u) * nloc) {
            __builtin_amdgcn_fence(__ATOMIC_RELEASE, "agent");
            asm volatile("s_waitcnt vmcnt(0)" ::: "memory");
            const unsigned og = xb_add(&bar[XB_TOP], 1u);
            const unsigned tg = og / nx;
            if (og + 1u == (tg + 1u) * nx) xb_add(&bar[XB_TOPGEN], 1u);
            else XB_SPIN(xb_ld(&bar[XB_TOPGEN]) == tg, bar);
            __builtin_amdgcn_fence(__ATOMIC_ACQUIRE, "agent");
            xb_add(&bar[XB_XGEN(b.x)], 1u);
            asm volatile("s_waitcnt vmcnt(0)" ::: "memory");
        } else {
            XB_SPIN(xb_ld(&bar[XB_XGEN(b.x)]) == gen, bar);
            __builtin_amdgcn_fence(__ATOMIC_ACQUIRE, "agent");
            asm volatile("s_waitcnt vmcnt(0)" ::: "memory");
        }
    }
    __syncthreads();
}

namespace pg8 {
#define PG8_LAS __attribute__((address_space(3)))
constexpr int BM = 256, BK = 64, HALF = 128, HTB = HALF * BK * 2, STAGE_BYTES = 8 * HTB, NXCD = 8, WGM = 8;
__host__ __device__ __forceinline__ int lds_byte(int r, int c) { const int st = (r >> 4) * 2 + (c >> 5), rr = r & 15, cc = c & 31, ob = rr * 64 + cc * 2; return st * 1024 + (ob ^ (((ob >> 9) & 1) << 5)); }
__host__ __device__ __forceinline__ void stage_rc(int b, int& R, int& C) { const int st = b / 1024, sb = b % 1024, swz = sb ^ (((sb >> 9) & 1) << 5); R = (st >> 1) * 16 + swz / 64; C = (st & 1) * 32 + (swz % 64) / 2; }
__host__ __device__ __forceinline__ int perm32(int rho) { const int n = rho >> 4, i = rho & 15; return 8 * (i >> 2) + 4 * n + (i & 3); }

struct Unit { const char* A; const char* B; int pm, pn, e, nvalid, slot; };

struct StaticOrder {
    const char* A; const char* B; int K;
    int nM, nN, nwg, G, c;
    __device__ void init(const void* A_, const void* B_, int M, int N, int K_, int G_, int c_) { A = (const char*)A_; B = (const char*)B_; K = K_; nM = M / BM; nN = N / BM; nwg = nM * nN; G = G_; c = c_; }
    __device__ bool next(int i, Unit& u) const {
        const long L = (long)i * G + c; if (L >= nwg) return false;
        int wgid = (int)L; { const int q = nwg / NXCD, r = nwg % NXCD, xcd = wgid % NXCD, off = wgid / NXCD; wgid = (xcd < r ? xcd * (q + 1) : r * (q + 1) + (xcd - r) * q) + off; }
        const int nig = WGM * nN, gid = wgid / nig, fm = gid * WGM, gsz = (nM - fm) < WGM ? (nM - fm) : WGM;
        u.pm = fm + ((wgid % nig) % gsz); u.pn = (wgid % nig) / gsz; u.e = 0; u.nvalid = BM; u.slot = 0;
        u.A = A + (size_t)u.pm * BM * K * 2; u.B = B + (size_t)u.pn * BM * K * 2; return true;
    }
    __device__ const PG8_LAS int* rowsA(int) const { return nullptr; }
};

__device__ __forceinline__ unsigned cvt_pk_bf16(float lo, float hi) { unsigned r; asm volatile("v_cvt_pk_bf16_f32 %0, %1, %2" : "=v"(r) : "v"(lo), "v"(hi)); return r; }

__device__ __forceinline__ f32x4 mma_bf16(v4u b, v4u a, f32x4 c) { return __builtin_amdgcn_mfma_f32_16x16x32_bf16(__builtin_bit_cast(bf16x8, b), __builtin_bit_cast(bf16x8, a), c, 0, 0, 0); }
__device__ __forceinline__ f32x4 mma_fp8(i32x8 B, i32x8 A, f32x4 c) {
    return __builtin_amdgcn_mfma_scale_f32_16x16x128_f8f6f4(B, A, c, 0, 0, 0, 0x7f7f7f7f, 0, 0x7f7f7f7f);
}
typedef int i32x4 __attribute__((ext_vector_type(4)));
template <class Epi, class Sched, bool ALIGN_EPI, bool GATHER = false, int ESZ = 2>
__device__ __forceinline__ void gemm_phase(PG8_LAS unsigned char* lds, const int K, const Sched& S, const Epi& E) {
    const int tid = threadIdx.x, wid = __builtin_amdgcn_readfirstlane(tid >> 6), lane = tid & 63, wr = wid >> 2, wc = wid & 3, fr = lane & 15, fq = lane >> 4;
    const int rb = K * ESZ; int nt = rb / (BK * 2);
    asm volatile("" : "+s"(nt));
    unsigned voffB[2]; int RA[2], CA[2];
#pragma unroll
    for (int i = 0; i < 2; ++i) { int R, C; stage_rc(tid * 16 + i * 8192, R, C); const int Rb = Epi::PERM ? ((R & ~31) + perm32(R & 31)) : R;
        RA[i] = R; CA[i] = C; voffB[i] = (unsigned)(Rb * rb + C * 2); }
    unsigned cvA0[2], cvA1[2];
#define PG8_SETVA(v0, v1, ui_) do { _Pragma("unroll") for (int _i = 0; _i < 2; ++_i) { \
        v0[_i] = (unsigned)(RA[_i] * rb + CA[_i] * 2); v1[_i] = (unsigned)((HALF + RA[_i]) * rb + CA[_i] * 2); } } while (0)
#define PG8_GVA(v, ui_, h_) do { int _t = threadIdx.x; asm volatile("" : "+v"(_t)); const PG8_LAS int* _rows = S.rowsA(ui_); _Pragma("unroll") for (int _i = 0; _i < 2; ++_i) { int _R, _C; stage_rc(_t * 16 + _i * 8192, _R, _C); \
        v[_i] = (unsigned)(_rows[(h_) * HALF + _R] * rb + _C * 2); } } while (0)
    const size_t kstep = (size_t)(BK * 2);
    const size_t hstep = (size_t)HALF * rb;
    const unsigned ldsw = (unsigned)wid * 1024u;
    const int aoff0 = lds_byte(wr * 64 + fr, ESZ == 2 ? fq * 8 : fq * 16), boff0 = lds_byte(wc * 32 + fr, ESZ == 2 ? fq * 8 : fq * 16);
    constexpr int CH1 = ESZ == 2 ? 1024 : 16;
#define PG8_SA(b, h) (((b) * 2 + (h)) * HTB)
#define PG8_SB(b, h) ((4 + (b) * 2 + (h)) * HTB)
#define PG8_STAGE(bufoff, gbase, voff) do { const char* _g = (const char*)(gbase); asm volatile("" : "+s"(_g));     \
        _Pragma("unroll") for (int _i = 0; _i < 2; ++_i) { unsigned _vo = (voff)[_i]; asm volatile("" : "+v"(_vo)); \
        __builtin_amdgcn_global_load_lds((const unsigned*)(_g + _vo), (PG8_LAS unsigned*)(lds + (bufoff) + ldsw + _i * 8192), 16, 0, 0); } } while (0)
#define PG8_LDF(lo_, hi_) __builtin_shufflevector(__builtin_bit_cast(i32x4, *(const PG8_LAS v4u*)(lo_)), __builtin_bit_cast(i32x4, *(const PG8_LAS v4u*)(hi_)), 0, 1, 2, 3, 4, 5, 6, 7)
#define PG8_LDA(dst, b, h) do { _Pragma("unroll") for (int m = 0; m < 4; ++m) dst[m] = PG8_LDF(lds + PG8_SA(b, h) + aoff0 + m * 2048, lds + PG8_SA(b, h) + aoff0 + m * 2048 + CH1); } while (0)
#define PG8_LDB(dst, b, h) do { _Pragma("unroll") for (int n = 0; n < 2; ++n) dst[n] = PG8_LDF(lds + PG8_SB(b, h) + boff0 + n * 2048, lds + PG8_SB(b, h) + boff0 + n * 2048 + CH1); } while (0)
#define PG8_LO(x) __builtin_bit_cast(v4u, __builtin_shufflevector(x, x, 0, 1, 2, 3))
#define PG8_HI(x) __builtin_bit_cast(v4u, __builtin_shufflevector(x, x, 4, 5, 6, 7))
#define PG8_MMA(ai, bj, At, Bt) do { __builtin_amdgcn_s_setprio(1); _Pragma("unroll") for (int m = 0; m < 4; ++m) _Pragma("unroll") for (int n = 0; n < 2; ++n) { \
        if constexpr (ESZ == 2) { acc[ai][bj][m][n] = mma_bf16(PG8_LO(Bt[n]), PG8_LO(At[m]), acc[ai][bj][m][n]); acc[ai][bj][m][n] = mma_bf16(PG8_HI(Bt[n]), PG8_HI(At[m]), acc[ai][bj][m][n]); } \
        else acc[ai][bj][m][n] = mma_fp8(Bt[n], At[m], acc[ai][bj][m][n]); } __builtin_amdgcn_s_setprio(0); } while (0)
#define PG8_WAIT_V(n) asm volatile("s_waitcnt vmcnt(" #n ")" ::: "memory")
#define PG8_WAIT_L(n) asm volatile("s_waitcnt lgkmcnt(" #n ")" ::: "memory")
#define PG8_BAR __builtin_amdgcn_s_barrier()
#define PG8_SCHED __builtin_amdgcn_sched_barrier(0)
    Unit cur, nxt; int ui = 0;
    if (!S.next(0, cur)) return;
    f32x4 acc[2][2][4][2];
#pragma unroll
    for (int a = 0; a < 2; ++a)
#pragma unroll
        for (int b = 0; b < 2; ++b)
#pragma unroll
            for (int m = 0; m < 4; ++m)
#pragma unroll
                for (int n = 0; n < 2; ++n) acc[a][b][m][n] = (f32x4){0.f, 0.f, 0.f, 0.f};
    i32x8 At[4], B0[2], B1[2];
    const char* cA = cur.A; const char* cB = cur.B;
    if constexpr (!GATHER) PG8_SETVA(cvA0, cvA1, 0);
#define PG8_STAGE_A(bufoff, gbase, h_, ui_) do { if constexpr (GATHER) { unsigned _v[2]; PG8_GVA(_v, ui_, h_); PG8_STAGE(bufoff, gbase, _v); } else { if ((h_) == 0) PG8_STAGE(bufoff, gbase, cvA0); else PG8_STAGE(bufoff, gbase, cvA1); } } while (0)
    PG8_STAGE(PG8_SB(0, 0), cB, voffB); PG8_STAGE(PG8_SB(0, 1), cB + hstep, voffB); PG8_STAGE_A(PG8_SA(0, 0), cA, 0, 0); PG8_STAGE_A(PG8_SA(0, 1), cA, 1, 0);
    if (wr == 1) PG8_BAR;
    PG8_WAIT_V(2); PG8_BAR;
    PG8_STAGE(PG8_SB(1, 0), cB + kstep, voffB); PG8_STAGE_A(PG8_SA(1, 0), cA + kstep, 0, 0); PG8_STAGE(PG8_SB(1, 1), cB + hstep + kstep, voffB);
    PG8_WAIT_V(6); PG8_BAR;
    for (;;) {
        const bool has_next = S.next(ui + 1, nxt);
        const char* nA = has_next ? nxt.A : cA; const char* nB = has_next ? nxt.B : cB;
#pragma unroll 1
        for (int t = 0; t < nt; t += 2) {
            const bool last = (t == nt - 2);
            const char* a1 = cA + (size_t)(t + 1) * kstep;
            const char* a2 = last ? nA : cA + (size_t)(t + 2) * kstep; const char* b2 = last ? nB : cB + (size_t)(t + 2) * kstep;
            const char* a3 = a2 + kstep; const char* b3 = b2 + kstep;
            const int un = (last && has_next) ? ui + 1 : ui;
            PG8_LDB(B0, 0, 0); PG8_LDB(B1, 0, 1); PG8_SCHED; PG8_LDA(At, 0, 0); PG8_STAGE_A(PG8_SA(1, 1), a1, 1, ui);
            PG8_WAIT_V(8); PG8_WAIT_L(0); PG8_BAR; PG8_MMA(0, 0, At, B0); PG8_MMA(0, 1, At, B1); PG8_BAR; PG8_SCHED;
            PG8_LDA(At, 0, 1); PG8_STAGE(PG8_SB(0, 0), b2, voffB); PG8_STAGE(PG8_SB(0, 1), b2 + hstep, voffB); PG8_STAGE_A(PG8_SA(0, 0), a2, 0, un);
            PG8_WAIT_V(8); PG8_WAIT_L(0); PG8_BAR; PG8_MMA(1, 0, At, B0); PG8_MMA(1, 1, At, B1); PG8_BAR; PG8_SCHED;
            PG8_LDB(B0, 1, 0); PG8_LDB(B1, 1, 1); PG8_SCHED; PG8_LDA(At, 1, 0); PG8_STAGE_A(PG8_SA(0, 1), a2, 1, un);
            PG8_WAIT_V(8); PG8_WAIT_L(0); PG8_BAR; PG8_MMA(0, 0, At, B0); PG8_MMA(0, 1, At, B1); PG8_BAR; PG8_SCHED;
            PG8_LDA(At, 1, 1); PG8_STAGE(PG8_SB(1, 0), b3, voffB); PG8_STAGE(PG8_SB(1, 1), b3 + hstep, voffB); PG8_STAGE_A(PG8_SA(1, 0), a3, 0, un);
            PG8_WAIT_V(8); PG8_WAIT_L(0); PG8_BAR; PG8_MMA(1, 0, At, B0); PG8_MMA(1, 1, At, B1); PG8_BAR; PG8_SCHED;
        }
        if constexpr (ALIGN_EPI) { if (wr == 0) PG8_BAR; }
        PG8_SCHED; asm volatile("s_nop 15\n\ts_nop 15"); PG8_SCHED;
        E(acc, cur, wr, wc, fr, fq);
        if (!has_next) break;
#pragma unroll
        for (int a = 0; a < 2; ++a)
#pragma unroll
            for (int b = 0; b < 2; ++b)
#pragma unroll
                for (int m = 0; m < 4; ++m)
#pragma unroll
                    for (int n = 0; n < 2; ++n) acc[a][b][m][n] = (f32x4){0.f, 0.f, 0.f, 0.f};
        cur = nxt; cA = nA; cB = nB; ++ui;
        if constexpr (ALIGN_EPI) { if (wr == 1) PG8_BAR; }
    }
    PG8_WAIT_V(0);
    if constexpr (!ALIGN_EPI) { if (wr == 0) PG8_BAR; }
    PG8_BAR;
#undef PG8_SETVA
#undef PG8_GVA
#undef PG8_STAGE_A
#undef PG8_SA
#undef PG8_SB
#undef PG8_STAGE
#undef PG8_LDA
#undef PG8_LDF
#undef PG8_LO
#undef PG8_HI
#undef PG8_LDB
#undef PG8_MMA
#undef PG8_WAIT_V
#undef PG8_WAIT_L
#undef PG8_BAR
#undef PG8_SCHED
}

struct EpiVU {
    static constexpr bool PERM = true;
    bf16* vu;
    __device__ __forceinline__ void operator()(const f32x4 (&acc)[2][2][4][2], const Unit& u, int wr, int wc, int fr, int fq) const {
        const int row0 = u.pm * BM + wr * 64 + fr, cw = wc * 32 + 8 * fq;
#pragma unroll
        for (int ai = 0; ai < 2; ++ai)
#pragma unroll
            for (int m = 0; m < 4; ++m) { bf16* rowp = vu + (size_t)(row0 + ai * HALF + m * 16) * D;
                if (u.pn < 4) {
                    f32x4 a0 = acc[ai][0][m][0], a1 = acc[ai][0][m][1]; const f32x4 g0 = acc[ai][1][m][0], g1 = acc[ai][1][m][1];
#pragma unroll
                    for (int j = 0; j < 4; ++j) { a0[j] *= sigmoidf_(g0[j]); a1[j] *= sigmoidf_(g1[j]); }
                    v4u w; w.x = cvt_pk_bf16(a0[0], a0[1]); w.y = cvt_pk_bf16(a0[2], a0[3]); w.z = cvt_pk_bf16(a1[0], a1[1]); w.w = cvt_pk_bf16(a1[2], a1[3]);
                    *(v4u*)(rowp + u.pn * 128 + cw) = w;
                } else {
#pragma unroll
                    for (int bj = 0; bj < 2; ++bj) { const f32x4 v0 = acc[ai][bj][m][0], v1 = acc[ai][bj][m][1];
                        v4u w; w.x = cvt_pk_bf16(v0[0], v0[1]); w.y = cvt_pk_bf16(v0[2], v0[3]); w.z = cvt_pk_bf16(v1[0], v1[1]); w.w = cvt_pk_bf16(v1[2], v1[3]);
                        *(v4u*)(rowp + 512 + (u.pn - 4) * 256 + bj * HALF + cw) = w; }
                }
            }
    }
};
struct EpiBf16Plain {
    static constexpr bool PERM = true;
    bf16* O; int ldc;
    __device__ __forceinline__ void operator()(const f32x4 (&acc)[2][2][4][2], const Unit& u, int wr, int wc, int fr, int fq) const {
        const int row0 = u.pm * BM + wr * 64 + fr, col0 = u.pn * BM + wc * 32 + 8 * fq;
#pragma unroll
        for (int ai = 0; ai < 2; ++ai)
#pragma unroll
            for (int m = 0; m < 4; ++m) { bf16* rowp = O + (size_t)(row0 + ai * HALF + m * 16) * ldc + col0;
#pragma unroll
                for (int bj = 0; bj < 2; ++bj) { const f32x4 v0 = acc[ai][bj][m][0], v1 = acc[ai][bj][m][1];
                    v4u w; w.x = cvt_pk_bf16(v0[0], v0[1]); w.y = cvt_pk_bf16(v0[2], v0[3]); w.z = cvt_pk_bf16(v1[0], v1[1]); w.w = cvt_pk_bf16(v1[2], v1[3]);
                    *(v4u*)(rowp + bj * HALF) = w; } }
    }
};

constexpr int MOE_TP_OFF = 131072, MOE_DESC_OFF = 131072 + 512, MOE_ROWS_OFF = 131072 + 1024, MOE_MAX_UNITS = 6, MOE_W_OFF = MOE_ROWS_OFF + MOE_MAX_UNITS * 1024;
struct MoeSched {
    const char* Abase; const char* Bbase; PG8_LAS unsigned char* lds; int nlocal, K, mode, esz;
    __device__ bool next(int i, Unit& u) const {
        if (i >= nlocal) return false;
        const int it = mode == 0 ? i : (i >> 1);
        const PG8_LAS int* d = (const PG8_LAS int*)(lds + MOE_DESC_OFF) + it * 8;
        u.e = __builtin_amdgcn_readfirstlane(d[0]); u.pm = __builtin_amdgcn_readfirstlane(d[1]); u.pn = __builtin_amdgcn_readfirstlane(d[2]); u.nvalid = __builtin_amdgcn_readfirstlane(d[3]); u.slot = it;
        if (mode == 0) { u.A = Abase; u.B = Bbase + ((size_t)u.e * 512 + (size_t)u.pn * 256) * 1024 * esz; }
        else { u.pn = 2 * u.pn + (i & 1); u.A = Abase + (size_t)u.pm * 256 * 256 * esz; u.B = Bbase + ((size_t)u.e * 1024 + (size_t)u.pn * 256) * 256 * esz; }
        return true;
    }
    __device__ const PG8_LAS int* rowsA(int i) const { return (const PG8_LAS int*)(lds + MOE_ROWS_OFF) + i * 256; }
};
struct EpiAct {
    static constexpr bool PERM = true;
    unsigned char* act8; float isc;
    __device__ __forceinline__ void operator()(const f32x4 (&acc)[2][2][4][2], const Unit& u, int wr, int wc, int fr, int fq) const {
        const size_t row0 = (size_t)u.pm * BM + wr * 64 + fr; const int col0 = u.pn * 128 + wc * 32 + 8 * fq;
#pragma unroll
        for (int ai = 0; ai < 2; ++ai)
#pragma unroll
            for (int m = 0; m < 4; ++m) {
                float a[8];
#pragma unroll
                for (int j = 0; j < 8; ++j) { const float g = acc[ai][0][m][j >> 2][j & 3] * isc, uu = acc[ai][1][m][j >> 2][j & 3] * (8.0f * isc);
                    a[j] = g * __builtin_amdgcn_rcpf(1.0f + __expf(-g)) * uu; }
                int lo = __builtin_amdgcn_cvt_pk_fp8_f32(a[0], a[1], 0, false); lo = __builtin_amdgcn_cvt_pk_fp8_f32(a[2], a[3], lo, true);
                int hi = __builtin_amdgcn_cvt_pk_fp8_f32(a[4], a[5], 0, false); hi = __builtin_amdgcn_cvt_pk_fp8_f32(a[6], a[7], hi, true);
                *(v2u*)(act8 + (row0 + ai * HALF + m * 16) * 256 + col0) = (v2u){(unsigned)lo, (unsigned)hi};
                asm volatile("" ::: "memory");
            }
    }
};
struct EpiDown {
    static constexpr bool PERM = true;
    unsigned char* yk8; bf16* ycomb; PG8_LAS unsigned char* lds;
    __device__ __forceinline__ void operator()(const f32x4 (&acc)[2][2][4][2], const Unit& u, int wr_, int wc_, int fr_, int fq_) const {
        int t_ = threadIdx.x; asm volatile("" : "+v"(t_));
        const int fr = t_ & 15, fq = (t_ >> 4) & 3, wc = (t_ >> 6) & 3, wr = t_ >> 8;
        const PG8_LAS int* rows = (const PG8_LAS int*)(lds + MOE_ROWS_OFF) + u.slot * 256;
        const PG8_LAS float* wts = (const PG8_LAS float*)(lds + MOE_W_OFF) + u.slot * 256;
        const int col = u.pn * 256 + wc * 32 + 8 * fq;
#pragma unroll
        for (int ai = 0; ai < 2; ++ai)
#pragma unroll
            for (int m = 0; m < 4; ++m) {
                const int id = rows[ai * HALF + wr * 64 + m * 16 + fr];
                if (id >= 0) {
                    if (u.e < 64) {
                        const float w = wts[ai * HALF + wr * 64 + m * 16 + fr] * (16.0f / 128.0f);
                        unsigned char* dst = yk8 + ((unsigned)id * 1024u + (unsigned)col);
#pragma unroll
                        for (int bj = 0; bj < 2; ++bj) { const f32x4 v0 = acc[ai][bj][m][0] * w, v1 = acc[ai][bj][m][1] * w;
                            int lo = __builtin_amdgcn_cvt_pk_fp8_f32(v0[0], v0[1], 0, false); lo = __builtin_amdgcn_cvt_pk_fp8_f32(v0[2], v0[3], lo, true);
                            int hi = __builtin_amdgcn_cvt_pk_fp8_f32(v1[0], v1[1], 0, false); hi = __builtin_amdgcn_cvt_pk_fp8_f32(v1[2], v1[3], hi, true);
                            *(v2u*)(dst + bj * HALF) = (v2u){(unsigned)lo, (unsigned)hi}; }
                    } else {
                        bf16* dst = ycomb + ((unsigned)id * 1024u + (unsigned)col);
#pragma unroll
                        for (int bj = 0; bj < 2; ++bj) { const f32x4 v0 = acc[ai][bj][m][0] * (1.0f / 128.0f), v1 = acc[ai][bj][m][1] * (1.0f / 128.0f);
                            v4u o; o.x = cvt_pk_bf16(v0[0], v0[1]); o.y = cvt_pk_bf16(v0[2], v0[3]); o.z = cvt_pk_bf16(v1[0], v1[1]); o.w = cvt_pk_bf16(v1[2], v1[3]);
                            *(v4u*)(dst + bj * HALF) = o; }
                    }
                }
            }
    }
};
}

struct Params {
    const float* in[34];
    float* out;
    unsigned char* ws;
    int ph_lo, ph_hi, li, flags;
};

__device__ __forceinline__ void transpose_item(const float* W, int ldw, bf16* WT, int ldt, LAS float* scr, int lane) {
#pragma unroll 8
    for (int i = 0; i < 32; ++i) { const int kk = 2 * i + (lane >> 5); scr[kk * 33 + (lane & 31)] = W[(size_t)kk * ldw + (lane & 31)]; }
    LDS_WAIT(); asm volatile("" ::: "memory");
    const int c = lane & 7;
#pragma unroll
    for (int j = 0; j < 4; ++j) { const int n = (lane >> 3) + 8 * j; const LAS float* s = scr + (8 * c) * 33 + n;
        v4u o; o.x = pk2(s[0 * 33], s[1 * 33]); o.y = pk2(s[2 * 33], s[3 * 33]); o.z = pk2(s[4 * 33], s[5 * 33]); o.w = pk2(s[6 * 33], s[7 * 33]);
        *(GAS v4u*)(WT + (size_t)n * ldt + 8 * c) = o; }
    LDS_WAIT(); asm volatile("" ::: "memory");
}

__device__ __forceinline__ void transpose_item_glu(const float* W, int k0, int n0, bf16* WF, LAS float* scr, int lane) {
#pragma unroll 8
    for (int i = 0; i < 32; ++i) { const int kk = 2 * i + (lane >> 5); scr[kk * 33 + (lane & 31)] = W[(size_t)(k0 + kk) * CC + n0 + (lane & 31)]; }
    LDS_WAIT(); asm volatile("" ::: "memory");
    const int c = lane & 7;
#pragma unroll
    for (int j = 0; j < 4; ++j) { const int nl = (lane >> 3) + 8 * j; const LAS float* s = scr + (8 * c) * 33 + nl;
        v4u o; o.x = pk2(s[0 * 33], s[1 * 33]); o.y = pk2(s[2 * 33], s[3 * 33]); o.z = pk2(s[4 * 33], s[5 * 33]); o.w = pk2(s[6 * 33], s[7 * 33]);
        const int n = n0 + nl, k = k0 + 8 * c;
        const int blk = (((n >> 6) * 16 + (k >> 5)) * 4 + ((n >> 4) & 3)), ln = ((k >> 3) & 3) * 16 + (n & 15);
        *(GAS v4u*)(WF + (size_t)blk * 512 + ln * 8) = o; }
    LDS_WAIT(); asm volatile("" ::: "memory");
}

__device__ __forceinline__ void transpose_item8(const float* W, int ldw, unsigned char* WT8, int ldt, float sc, LAS float* scr, int lane) {
#pragma unroll 8
    for (int i = 0; i < 32; ++i) { const int kk = 2 * i + (lane >> 5); scr[kk * 33 + (lane & 31)] = W[(size_t)kk * ldw + (lane & 31)]; }
    LDS_WAIT(); asm volatile("" ::: "memory");
    const int n = lane >> 1, h = lane & 1;
    const LAS float* s = scr + (32 * h) * 33 + n;
    unsigned w[8];
#pragma unroll
    for (int d = 0; d < 8; ++d) { int v = __builtin_amdgcn_cvt_pk_fp8_f32(s[(4 * d) * 33] * sc, s[(4 * d + 1) * 33] * sc, 0, false);
        v = __builtin_amdgcn_cvt_pk_fp8_f32(s[(4 * d + 2) * 33] * sc, s[(4 * d + 3) * 33] * sc, v, true); w[d] = (unsigned)v; }
    *(GAS v4u*)(WT8 + (size_t)n * ldt + 32 * h) = (v4u){w[0], w[1], w[2], w[3]};
    *(GAS v4u*)(WT8 + (size_t)n * ldt + 32 * h + 16) = (v4u){w[4], w[5], w[6], w[7]};
    LDS_WAIT(); asm volatile("" ::: "memory");
}
constexpr int IT_EG = 64 * 128, IT_EU = 64 * 128, IT_ED = 64 * 128, IT_SG = 128, IT_SU = 128, IT_SD = 128, IT_IN = 16 * 48, IT_OUT = 16 * 32, IT_GLU = 8 * 16, IT_RT = 16 * 2;
constexpr int NITEMS_T = IT_EG + IT_EU + IT_ED + IT_SG + IT_SU + IT_SD + IT_IN + IT_OUT + IT_GLU + IT_RT;

__device__ __forceinline__ void p0_convert_item(const Params& p, int it, LAS float* scr, int lane) {
    unsigned char* ws = p.ws;
    bf16* Wgu = (bf16*)(ws + WS_WGU_T); bf16* Wd = (bf16*)(ws + WS_WD_T);
    int r = it;
    if (r < IT_EG + IT_EU) {
        const int up = r >= IT_EG; if (up) r -= IT_EG;
        const int e = r >> 7, q = r & 127, kb = q >> 3, nb = q & 7, k0 = 64 * kb, n0 = 32 * nb;
        const float* src = (up ? p.in[29] : p.in[28]) + (size_t)e * D * DE + (size_t)k0 * DE + n0;
        const int drow = 256 * (n0 >> 7) + (n0 & 127) + (up ? 128 : 0);
        transpose_item8(src, DE, (unsigned char*)Wgu + (size_t)e * 512 * D + (size_t)drow * D + k0, D, 32.0f, scr, lane); return; }
    r -= IT_EG + IT_EU;
    if (r < IT_ED) {
        const int e = r >> 7, q = r & 127, kb = q >> 5, nb = q & 31, k0 = 64 * kb, n0 = 32 * nb;
        transpose_item8(p.in[30] + (size_t)e * DE * D + (size_t)k0 * D + n0, D, (unsigned char*)Wd + (size_t)e * D * DE + (size_t)n0 * DE + k0, DE, 16.0f, scr, lane); return; }
    r -= IT_ED;
    if (r < IT_SG + IT_SU) {
        const int up = r >= IT_SG; if (up) r -= IT_SG;
        const int kb = r >> 3, nb = r & 7, k0 = 64 * kb, n0 = 32 * nb;
        const float* src = (up ? p.in[32] : p.in[31]) + (size_t)k0 * DE + n0;
        const int drow = 256 * (n0 >> 7) + (n0 & 127) + (up ? 128 : 0);
        transpose_item8(src, DE, (unsigned char*)Wgu + (size_t)64 * 512 * D + (size_t)drow * D + k0, D, 32.0f, scr, lane); return; }
    r -= IT_SG + IT_SU;
    if (r < IT_SD) { const int kb = r >> 5, nb = r & 31, k0 = 64 * kb, n0 = 32 * nb;
        transpose_item8(p.in[33] + (size_t)k0 * D + n0, D, (unsigned char*)Wd + (size_t)64 * D * DE + (size_t)n0 * DE + k0, DE, 16.0f, scr, lane); return; }
    r -= IT_SD;
    if (r < IT_IN) { const int kb = r / 48, nb = r % 48, k0 = 64 * kb, n0 = 32 * nb;
        int drow; if (n0 < 512) drow = 256 * (n0 >> 7) + (n0 & 127); else if (n0 < 1024) { const int c = n0 - 512; drow = 256 * (c >> 7) + 128 + (c & 127); } else drow = n0;
        transpose_item(p.in[6] + (size_t)k0 * DIN + n0, DIN, (bf16*)(ws + WS_W_IN_T) + (size_t)drow * D + k0, D, scr, lane); return; }
    r -= IT_IN;
    if (r < IT_OUT) { const int kb = r >> 5, nb = r & 31, k0 = 64 * kb, n0 = 32 * nb;
        transpose_item(p.in[23] + (size_t)k0 * D + n0, D, (bf16*)(ws + WS_W_OUT_T) + (size_t)n0 * D + k0, D, scr, lane); return; }
    r -= IT_OUT;
    if (r < IT_GLU) { const int kb = r >> 4, nb = r & 15, k0 = 64 * kb, n0 = 32 * nb;
        transpose_item_glu(p.in[19], k0, n0, (bf16*)(ws + WS_W_GLU_T), scr, lane); return; }
    r -= IT_GLU;
    { const int kb = r >> 1, nb = r & 1, k0 = 64 * kb, n0 = 32 * nb;
      transpose_item(p.in[26] + (size_t)k0 * NE + n0, NE, (bf16*)(ws + WS_W_RT_T) + (size_t)n0 * D + k0, D, scr, lane); }
}

__device__ __forceinline__ void p0_mod_item(const Params& p, int item, LAS float* red, int tid) {
    const int cg = tid & 7, kr = tid >> 3, j0 = item * 32 + cg * 4;
    const float* c = p.in[1]; const float* w = p.in[2];
    f32x4 a0 = {0.f, 0.f, 0.f, 0.f}, a1 = {0.f, 0.f, 0.f, 0.f};
#pragma unroll 4
    for (int ps = 0; ps < 16; ++ps) { const int k = ps * 64 + kr;
        const f32x4 w4 = *(const f32x4*)(w + (size_t)k * 6 * D + j0);
        const float s0 = siluf_(c[k]), s1 = siluf_(c[D + k]);
        a0 += w4 * s0; a1 += w4 * s1; }
    LAS float* my = red + (kr * 8 + cg) * 8;
    my[0] = a0[0]; my[1] = a0[1]; my[2] = a0[2]; my[3] = a0[3]; my[4] = a1[0]; my[5] = a1[1]; my[6] = a1[2]; my[7] = a1[3];
    __syncthreads();
    if (tid < 64) { const int g = tid >> 3, q = tid & 7; float s = 0.f;
        for (int k2 = 0; k2 < 64; ++k2) s += red[(k2 * 8 + g) * 8 + q];
        const int b = q >> 2, j = item * 32 + g * 4 + (q & 3);
        ((float*)(p.ws + WS_MOD))[b * 6 * D + j] = s + p.in[3][j]; }
    __syncthreads();
}

__device__ __forceinline__ void p1_row(const Params& p, int m, int lane) {
    const int b = m / SEQL;
    const float* mod = (const float*)(p.ws + WS_MOD) + b * 6 * D;
    const GAS f32x4* xr = (const GAS f32x4*)(p.in[0] + (size_t)m * D) + lane;
    f32x4 v[4]; float s = 0.f;
#pragma unroll
    for (int j = 0; j < 4; ++j) { v[j] = xr[64 * j]; s += (v[j].x * v[j].x + v[j].y * v[j].y) + (v[j].z * v[j].z + v[j].w * v[j].w); }
    const float rstd = rsqrtf(wave_sum(s) * (1.f / D) + EPS);
    GAS unsigned long long* o8 = (GAS unsigned long long*)((bf16*)(p.ws + WS_ABUF) + (size_t)m * D) + lane;
#pragma unroll
    for (int j = 0; j < 4; ++j) { const int n = 4 * lane + 256 * j;
        const f32x4 g = *(const f32x4*)(p.in[4] + n), sc = *(const f32x4*)(mod + D + n), sh = *(const f32x4*)(mod + n);
        const f32x4 o = v[j] * rstd * g * (sc + 1.0f) + sh;
        o8[64 * j] = (unsigned long long)pk2(o.x, o.y) | ((unsigned long long)pk2(o.z, o.w) << 32); }
}

typedef float f32x16 __attribute__((ext_vector_type(16)));
__device__ __forceinline__ void p0_ssm_tables_gp(const Params& p, int q  ) {
    const int g = q >> 6;
    const double ar = p.in[11][q], ai = p.in[12][q], dt = exp((double)p.in[13][g]);
    const double mag = exp(ar * dt), lr = mag * cos(ai * dt), li = mag * sin(ai * dt);
    const double den = ar * ar + ai * ai, nr = lr - 1.0;
    const double kr = (nr * ar + li * ai) / den, ki = (li * ar - nr * ai) / den;
    ((f32x2*)(p.ws + WS_LAM))[q] = (f32x2){(float)lr, (float)li};
    double pr = lr, pi = li;
#pragma unroll
    for (int s = 0; s < 5; ++s) { const double nr2 = pr * pr - pi * pi, ni2 = 2.0 * pr * pi; pr = nr2; pi = ni2; }
    ((f32x2*)(p.ws + WS_LAM32))[q] = (f32x2){(float)pr, (float)pi};
    bf16* Bb = (bf16*)(p.ws + WS_BB);
    const int pp = q & 63;
    for (int h = 0; h < 16; ++h) { const double br = p.in[14][q * 16 + h], bi = p.in[15][q * 16 + h];
        Bb[((g * 2 + 0) * 64 + pp) * 16 + h] = (bf16)f2bf((float)(kr * br - ki * bi));
        Bb[((g * 2 + 1) * 64 + pp) * 16 + h] = (bf16)f2bf((float)(kr * bi + ki * br)); }
}
__device__ __forceinline__ void p0_ssm_tables_ct(const Params& p, int idx  ) {
    const int k = idx & 127, gh = idx >> 7;
    const float v = (k < 64) ? p.in[16][gh * 64 + k] : -p.in[17][gh * 64 + (k - 64)];
    ((bf16*)(p.ws + WS_CT))[idx] = (bf16)f2bf(v);
}

__device__ __forceinline__ bf16x8 ssm_load_u(const bf16* vu, int tokA, int tokB, int g, int lane) {
    const int i = lane & 31, kh = lane >> 5;
    const int hf = (i >> 2) & 1, r = (i & 3) + 4 * (i >> 3);
    const int tok = (hf ? tokB : tokA) + r;
    return *(const bf16x8*)(vu + (size_t)tok * D + CC + g * 16 + 8 * kh);
}
#define KEEP_V(x) asm volatile("" :: "v"(x))
#define MFMA_SETTLE1(x) asm volatile("s_nop 15\n\ts_nop 7" : "+v"(x))
#define MFMA_SETTLE_ALL() do { __builtin_amdgcn_sched_barrier(0); asm volatile("s_nop 15\n\ts_nop 15\n\ts_nop 15\n\ts_nop 15"); __builtin_amdgcn_sched_barrier(0); } while (0)
#define MFMA_SETTLE2(x, y) asm volatile("s_nop 15\n\ts_nop 7" : "+v"(x), "+v"(y))
__device__ __forceinline__ f32x16 mfma32(bf16x8 a, bf16x8 b, f32x16 c) { return __builtin_amdgcn_mfma_f32_32x32x16_bf16(a, b, c, 0, 0, 0); }
__device__ __forceinline__ void mfma_roundtrip2(f32x16& x, f32x16& y, LAS float* scr, int lane) {
#pragma unroll
    for (int k = 0; k < 16; ++k) { scr[k * 64 + lane] = x[k]; scr[(16 + k) * 64 + lane] = y[k]; }
    LDS_WAIT(); asm volatile("" ::: "memory");
#pragma unroll
    for (int k = 0; k < 16; ++k) { x[k] = scr[k * 64 + lane]; y[k] = scr[(16 + k) * 64 + lane]; }
    LDS_WAIT(); asm volatile("" ::: "memory");
}
__device__ __forceinline__ void mfma_roundtrip1(f32x16& x, LAS float* scr, int lane) {
#pragma unroll
    for (int k = 0; k < 16; ++k) scr[k * 64 + lane] = x[k];
    LDS_WAIT(); asm volatile("" ::: "memory");
#pragma unroll
    for (int k = 0; k < 16; ++k) x[k] = scr[k * 64 + lane];
    LDS_WAIT(); asm volatile("" ::: "memory");
}
struct SsmGroup { bf16x8 bb[2][2]; f32x2 lam[2]; };
__device__ __forceinline__ void ssm_group_load(const unsigned char* ws, int g, int lane, SsmGroup& G) {
    const bf16* Bb = (const bf16*)(ws + WS_BB);
#pragma unroll
    for (int ri = 0; ri < 2; ++ri)
#pragma unroll
        for (int pb = 0; pb < 2; ++pb) G.bb[ri][pb] = *(const bf16x8*)(Bb + ((g * 2 + ri) * 64 + pb * 32 + (lane & 31)) * 16 + 8 * (lane >> 5));
#pragma unroll
    for (int pb = 0; pb < 2; ++pb) G.lam[pb] = ((const f32x2*)(ws + WS_LAM))[g * 64 + pb * 32 + (lane & 31)];
}

__device__ __forceinline__ void p3a_items(const Params& p, int gw0, int NGW, int lane) {
    const int g = gw0 & 31;
    const bf16* vu = (const bf16*)(p.ws + WS_BBUF);
    SsmGroup G; ssm_group_load(p.ws, g, lane, G);
    const f32x16 z16 = {0.f, 0.f, 0.f, 0.f, 0.f, 0.f, 0.f, 0.f, 0.f, 0.f, 0.f, 0.f, 0.f, 0.f, 0.f, 0.f};
    f32x2* E = (f32x2*)(p.ws + WS_E);
    bf16x8 an[2];
    { const int i0 = gw0 >> 5; an[0] = ssm_load_u(vu, 64 * i0, 64 * i0 + 32, g, lane); an[1] = ssm_load_u(vu, 64 * i0 + 16, 64 * i0 + 48, g, lane); }
    for (int item = gw0; item < 256 * 32; item += NGW) {
        const int i = item >> 5;
        bf16x8 a[2] = {an[0], an[1]};
        if (item + NGW < 256 * 32) { const int i1 = (item + NGW) >> 5; an[0] = ssm_load_u(vu, 64 * i1, 64 * i1 + 32, g, lane); an[1] = ssm_load_u(vu, 64 * i1 + 16, 64 * i1 + 48, g, lane); }
        float sr[2] = {0.f, 0.f}, si[2] = {0.f, 0.f};
#pragma unroll
        for (int blk = 0; blk < 2; ++blk) {
#pragma unroll
            for (int pb = 0; pb < 2; ++pb) {
                f32x16 bur = mfma32(a[blk], G.bb[0][pb], z16);
                f32x16 bui = mfma32(a[blk], G.bb[1][pb], z16);
                MFMA_SETTLE2(bur, bui);
                const float lr = G.lam[pb].x, li = G.lam[pb].y;
#pragma unroll
                for (int r = 0; r < 16; ++r) { float nsr = fmaf(lr, sr[pb], fmaf(-li, si[pb], bur[r])), nsi = fmaf(lr, si[pb], fmaf(li, sr[pb], bui[r])); asm volatile("" : "+v"(nsr)); asm volatile("" : "+v"(nsi)); sr[pb] = nsr; si[pb] = nsi; }
            }
        }
        const int sc = 2 * i + (lane >> 5);
#pragma unroll
        for (int pb = 0; pb < 2; ++pb) E[(size_t)sc * 2048 + g * 64 + pb * 32 + (lane & 31)] = (f32x2){sr[pb], si[pb]};
        asm volatile("" :: "v"(a[0]), "v"(a[1]) : "memory");
    }
    asm volatile("" :: "v"(G.bb[0][0]), "v"(G.bb[0][1]), "v"(G.bb[1][0]), "v"(G.bb[1][1]) : "memory");
}

__device__ __forceinline__ float wave_reduce_scatter16(const float (&v)[16], int lane) {
    float a[8], b[4], c[2], d;
    const bool s5 = (lane & 32) != 0, s4 = (lane & 16) != 0, s3 = (lane & 8) != 0, s2 = (lane & 4) != 0;
#pragma unroll
    for (int i = 0; i < 8; ++i) { const float mine = s5 ? v[8 + i] : v[i], theirs = s5 ? v[i] : v[8 + i]; a[i] = mine + __shfl_xor(theirs, 32); }
#pragma unroll
    for (int i = 0; i < 4; ++i) { const float mine = s4 ? a[4 + i] : a[i], theirs = s4 ? a[i] : a[4 + i]; b[i] = mine + __shfl_xor(theirs, 16); }
#pragma unroll
    for (int i = 0; i < 2; ++i) { const float mine = s3 ? b[2 + i] : b[i], theirs = s3 ? b[i] : b[2 + i]; c[i] = mine + __shfl_xor(theirs, 8); }
    { const float mine = s2 ? c[1] : c[0], theirs = s2 ? c[0] : c[1]; d = mine + __shfl_xor(theirs, 4); }
    d += __shfl_xor(d, 2); d += __shfl_xor(d, 1);
    return d;
}
__device__ __forceinline__ int rs16_token(int lane) { return ((lane >> 5) & 1) * 8 + ((lane >> 4) & 1) * 4 + ((lane >> 3) & 1) * 2 + ((lane >> 2) & 1); }

constexpr int CONV_ROWS = 62, CONV_RED_OFF = CONV_ROWS * 1024, CONV_STAT_OFF = CONV_RED_OFF + 1024, CONV_PART_OFF = CONV_STAT_OFF + 256;
__device__ __forceinline__ void p3_conv_tile(const Params& p, int tile, LAS unsigned char* lds, int tid) {
    const int lane = tid & 63, wave = tid >> 6, cp = tid & 255, th = tid >> 8;
    const int t0 = tile * 32, tl0 = t0 % SEQL;
    const bf16* vu = (const bf16*)(p.ws + WS_BBUF);
    LAS unsigned char* vt = lds;
    LAS float* red = (LAS float*)(lds + CONV_RED_OFF);
    LAS float* stat = (LAS float*)(lds + CONV_STAT_OFF);
    for (int r = wave; r < CONV_ROWS; r += NWAVES) {
        v4u val = {0u, 0u, 0u, 0u};
        if (tl0 + r - 30 >= 0) val = *(const v4u*)(vu + (size_t)(t0 + r - 30) * D + lane * 8);
        *(LAS v4u*)(vt + r * 1024 + lane * 16) = val;
    }
    f32x2 w[31];
#pragma unroll
    for (int j = 0; j < 31; ++j) w[j] = *(const f32x2*)(p.in[7] + j * CC + 2 * cp);
    const f32x2 bias = *(const f32x2*)(p.in[8] + 2 * cp);
    __syncthreads();
    f32x2 acc[16];
#pragma unroll
    for (int o = 0; o < 16; ++o) acc[o] = bias;
#pragma unroll
    for (int s = 0; s < 46; ++s) {
        const unsigned pr = *(const LAS unsigned*)(vt + (16 * th + s) * 1024 + cp * 4);
        const f32x2 v = {bflo(pr), bfhi(pr)};
#pragma unroll
        for (int o = 0; o < 16; ++o) { const int j = s - o; if (j >= 0 && j <= 30) acc[o] += v * w[j]; }
    }
    LAS f32x2* part = (LAS f32x2*)(lds + CONV_PART_OFF);
#pragma unroll
    for (int o = 0; o < 16; ++o) part[(16 * th + o) * 257 + cp] = (f32x2){acc[o].x + acc[o].y, acc[o].x * acc[o].x + acc[o].y * acc[o].y};
    __syncthreads();
    { const int tk = tid >> 4, sub = tid & 15; float s = 0.f, q = 0.f;
#pragma unroll
      for (int i = 0; i < 16; ++i) { const f32x2 v = part[tk * 257 + sub + 16 * i]; s += v.x; q += v.y; }
#pragma unroll
      for (int o = 1; o < 16; o <<= 1) { s += __shfl_xor(s, o); q += __shfl_xor(q, o); }
      if (sub == 0) { const float mu = s * (1.f / CC), var = q * (1.f / CC) - mu * mu; stat[tk * 2] = mu; stat[tk * 2 + 1] = rsqrtf(var + EPS); } }
    __syncthreads();
    const f32x2 lg = *(const f32x2*)(p.in[9] + 2 * cp), lb = *(const f32x2*)(p.in[10] + 2 * cp);
#pragma unroll
    for (int o = 0; o < 16; ++o) { const float mu = stat[(16 * th + o) * 2], rs = stat[(16 * th + o) * 2 + 1];
        f32x2 y = (acc[o] - mu) * rs * lg + lb; y.x = siluf_(y.x); y.y = siluf_(y.y); acc[o] = y;
        part[(16 * th + o) * 257 + cp].x = y.x * y.x + y.y * y.y; }
    __syncthreads();
    { const int tk = tid >> 4, sub = tid & 15; float q = 0.f;
#pragma unroll
      for (int i = 0; i < 16; ++i) q += part[tk * 257 + sub + 16 * i].x;
#pragma unroll
      for (int o = 1; o < 16; o <<= 1) q += __shfl_xor(q, o);
      if (sub == 0) stat[tk * 2] = rsqrtf(q * (1.f / CC) + EPS); }
    __syncthreads();
    const f32x2 go = *(const f32x2*)(p.in[21] + 2 * cp);
    bf16* mixed = (bf16*)(p.ws + WS_ABUF);
#pragma unroll
    for (int o = 0; o < 16; ++o) { const float rs = stat[(16 * th + o) * 2]; const f32x2 y = acc[o] * rs * go;
        *(unsigned*)(mixed + (size_t)(t0 + 16 * th + o) * D + 2 * cp) = pk2(y.x, y.y); }
    __syncthreads();
}

__device__ __forceinline__ void p3b_block(const Params& p, int blk, LAS unsigned char* lds, int tid) {
    const int sl = tid & 15, seg = tid >> 4;
    const int idx = blk * 16 + sl, b = idx >> 11, q = idx & 2047;
    const f32x2 L = ((const f32x2*)(p.ws + WS_LAM32))[q];
    const f32x2* E = (const f32x2*)(p.ws + WS_E) + (size_t)b * 256 * 2048 + q + (size_t)(8 * seg) * 2048;
    f32x2* S = (f32x2*)(p.ws + WS_SINIT) + (size_t)b * 256 * 2048 + q + (size_t)(8 * seg) * 2048;
    f32x2 e[8];
#pragma unroll
    for (int j = 0; j < 8; ++j) e[j] = E[(size_t)j * 2048];
    float pr = L.x, pi = L.y;
#pragma unroll
    for (int s = 0; s < 3; ++s) { const float nr = pr * pr - pi * pi, ni = 2.0f * pr * pi; pr = nr; pi = ni; }
    float xr = 0.f, xi = 0.f;
#pragma unroll
    for (int j = 0; j < 8; ++j) { float nr = fmaf(L.x, xr, fmaf(-L.y, xi, e[j].x)), ni = fmaf(L.x, xi, fmaf(L.y, xr, e[j].y)); asm volatile("" : "+v"(nr)); asm volatile("" : "+v"(ni)); xr = nr; xi = ni; }
    LAS f32x2* xs = (LAS f32x2*)lds;
    xs[sl * 33 + seg] = (f32x2){xr, xi};
    __syncthreads();
    if (tid < 16) {
        f32x2 x[32];
#pragma unroll
        for (int k = 0; k < 32; ++k) x[k] = xs[tid * 33 + k];
        float cr = 0.f, ci = 0.f;
#pragma unroll
        for (int k = 0; k < 32; ++k) { xs[tid * 33 + k] = (f32x2){cr, ci};
            float nr = fmaf(pr, cr, fmaf(-pi, ci, x[k].x)), ni = fmaf(pr, ci, fmaf(pi, cr, x[k].y)); asm volatile("" : "+v"(nr)); asm volatile("" : "+v"(ni)); cr = nr; ci = ni; }
    }
    __syncthreads();
    const f32x2 in = xs[sl * 33 + seg];
    float sr = in.x, si = in.y;
#pragma unroll
    for (int j = 0; j < 8; ++j) { S[(size_t)j * 2048] = (f32x2){sr, si};
        float nr = fmaf(L.x, sr, fmaf(-L.y, si, e[j].x)), ni = fmaf(L.x, si, fmaf(L.y, sr, e[j].y)); asm volatile("" : "+v"(nr)); asm volatile("" : "+v"(ni)); sr = nr; si = ni; }
    __syncthreads();
}

constexpr int P3C_STILE = 32 * 272, P3C_G_OFF = 8 * P3C_STILE, P3C_G_STRIDE = 1040, P3C_RED_OFF = P3C_G_OFF + 64 * P3C_G_STRIDE;
__device__ __forceinline__ void p3c_chunk(const Params& p, int chunk, LAS unsigned char* lds, int tid) {
    const int lane = tid & 63, wave = __builtin_amdgcn_readfirstlane(tid >> 6);
    const int t0 = chunk * 64;
    const bf16* vu = (const bf16*)(p.ws + WS_BBUF);
    LAS unsigned char* st = lds + wave * P3C_STILE;
    LAS unsigned char* gt = lds + P3C_G_OFF;
    const int hf = lane >> 5, j = lane & 31;
    const f32x16 z16 = {0.f, 0.f, 0.f, 0.f, 0.f, 0.f, 0.f, 0.f, 0.f, 0.f, 0.f, 0.f, 0.f, 0.f, 0.f, 0.f};
    const bf16* Ct = (const bf16*)(p.ws + WS_CT);
    for (int gi = 0; gi < ((p.flags & 2) ? 0 : 4); ++gi) {
        const int g = wave * 4 + gi;
        SsmGroup G; ssm_group_load(p.ws, g, lane, G);
        float sr[2], si[2];
        { const f32x2* S0 = (const f32x2*)(p.ws + WS_SINIT) + (size_t)(2 * chunk + hf) * 2048 + g * 64 + j;
          const f32x2 s0 = S0[0], s1 = S0[32]; sr[0] = s0.x; si[0] = s0.y; sr[1] = s1.x; si[1] = s1.y; }
        bf16x8 cb[8];
#pragma unroll
        for (int ks = 0; ks < 8; ++ks) { bf16x8 v = {0, 0, 0, 0, 0, 0, 0, 0}; if (j < 16) v = *(const bf16x8*)(Ct + (size_t)(g * 16 + j) * 128 + ks * 16 + 8 * hf); cb[ks] = v; }
        bf16x8 db = {0, 0, 0, 0, 0, 0, 0, 0};
        if (j < 16 && (j >> 3) == hf) { const unsigned short dv = (unsigned short)f2bf(p.in[18][g * 16 + j]);
#pragma unroll
            for (int e = 0; e < 8; ++e) if ((j & 7) == e) db[e] = (short)dv; }
#pragma unroll
        for (int blk = 0; blk < 2; ++blk) {
            const bf16x8 a = ssm_load_u(vu, t0 + 16 * blk, t0 + 32 + 16 * blk, g, lane);
            f32x16 bur[2], bui[2];
#pragma unroll
            for (int pb = 0; pb < 2; ++pb) {
                bur[pb] = mfma32(a, G.bb[0][pb], z16);
                bui[pb] = mfma32(a, G.bb[1][pb], z16);
                MFMA_SETTLE2(bur[pb], bui[pb]);
            }
#pragma unroll
            for (int pb = 0; pb < 2; ++pb) {
                const float lr = G.lam[pb].x, li = G.lam[pb].y;
#pragma unroll
                for (int r = 0; r < 16; ++r) {
                    float nsr = fmaf(lr, sr[pb], fmaf(-li, si[pb], bur[pb][r])), nsi = fmaf(lr, si[pb], fmaf(li, sr[pb], bui[pb][r])); asm volatile("" : "+v"(nsr)); asm volatile("" : "+v"(nsi)); sr[pb] = nsr; si[pb] = nsi;
                    const int row = (r & 3) + 8 * (r >> 2) + 4 * hf;
                    const unsigned wri = pk2(nsr, nsi);
                    *(LAS unsigned short*)(st + row * 272 + (pb * 32 + j) * 2) = (unsigned short)wri;
                    *(LAS unsigned short*)(st + row * 272 + (64 + pb * 32 + j) * 2) = (unsigned short)(wri >> 16);
                }
            }
            LDS_WAIT(); asm volatile("" ::: "memory");
            f32x16 y = mfma32(a, db, z16);
#pragma unroll
            for (int ks = 0; ks < 8; ++ks) { const bf16x8 sa = *(const LAS bf16x8*)(st + j * 272 + (ks * 16 + 8 * hf) * 2); y = mfma32(sa, cb[ks], y); KEEP_V(sa); }
            MFMA_SETTLE1(y);
            LDS_WAIT(); asm volatile("" ::: "memory");
#pragma unroll
            for (int r = 0; r < 16; ++r) { float yr = y[r]; asm volatile("" : "+v"(yr)); y[r] = yr; }
            KEEP_V(a);
            if (j < 16) {
#pragma unroll
                for (int r = 0; r < 16; r += 2) { const int tokl = 32 * hf + 16 * blk + r; const unsigned w2 = pk2(gelu_tanh(y[r]), gelu_tanh(y[r + 1]));
                    *(LAS unsigned short*)(gt + tokl * P3C_G_STRIDE + (g * 16 + j) * 2) = (unsigned short)w2;
                    *(LAS unsigned short*)(gt + (tokl + 1) * P3C_G_STRIDE + (g * 16 + j) * 2) = (unsigned short)(w2 >> 16); }
            }
            LDS_WAIT(); asm volatile("" ::: "memory");
        }
        KEEP_V(db); KEEP_V(G.bb[0][0]); KEEP_V(G.bb[0][1]); KEEP_V(G.bb[1][0]); KEEP_V(G.bb[1][1]);
#pragma unroll
        for (int ks = 0; ks < 8; ++ks) KEEP_V(cb[ks]);
    }
    __syncthreads();
    if (p.flags & 4) return;
    const int fr = lane & 15, fq = lane >> 4;
    f32x4 acc[4][4];
#pragma unroll
    for (int mf = 0; mf < 4; ++mf)
#pragma unroll
        for (int nf = 0; nf < 4; ++nf) acc[mf][nf] = (f32x4){0.f, 0.f, 0.f, 0.f};
    const bf16* Wg = (const bf16*)(p.ws + WS_W_GLU_T);
#pragma unroll 4
    for (int ks = 0; ks < 16; ++ks) {
        bf16x8 af[4], bfr[4];
#pragma unroll
        for (int nf = 0; nf < 4; ++nf) bfr[nf] = *(const bf16x8*)(Wg + (size_t)((wave * 16 + ks) * 4 + nf) * 512 + lane * 8);
#pragma unroll
        for (int mf = 0; mf < 4; ++mf) af[mf] = *(const LAS bf16x8*)(gt + (16 * mf + fr) * P3C_G_STRIDE + (32 * ks + 8 * fq) * 2);
#pragma unroll
        for (int mf = 0; mf < 4; ++mf)
#pragma unroll
            for (int nf = 0; nf < 4; ++nf) acc[mf][nf] = __builtin_amdgcn_mfma_f32_16x16x32_bf16(bfr[nf], af[mf], acc[mf][nf], 0, 0, 0);
    }
    MFMA_SETTLE_ALL();
    float ssq[4] = {0.f, 0.f, 0.f, 0.f};
#pragma unroll
    for (int nf = 0; nf < 4; ++nf) { const int n0 = 64 * wave + 16 * nf + 4 * fq; const f32x4 bg = *(const f32x4*)(p.in[20] + n0);
#pragma unroll
        for (int mf = 0; mf < 4; ++mf) { const v2u gw = *(const LAS v2u*)(gt + (16 * mf + fr) * P3C_G_STRIDE + n0 * 2);
            const f32x4 gv = {bflo(gw.x), bfhi(gw.x), bflo(gw.y), bfhi(gw.y)}; f32x4 o;
#pragma unroll
            for (int e = 0; e < 4; ++e) { o[e] = gv[e] * sigmoidf_(acc[mf][nf][e] + bg[e]); ssq[mf] += o[e] * o[e]; }
            acc[mf][nf] = o; } }
    LAS float* red = (LAS float*)(lds + P3C_RED_OFF);
#pragma unroll
    for (int mf = 0; mf < 4; ++mf) { float s = ssq[mf]; s += __shfl_xor(s, 16); s += __shfl_xor(s, 32); if (fq == 0) red[wave * 64 + 16 * mf + fr] = s; }
    __syncthreads();
    float rs[4];
#pragma unroll
    for (int mf = 0; mf < 4; ++mf) { float s = 0.f;
#pragma unroll
        for (int wv = 0; wv < 8; ++wv) s += red[wv * 64 + 16 * mf + fr];
        rs[mf] = rsqrtf(s * (1.f / CC) + EPS); }
    bf16* mixed = (bf16*)(p.ws + WS_ABUF);
#pragma unroll
    for (int nf = 0; nf < 4; ++nf) { const int n0 = 64 * wave + 16 * nf + 4 * fq; const f32x4 go = *(const f32x4*)(p.in[22] + n0);
#pragma unroll
        for (int mf = 0; mf < 4; ++mf) { const f32x4 o = acc[mf][nf] * rs[mf] * go;
            v2u w; w.x = pk2(o[0], o[1]); w.y = pk2(o[2], o[3]);
            *(v2u*)(mixed + (size_t)(t0 + 16 * mf + fr) * D + CC + n0) = w; } }
    __syncthreads();
}


constexpr int P4B_HSTRIDE = 2064, P4B_LOGIT_OFF = 32 * P4B_HSTRIDE;
__device__ __forceinline__ float wave_max(float v) {
#pragma unroll
    for (int o = 1; o < 64; o <<= 1) v = fmaxf(v, __shfl_xor(v, o));
    return v;
}
__device__ __forceinline__ void p4b_tile(const Params& p, int tile, LAS unsigned char* lds, int tid) {
    const int lane = tid & 63, wave = __builtin_amdgcn_readfirstlane(tid >> 6);
    const int t0 = tile * 32, b = t0 / SEQL;
    const float* mod = (const float*)(p.ws + WS_MOD) + b * 6 * D;
    const bf16* obuf = (const bf16*)(p.ws + WS_BBUF);
    bf16* h2 = (bf16*)(p.ws + WS_ABUF);
    LAS unsigned char* ht = lds;
    LAS float* logits = (LAS float*)(lds + P4B_LOGIT_OFF);
    const int n0 = 8 * lane, n1 = 512 + 8 * lane;
    {
        f32x4 gp[4], gt[4], gq[4], sc[4], sh[4];
#pragma unroll
        for (int q = 0; q < 4; ++q) { const int n = (q < 2 ? n0 : n1) + 4 * (q & 1);
            gp[q] = *(const f32x4*)(p.in[5] + n); gt[q] = *(const f32x4*)(mod + 2 * D + n); gq[q] = *(const f32x4*)(p.in[24] + n);
            sc[q] = *(const f32x4*)(mod + 4 * D + n) + 1.0f; sh[q] = *(const f32x4*)(mod + 3 * D + n); }
        for (int rr = 0; rr < 4; ++rr) {
            const int row = 4 * wave + rr; const size_t t = (size_t)(t0 + row);
            const v4u o0 = *(const v4u*)(obuf + t * D + n0), o1 = *(const v4u*)(obuf + t * D + n1);
            f32x4 ov[4] = {{bflo(o0.x), bfhi(o0.x), bflo(o0.y), bfhi(o0.y)}, {bflo(o0.z), bfhi(o0.z), bflo(o0.w), bfhi(o0.w)},
                           {bflo(o1.x), bfhi(o1.x), bflo(o1.y), bfhi(o1.y)}, {bflo(o1.z), bfhi(o1.z), bflo(o1.w), bfhi(o1.w)}};
            f32x4 xv[4];
#pragma unroll
            for (int q = 0; q < 4; ++q) xv[q] = *(const f32x4*)(p.in[0] + t * D + (q < 2 ? n0 : n1) + 4 * (q & 1));
            float ss = 0.f;
#pragma unroll
            for (int q = 0; q < 4; ++q) ss += (ov[q].x * ov[q].x + ov[q].y * ov[q].y) + (ov[q].z * ov[q].z + ov[q].w * ov[q].w);
            const float rstd = rsqrtf(wave_sum(ss) * (1.f / D) + EPS);
            float s2 = 0.f;
#pragma unroll
            for (int q = 0; q < 4; ++q) { xv[q] = xv[q] + gt[q] * (ov[q] * rstd * gp[q]); s2 += (xv[q].x * xv[q].x + xv[q].y * xv[q].y) + (xv[q].z * xv[q].z + xv[q].w * xv[q].w);
                *(f32x4*)(p.out + t * D + (q < 2 ? n0 : n1) + 4 * (q & 1)) = xv[q]; }
            const float r2 = rsqrtf(wave_sum(s2) * (1.f / D) + EPS);
            f32x4 hv[4];
#pragma unroll
            for (int q = 0; q < 4; ++q) hv[q] = xv[q] * r2 * gq[q] * sc[q] + sh[q];
            v4u w0, w1;
            w0.x = pk2(hv[0].x, hv[0].y); w0.y = pk2(hv[0].z, hv[0].w); w0.z = pk2(hv[1].x, hv[1].y); w0.w = pk2(hv[1].z, hv[1].w);
            w1.x = pk2(hv[2].x, hv[2].y); w1.y = pk2(hv[2].z, hv[2].w); w1.z = pk2(hv[3].x, hv[3].y); w1.w = pk2(hv[3].z, hv[3].w);
            *(v4u*)(h2 + t * D + n0) = w0; *(v4u*)(h2 + t * D + n1) = w1;
            { unsigned char* h8 = p.ws + WS_H8 + t * D;
              int a0 = __builtin_amdgcn_cvt_pk_fp8_f32(hv[0].x, hv[0].y, 0, false); a0 = __builtin_amdgcn_cvt_pk_fp8_f32(hv[0].z, hv[0].w, a0, true);
              int a1 = __builtin_amdgcn_cvt_pk_fp8_f32(hv[1].x, hv[1].y, 0, false); a1 = __builtin_amdgcn_cvt_pk_fp8_f32(hv[1].z, hv[1].w, a1, true);
              int b0 = __builtin_amdgcn_cvt_pk_fp8_f32(hv[2].x, hv[2].y, 0, false); b0 = __builtin_amdgcn_cvt_pk_fp8_f32(hv[2].z, hv[2].w, b0, true);
              int b1 = __builtin_amdgcn_cvt_pk_fp8_f32(hv[3].x, hv[3].y, 0, false); b1 = __builtin_amdgcn_cvt_pk_fp8_f32(hv[3].z, hv[3].w, b1, true);
              *(v2u*)(h8 + n0) = (v2u){(unsigned)a0, (unsigned)a1}; *(v2u*)(h8 + n1) = (v2u){(unsigned)b0, (unsigned)b1}; }
            *(LAS v4u*)(ht + row * P4B_HSTRIDE + n0 * 2) = w0; *(LAS v4u*)(ht + row * P4B_HSTRIDE + n1 * 2) = w1;
        }
    }
    __syncthreads();
    {
        const int fr = lane & 15, fq = lane >> 4, mf = wave & 1, nf = wave >> 1;
        const bf16* Wr = (const bf16*)(p.ws + WS_W_RT_T);
        f32x4 acc = {0.f, 0.f, 0.f, 0.f};
#pragma unroll 8
        for (int ks = 0; ks < 32; ++ks) {
            const bf16x8 a = *(const LAS bf16x8*)(ht + (16 * mf + fr) * P4B_HSTRIDE + (32 * ks + 8 * fq) * 2);
            const bf16x8 bb = *(const bf16x8*)(Wr + (size_t)(16 * nf + fr) * D + 32 * ks + 8 * fq);
            acc = __builtin_amdgcn_mfma_f32_16x16x32_bf16(a, bb, acc, 0, 0, 0);
        }
        MFMA_SETTLE1(acc);
#pragma unroll
        for (int r = 0; r < 4; ++r) logits[(16 * mf + 4 * fq + r) * 64 + 16 * nf + fr] = acc[r];
    }
    __syncthreads();
    {
        unsigned* cnt = (unsigned*)(p.ws + WS_CTL) + CW_CNT;
        int* list = (int*)(p.ws + WS_LIST);
        int* top_idx = (int*)(p.ws + WS_TOPIDX); float* gate_w = (float*)(p.ws + WS_GATEW);
        LAS unsigned* lcnt = (LAS unsigned*)(lds + P4B_LOGIT_OFF + 8192);
        LAS int* lsel = (LAS int*)(lds + P4B_LOGIT_OFF + 8192 + 256);
        if (tid < 64) lcnt[tid] = 0u;
        __syncthreads();
        const float brt = p.in[27][lane];
        const float NEG = -3.0e38f;
        {
            float s[4], bsc[4], gs[4], masked[4], mysel[4], ssum[4]; int myidx[4];
            const int g = lane >> 3;
#pragma unroll
            for (int rr = 0; rr < 4; ++rr) { s[rr] = sigmoidf_(logits[(4 * wave + rr) * 64 + lane]); bsc[rr] = s[rr] + brt; myidx[rr] = 0; mysel[rr] = 0.f; ssum[rr] = 0.f; }
            float m1[4], m2[4];
#pragma unroll
            for (int rr = 0; rr < 4; ++rr) m1[rr] = bsc[rr];
#pragma unroll
            for (int o = 1; o < 8; o <<= 1) {
#pragma unroll
                for (int rr = 0; rr < 4; ++rr) m1[rr] = fmaxf(m1[rr], __shfl_xor(m1[rr], o)); }
#pragma unroll
            for (int rr = 0; rr < 4; ++rr) { const unsigned long long eq = __ballot(bsc[rr] == m1[rr]);
                const int first = __ffsll((long long)(eq & (0xFFull << (8 * g)))) - 1; m2[rr] = (lane == first) ? NEG : bsc[rr]; }
#pragma unroll
            for (int o = 1; o < 8; o <<= 1) {
#pragma unroll
                for (int rr = 0; rr < 4; ++rr) m2[rr] = fmaxf(m2[rr], __shfl_xor(m2[rr], o)); }
#pragma unroll
            for (int rr = 0; rr < 4; ++rr) gs[rr] = m1[rr] + m2[rr];
            int rank[4] = {0, 0, 0, 0};
#pragma unroll
            for (int j = 0; j < 8; ++j) {
#pragma unroll
                for (int rr = 0; rr < 4; ++rr) { const float gj = __shfl(gs[rr], 8 * j); rank[rr] += (gj > gs[rr] || (gj == gs[rr] && j < g)) ? 1 : 0; } }
#pragma unroll
            for (int rr = 0; rr < 4; ++rr) masked[rr] = (rank[rr] < 4) ? bsc[rr] : NEG;
#pragma unroll
            for (int r = 0; r < 8; ++r) {
                float m[4];
#pragma unroll
                for (int rr = 0; rr < 4; ++rr) m[rr] = masked[rr];
#pragma unroll
                for (int o = 1; o < 64; o <<= 1) {
#pragma unroll
                    for (int rr = 0; rr < 4; ++rr) m[rr] = fmaxf(m[rr], __shfl_xor(m[rr], o)); }
#pragma unroll
                for (int rr = 0; rr < 4; ++rr) {
                    const unsigned long long eb = __ballot(masked[rr] == m[rr]);
                    const int idx = __ffsll((long long)eb) - 1;
                    const float sv = __shfl(s[rr], idx);
                    ssum[rr] += sv;
                    if (lane == r) { myidx[rr] = idx; mysel[rr] = sv; }
                    if (lane == idx) masked[rr] = NEG;
                }
            }
            if (lane < 8) {
#pragma unroll
                for (int rr = 0; rr < 4; ++rr) { const int row = 4 * wave + rr, t = t0 + row;
                    const float w = mysel[rr] / (ssum[rr] + 1e-20f) * 2.5f;
                    top_idx[t * 8 + lane] = myidx[rr]; gate_w[t * 8 + lane] = w;
                    const unsigned lp = __hip_atomic_fetch_add(&lcnt[myidx[rr]], 1u, __ATOMIC_RELAXED, __HIP_MEMORY_SCOPE_WORKGROUP);
                    lsel[row * 8 + lane] = myidx[rr] | ((int)lp << 8); }
            }
        }
        __syncthreads();
        if (tid < 64) { const unsigned c = lcnt[tid]; unsigned base = 0u; if (c) base = atomicAdd(&cnt[tid * CNT_STRIDE], c); lcnt[tid] = base; }
        __syncthreads();
        if (tid < 256) { const int v = lsel[tid], e = v & 255, lp = v >> 8; list[(size_t)e * T + lcnt[e] + lp] = (t0 + (tid >> 3)) * 8 + (tid & 7); }
    }
    __syncthreads();
}


__device__ __forceinline__ int moe_build_units(const Params& p, LAS unsigned char* lds, int tid, int bid, int G, int mode) {
    LAS int* tp = (LAS int*)(lds + pg8::MOE_TP_OFF);
    LAS int* desc = (LAS int*)(lds + pg8::MOE_DESC_OFF);
    LAS int* rows = (LAS int*)(lds + pg8::MOE_ROWS_OFF);
    const unsigned* cnt = (const unsigned*)(p.ws + WS_CTL) + CW_CNT;
    if (tid < 64) {
        const int nt_e = ((int)cnt[tid * CNT_STRIDE] + 255) >> 8; int s = nt_e;
#pragma unroll
        for (int o = 1; o < 64; o <<= 1) { const int v = __shfl_up(s, o); if (tid >= o) s += v; }
        tp[tid] = s - nt_e; if (tid == 63) { tp[64] = s; tp[65] = s + 64; } }
    __syncthreads();
    const int NU = tp[65] * 2;
    int nlocal = 0; for (int u = bid; u < NU; u += G) ++nlocal;
    if (nlocal > pg8::MOE_MAX_UNITS) nlocal = pg8::MOE_MAX_UNITS;
    if (tid < nlocal) { const int u = bid + tid * G, ti = u >> 1, pn = u & 1;
        int e = 0; for (int q = 1; q <= 64; ++q) if (tp[q] <= ti) e = q;
        const int tile = ti - tp[e], n = (e < 64) ? (int)cnt[e * CNT_STRIDE] : T, nv = n - tile * 256;
        desc[tid * 8 + 0] = e; desc[tid * 8 + 1] = ti; desc[tid * 8 + 2] = pn; desc[tid * 8 + 3] = nv > 256 ? 256 : nv; desc[tid * 8 + 4] = tile; }
    __syncthreads();
    const int* list = (const int*)(p.ws + WS_LIST);
    for (int q = tid; q < nlocal * 256; q += NTHREADS) { const int s = q >> 8, r = q & 255;
        const int e = desc[s * 8], tile = desc[s * 8 + 4], nv = desc[s * 8 + 3];
        int id = -1;
        if (r < nv) id = (e < 64) ? list[(size_t)e * T + tile * 256 + r] : tile * 256 + r;
        rows[q] = (mode == 0) ? (id < 0 ? 0 : (e < 64 ? (id >> 3) : id)) : id;
        if (mode == 1) ((LAS float*)(lds + pg8::MOE_W_OFF))[q] = (id >= 0 && e < 64) ? ((const float*)(p.ws + WS_GATEW))[id] : 1.0f; }
    __syncthreads();
    return nlocal;
}

__device__ __forceinline__ void moe_combine_row(const Params& p, int t, int lane) {
    const unsigned char* yk8 = p.ws + WS_WGU_T;
    const bf16* ycomb = (const bf16*)(p.ws + WS_ABUF);
    const int c0 = 16 * lane;
    float a[16];
    { const v4u w0 = *(const v4u*)(ycomb + (size_t)t * D + c0), w1 = *(const v4u*)(ycomb + (size_t)t * D + c0 + 8);
      a[0] = bflo(w0.x); a[1] = bfhi(w0.x); a[2] = bflo(w0.y); a[3] = bfhi(w0.y); a[4] = bflo(w0.z); a[5] = bfhi(w0.z); a[6] = bflo(w0.w); a[7] = bfhi(w0.w);
      a[8] = bflo(w1.x); a[9] = bfhi(w1.x); a[10] = bflo(w1.y); a[11] = bfhi(w1.y); a[12] = bflo(w1.z); a[13] = bfhi(w1.z); a[14] = bflo(w1.w); a[15] = bfhi(w1.w); }
    v4u q[8];
#pragma unroll
    for (int k = 0; k < 8; ++k) q[k] = *(const v4u*)(yk8 + ((size_t)t * 8 + k) * 1024 + c0);
    float r[16];
#pragma unroll
    for (int j = 0; j < 16; ++j) r[j] = 0.f;
#pragma unroll
    for (int k = 0; k < 8; ++k) {
        const unsigned w4[4] = {q[k].x, q[k].y, q[k].z, q[k].w};
#pragma unroll
        for (int d = 0; d < 4; ++d) { const f32x2 lo = __builtin_amdgcn_cvt_pk_f32_fp8((int)w4[d], false), hi = __builtin_amdgcn_cvt_pk_f32_fp8((int)w4[d], true);
            r[4 * d + 0] += lo.x; r[4 * d + 1] += lo.y; r[4 * d + 2] += hi.x; r[4 * d + 3] += hi.y; }
    }
    float ss = 0.f;
#pragma unroll
    for (int j = 0; j < 16; ++j) { a[j] += r[j] * (1.0f / 16.0f); ss += a[j] * a[j]; }
    const float rstd = rsqrtf(wave_sum(ss) * (1.f / D) + EPS);
    const int b = t / SEQL;
    const float* gtf = (const float*)(p.ws + WS_MOD) + b * 6 * D + 5 * D;
    float* o = p.out + (size_t)t * D + c0;
#pragma unroll
    for (int qd = 0; qd < 4; ++qd) { const f32x4 g = *(const f32x4*)(p.in[25] + c0 + 4 * qd), gt = *(const f32x4*)(gtf + c0 + 4 * qd); f32x4 x1 = *(const f32x4*)(o + 4 * qd);
        x1.x += gt.x * (a[4 * qd + 0] * rstd * g.x); x1.y += gt.y * (a[4 * qd + 1] * rstd * g.y); x1.z += gt.z * (a[4 * qd + 2] * rstd * g.z); x1.w += gt.w * (a[4 * qd + 3] * rstd * g.w);
        *(f32x4*)(o + 4 * qd) = x1; }
}

__global__ void __launch_bounds__(NTHREADS, 2) mega(Params p) {
    extern __shared__ __attribute__((aligned(16))) unsigned char lds_raw[];
    LAS unsigned char* lds = (LAS unsigned char*)lds_raw;
    volatile LAS unsigned* MISC = (volatile LAS unsigned*)(lds + MISC_OFF);
    const int tid = threadIdx.x, lane = tid & 63, wave = __builtin_amdgcn_readfirstlane(tid >> 6);
    const int G = gridDim.x, bid = blockIdx.x;
    if (tid < 32) MISC[tid] = 0u;
    __syncthreads();
    unsigned* ctl = (unsigned*)(p.ws + WS_CTL);
    XcdBarrier bar = xcd_barrier_post(ctl + CW_BAR + p.li * XCD_BAR_WORDS, MISC + 8);
    const int gw = bid * NWAVES + wave, NGW = G * NWAVES;

    if (RUN(0)) {
    if (bid < 192) p0_mod_item(p, bid, (LAS float*)lds, tid);
    else if (bid < 196) p0_ssm_tables_gp(p, (bid - 192) * NTHREADS + tid);
    else if (bid < 200) { for (int i = 0; i < 32; ++i) p0_ssm_tables_ct(p, ((bid - 196) * NTHREADS + tid) * 32 + i); }
    {
        LAS float* scr = (LAS float*)(lds + wave * 16384);
        for (int it = gw; it < NITEMS_T; it += NGW) p0_convert_item(p, it, scr, lane);
    }
    }
    xcd_barrier(bar);
    if (RUN(1)) for (int m = gw; m < T; m += NGW) p1_row(p, m, lane);
    xcd_barrier(bar);
    if (RUN(2)) {
        pg8::StaticOrder S; S.init(p.ws + WS_ABUF, p.ws + WS_W_IN_T, T, DIN, D, G, bid);
        pg8::EpiVU E{(bf16*)(p.ws + WS_BBUF)};
        pg8::gemm_phase<pg8::EpiVU, pg8::StaticOrder, true>(lds, D, S, E);
    }
    xcd_barrier(bar);
    if (RUN(3)) {
    p3a_items(p, gw, NGW, lane);
    __syncthreads();
    if (!(p.flags & 8)) for (int tile = bid; tile < T / 32; tile += G) p3_conv_tile(p, tile, lds, tid);
    }
    xcd_barrier(bar);
    if (RUN(4)) for (int blk = bid; blk < 256; blk += G) p3b_block(p, blk, lds, tid);
    xcd_barrier(bar);
    if (RUN(5)) for (int c = bid; c < T / 64; c += G) p3c_chunk(p, c, lds, tid);
    xcd_barrier(bar);
    if (RUN(6)) {
        pg8::StaticOrder S; S.init(p.ws + WS_ABUF, p.ws + WS_W_OUT_T, T, D, D, G, bid);
        pg8::EpiBf16Plain E{(bf16*)(p.ws + WS_BBUF), D};
        pg8::gemm_phase<pg8::EpiBf16Plain, pg8::StaticOrder, true>(lds, D, S, E);
    }
    xcd_barrier(bar);
    if (RUN(7)) for (int tile = bid; tile < T / 32; tile += G) p4b_tile(p, tile, lds, tid);
    xcd_barrier(bar);
    if (RUN(8)) {
        const int nl = moe_build_units(p, lds, tid, bid, G, 0);
        pg8::MoeSched S{(const char*)(p.ws + WS_H8), (const char*)(p.ws + WS_WGU_T), lds, nl, D, 0, 1};
        pg8::EpiAct E{p.ws + WS_ACT, 1.0f / 32.0f};
        pg8::gemm_phase<pg8::EpiAct, pg8::MoeSched, true, true, 1>(lds, D, S, E);
    }
    xcd_barrier(bar);
    if (RUN(9)) {
        const int nl = moe_build_units(p, lds, tid, bid, G, 1);
        pg8::MoeSched S{(const char*)(p.ws + WS_ACT), (const char*)(p.ws + WS_WD_T), lds, 2 * nl, DE, 1, 1};
        pg8::EpiDown E{p.ws + WS_WGU_T, (bf16*)(p.ws + WS_ABUF), lds};
        pg8::gemm_phase<pg8::EpiDown, pg8::MoeSched, true, false, 1>(lds, DE, S, E);
    }
    xcd_barrier(bar);
    if (RUN(10)) { int l10 = lane; asm volatile("" : "+v"(l10));
        for (int t = gw; t < T; t += NGW) moe_combine_row(p, t, l10); }
}

extern "C" void kernel_launch(void* const* d_in, const int* in_sizes, int n_in, void* d_out, int out_size, void* d_ws, size_t ws_size, hipStream_t stream) {
    static int grid = 0;
    if (grid == 0) {
        int dev = 0, cus = 0;
        if (n_in != 34 || out_size != T * D || ws_size < WS_END) { grid = -1; return; }
        if (hipGetDevice(&dev) != hipSuccess || hipDeviceGetAttribute(&cus, hipDeviceAttributeMultiprocessorCount, dev) != hipSuccess) { grid = -1; return; }
        if (hipFuncSetAttribute((const void*)mega, hipFuncAttributeMaxDynamicSharedMemorySize, LDS_BYTES) != hipSuccess) { grid = -1; return; }
        (void)hipGetLastError();
        grid = cus;
    }
    if (grid < 0) return;
    (void)hipMemsetAsync((char*)d_ws + WS_CTL, 0, CTL_ZERO_BYTES, stream);
    Params p{};
    for (int i = 0; i < 34; ++i) p.in[i] = (const float*)d_in[i];
    p.out = (float*)d_out; p.ws = (unsigned char*)d_ws; p.ph_lo = 0; p.ph_hi = 99;
    hipLaunchKernelGGL(mega, dim3(grid), dim3(NTHREADS), LDS_BYTES, stream, p);
    if (PROBE_K >= 0 && PROBE_K < 60) { Params q = p; q.ph_lo = PROBE_K; q.ph_hi = PROBE_K + 1; q.li = 1; q.flags = PROBE_FLAGS; hipLaunchKernelGGL(mega, dim3(grid), dim3(NTHREADS), LDS_BYTES, stream, q); }

}
```

```cpp
#include <hip/hip_runtime.h>
#include <cstdio>
#include <cstdint>

#define GAS __attribute__((address_space(1)))
#define LAS __attribute__((address_space(3)))
typedef unsigned short bf16;
typedef unsigned v4u __attribute__((ext_vector_type(4)));
typedef unsigned v2u __attribute__((ext_vector_type(2)));
typedef float f32x4 __attribute__((ext_vector_type(4)));
typedef float f32x2 __attribute__((ext_vector_type(2)));
typedef short bf16x8 __attribute__((ext_vector_type(8)));
typedef int i32x8 __attribute__((ext_vector_type(8)));

constexpr int T = 16384, D = 1024, SEQL = 8192, DIN = 1536, CC = 512, NE = 64, DE = 256;
constexpr float EPS = 1e-6f;
constexpr int NTHREADS = 512, NWAVES = 8;
constexpr int LDS_BYTES = 147456;
constexpr int RING_BYTES = 131072, MISC_OFF = LDS_BYTES - 512;

constexpr size_t MiB = 1u << 20;
constexpr size_t WS_CTL = 0, CTL_ZERO_BYTES = 1 * MiB;
constexpr size_t WS_MOD = 1 * MiB;
constexpr size_t WS_LAM = WS_MOD + 64 * 1024;
constexpr size_t WS_LAM32 = WS_MOD + 80 * 1024;
constexpr size_t WS_BB = WS_MOD + 96 * 1024;
constexpr size_t WS_CT = WS_MOD + 224 * 1024;
constexpr size_t WS_WD_T = 2 * MiB;
constexpr size_t WS_LISTS = 35 * MiB;
constexpr size_t WS_ABUF = 41 * MiB;
constexpr size_t WS_ACT = 73 * MiB;
constexpr size_t WS_WGU_T = 153 * MiB;
constexpr size_t WS_W_IN_T = 218 * MiB;
constexpr size_t WS_W_OUT_T = 221 * MiB;
constexpr size_t WS_W_GLU_T = 223 * MiB;
constexpr size_t WS_W_RT_T = 223 * MiB + 512 * 1024;
constexpr size_t WS_H8 = 190 * MiB;
constexpr size_t WS_E = 224 * MiB;
constexpr size_t WS_SINIT = 232 * MiB;
constexpr size_t WS_BBUF = 240 * MiB;
constexpr size_t WS_END = 281 * MiB;
constexpr size_t WS_NAIVE = 2 * MiB;

constexpr int CW_BAR = 4096;
constexpr int PROBE_K = -1;
constexpr int PROBE_FLAGS = 0;
#define RUN(k) (p.ph_lo <= (k) && (k) < p.ph_hi)
constexpr int CW_CNT = 16384, CNT_STRIDE = 64;
constexpr size_t WS_LIST = WS_LISTS;
constexpr size_t WS_TOPIDX = WS_LISTS + 4 * MiB;
constexpr size_t WS_GATEW = WS_LISTS + 4 * MiB + 512 * 1024;

__device__ __forceinline__ float sigmoidf_(float x) { return 1.0f / (1.0f + __expf(-x)); }
__device__ __forceinline__ float siluf_(float x) { return x * sigmoidf_(x); }
__device__ __forceinline__ float gelu_tanh(float x) {
    const float u = 0.7978845608028654f * (x + 0.044715f * x * x * x);
    return x * __builtin_amdgcn_rcpf(1.0f + __expf(-2.0f * u));
}
__device__ __forceinline__ unsigned pk2(float lo, float hi) { unsigned r; asm("v_cvt_pk_bf16_f32 %0, %1, %2" : "=v"(r) : "v"(lo), "v"(hi)); return r; }
__device__ __forceinline__ unsigned f2bf(float f) { return pk2(f, f) & 0xffffu; }
__device__ __forceinline__ float bf2f(unsigned short b) { return __builtin_bit_cast(float, ((unsigned)b) << 16); }
__device__ __forceinline__ float bflo(unsigned w) { return __builtin_bit_cast(float, w << 16); }
__device__ __forceinline__ float bfhi(unsigned w) { return __builtin_bit_cast(float, w & 0xffff0000u); }
#define LDS_WAIT() asm volatile("s_waitcnt lgkmcnt(0)" ::: "memory")
#define VM_WAIT() asm volatile("s_waitcnt vmcnt(0)" ::: "memory")

__device__ __forceinline__ float wave_sum(float v) {
#pragma unroll
    for (int o = 1; o < 64; o <<= 1) v += __shfl_xor(v, o);
    return v;
}
__device__ __forceinline__ float block_sum(float v, float* red) {
    v = wave_sum(v);
    const int w = threadIdx.x >> 6, nw = blockDim.x >> 6;
    __syncthreads();
    if ((threadIdx.x & 63) == 0) red[w] = v;
    __syncthreads();
    float s = 0.f;
    for (int i = 0; i < nw; ++i) s += red[i];
    return s;
}

#define XB_TMO      128
#define XB_XCNT(j)  (256  + 64 * (j))
#define XB_XSUB(j)  (1280 + 64 * (j))
#define XB_XGEN(j)  (2304 + 64 * (j))
#define XB_TOP      3328
#define XB_TOPGEN   3392
#define XCD_BAR_WORDS 3456
#define XB_SPIN_CAP (1u << 18)
__device__ __forceinline__ unsigned xb_ld(unsigned* p)              { return __hip_atomic_load(p, __ATOMIC_RELAXED, __HIP_MEMORY_SCOPE_AGENT); }
__device__ __forceinline__ unsigned xb_add(unsigned* p, unsigned v) { return __hip_atomic_fetch_add(p, v, __ATOMIC_RELAXED, __HIP_MEMORY_SCOPE_AGENT); }
__device__ __forceinline__ unsigned xb_xcc_id() { return (unsigned)__builtin_amdgcn_s_getreg((3 << 11) | 20) & 0xFu; }
#define XB_SPIN(cond, bar) do { unsigned _sp = 0; while (cond) { __builtin_amdgcn_s_sleep(1); \
    if ((++_sp & 255u) == 0u) { if (xb_ld(&(bar)[XB_TMO])) break; if (_sp > XB_SPIN_CAP) { atomicAdd(&(bar)[XB_TMO], 1u); break; } } } } while (0)
struct XcdBarrier { unsigned* bar; unsigned x; volatile LAS unsigned* st; };
__device__ __forceinline__ XcdBarrier xcd_barrier_post(unsigned* bar, volatile LAS unsigned* st) {
    XcdBarrier b; b.bar = bar; b.x = xb_xcc_id(); b.st = st;
    if (threadIdx.x == 0) (void)xb_add(&bar[XB_XCNT(b.x)], 1u);
    return b;
}
__device__ __forceinline__ void xcd_barrier_complete(unsigned* bar, unsigned x, unsigned& nloc, unsigned& nx) {
    const unsigned G = gridDim.x * gridDim.y * gridDim.z;
    unsigned sum, cnt, mine, sp = 0u;
    for (;;) {
        sum = 0u; cnt = 0u; mine = 0u;
#pragma unroll
        for (unsigned j = 0; j < 16; ++j) { const unsigned c = xb_ld(&bar[XB_XCNT(j)]); sum += c; cnt += (c > 0u) ? 1u : 0u; mine = (j == x) ? c : mine; }
        if (sum == G) break;
        __builtin_amdgcn_s_sleep(1);
        if ((++sp & 255u) == 0u) { if (xb_ld(&bar[XB_TMO])) break; if (sp > XB_SPIN_CAP) { atomicAdd(&bar[XB_TMO], 1u); break; } }
    }
    nloc = mine > 0u ? mine : 1u; nx = cnt > 0u ? cnt : 1u;
}
__device__ __forceinline__ void xcd_barrier(const XcdBarrier& b) {
    asm volatile("s_waitcnt vmcnt(0)" ::: "memory");
    __syncthreads();
    if (threadIdx.x == 0) {
        unsigned* bar = b.bar;
        __builtin_amdgcn_s_waitcnt(0);
        unsigned nloc = b.st[0], nx = b.st[1];
        if (nloc == 0u) { xcd_barrier_complete(bar, b.x, nloc, nx); b.st[0] = nloc; b.st[1] = nx; }
        const unsigned old = xb_add(&bar[XB_XSUB(b.x)], 1u);
        const unsigned gen = old / nloc;
        if (old + 1u == (gen + 1u) * nloc) {
            __builtin_amdgcn_fence(__ATOMIC_RELEASE, "agent");
            asm volatile("s_waitcnt vmcnt(0)" ::: "memory");
            const unsigned og = xb_add(&bar[XB_TOP], 1u);
            const unsigned tg = og / nx;
            if (og + 1u == (tg + 1u) * nx) xb_add(&bar[XB_TOPGEN], 1u);
            else XB_SPIN(xb_ld(&bar[XB_TOPGEN]) == tg, bar);
            __builtin_amdgcn_fence(__ATOMIC_ACQUIRE, "agent");
            xb_add(&bar[XB_XGEN(b.x)], 1u);
            asm volatile("s_waitcnt vmcnt(0)" ::: "memory");
        } else {
            XB_SPIN(xb_ld(&bar[XB_XGEN(b.x)]) == gen, bar);
            __builtin_amdgcn_fence(__ATOMIC_ACQUIRE, "agent");
            asm volatile("s_waitcnt vmcnt(0)" ::: "memory");
        }
    }
    __syncthreads();
}

namespace pg8 {
#define PG8_LAS __attribute__((address_space(3)))
constexpr int BM = 256, BK = 64, HALF = 128, HTB = HALF * BK * 2, STAGE_BYTES = 8 * HTB, NXCD = 8, WGM = 8;
__host__ __device__ __forceinline__ int lds_byte(int r, int c) { const int st = (r >> 4) * 2 + (c >> 5), rr = r & 15, cc = c & 31, ob = rr * 64 + cc * 2; return st * 1024 + (ob ^ (((ob >> 9) & 1) << 5)); }
__host__ __device__ __forceinline__ void stage_rc(int b, int& R, int& C) { const int st = b / 1024, sb = b % 1024, swz = sb ^ (((sb >> 9) & 1) << 5); R = (st >> 1) * 16 + swz / 64; C = (st & 1) * 32 + (swz % 64) / 2; }
__host__ __device__ __forceinline__ int perm32(int rho) { const int n = rho >> 4, i = rho & 15; return 8 * (i >> 2) + 4 * n + (i & 3); }

struct Unit { const char* A; const char* B; int pm, pn, e, nvalid, slot; };

struct StaticOrder {
    const char* A; const char* B; int K;
    int nM, nN, nwg, G, c;
    __device__ void init(const void* A_, const void* B_, int M, int N, int K_, int G_, int c_) { A = (const char*)A_; B = (const char*)B_; K = K_; nM = M / BM; nN = N / BM; nwg = nM * nN; G = G_; c = c_; }
    __device__ bool next(int i, Unit& u) const {
        const long L = (long)i * G + c; if (L >= nwg) return false;
        int wgid = (int)L; { const int q = nwg / NXCD, r = nwg % NXCD, xcd = wgid % NXCD, off = wgid / NXCD; wgid = (xcd < r ? xcd * (q + 1) : r * (q + 1) + (xcd - r) * q) + off; }
        const int nig = WGM * nN, gid = wgid / nig, fm = gid * WGM, gsz = (nM - fm) < WGM ? (nM - fm) : WGM;
        u.pm = fm + ((wgid % nig) % gsz); u.pn = (wgid % nig) / gsz; u.e = 0; u.nvalid = BM; u.slot = 0;
        u.A = A + (size_t)u.pm * BM * K * 2; u.B = B + (size_t)u.pn * BM * K * 2; return true;
    }
    __device__ const PG8_LAS int* rowsA(int) const { return nullptr; }
};

__device__ __forceinline__ unsigned cvt_pk_bf16(float lo, float hi) { unsigned r; asm volatile("v_cvt_pk_bf16_f32 %0, %1, %2" : "=v"(r) : "v"(lo), "v"(hi)); return r; }

__device__ __forceinline__ f32x4 mma_bf16(v4u b, v4u a, f32x4 c) { return __builtin_amdgcn_mfma_f32_16x16x32_bf16(__builtin_bit_cast(bf16x8, b), __builtin_bit_cast(bf16x8, a), c, 0, 0, 0); }
__device__ __forceinline__ f32x4 mma_fp8(i32x8 B, i32x8 A, f32x4 c) {
    return __builtin_amdgcn_mfma_scale_f32_16x16x128_f8f6f4(B, A, c, 0, 0, 0, 0x7f7f7f7f, 0, 0x7f7f7f7f);
}
typedef int i32x4 __attribute__((ext_vector_type(4)));
template <class Epi, class Sched, bool ALIGN_EPI, bool GATHER = false, int ESZ = 2>
__device__ __forceinline__ void gemm_phase(PG8_LAS unsigned char* lds, const int K, const Sched& S, const Epi& E) {
    const int tid = threadIdx.x, wid = __builtin_amdgcn_readfirstlane(tid >> 6), lane = tid & 63, wr = wid >> 2, wc = wid & 3, fr = lane & 15, fq = lane >> 4;
    const int rb = K * ESZ; int nt = rb / (BK * 2);
    asm volatile("" : "+s"(nt));
    unsigned voffB[2]; int RA[2], CA[2];
#pragma unroll
    for (int i = 0; i < 2; ++i) { int R, C; stage_rc(tid * 16 + i * 8192, R, C); const int Rb = Epi::PERM ? ((R & ~31) + perm32(R & 31)) : R;
        const int Cb = (ESZ == 2) ? C * 2 : (((C >> 3) & 3) * 32 + (C >> 5) * 16);
        RA[i] = R; CA[i] = Cb; voffB[i] = (unsigned)(Rb * rb + Cb); }
    unsigned cvA0[2], cvA1[2];
#define PG8_SETVA(v0, v1, ui_) do { _Pragma("unroll") for (int _i = 0; _i < 2; ++_i) { \
        v0[_i] = (unsigned)(RA[_i] * rb + CA[_i]); v1[_i] = (unsigned)((HALF + RA[_i]) * rb + CA[_i]); } } while (0)
#define PG8_GVA(v, ui_, h_) do { unsigned _t = threadIdx.x; asm volatile("" : "+v"(_t)); const PG8_LAS int* _rows = S.rowsA(ui_); \
          \
        const unsigned _b = _t * 16u, _st = _b >> 10, _sb = _b & 1023u, _sw = _sb ^ (((_sb >> 9) & 1u) << 5), _R = (_st >> 1) * 16u + (_sw >> 6), _C = (_st & 1u) * 32u + ((_sw & 63u) >> 1); \
        const unsigned _cb = (ESZ == 2) ? _C * 2u : (((_C >> 3) & 3u) * 32u + (_C >> 5) * 16u); \
        _Pragma("unroll") for (int _i = 0; _i < 2; ++_i) v[_i] = (unsigned)(_rows[(h_) * HALF + _R + 64 * _i] * rb) + _cb; } while (0)
    const size_t kstep = (size_t)(BK * 2);
    const size_t hstep = (size_t)HALF * rb;
    const unsigned ldsw = (unsigned)wid * 1024u;
    const int aoff0 = lds_byte(wr * 64 + fr, fq * 8), boff0 = lds_byte(wc * 32 + fr, fq * 8);
    constexpr int CH1 = 1024;
#define PG8_SA(b, h) (((b) * 2 + (h)) * HTB)
#define PG8_SB(b, h) ((4 + (b) * 2 + (h)) * HTB)
#define PG8_STAGE(bufoff, gbase, voff) do { const char* _g = (const char*)(gbase); asm volatile("" : "+s"(_g));     \
        _Pragma("unroll") for (int _i = 0; _i < 2; ++_i) { unsigned _vo = (voff)[_i]; asm volatile("" : "+v"(_vo)); \
        __builtin_amdgcn_global_load_lds((const unsigned*)(_g + _vo), (PG8_LAS unsigned*)(lds + (bufoff) + ldsw + _i * 8192), 16, 0, 0); } } while (0)
#define PG8_LDF(lo_, hi_) __builtin_shufflevector(__builtin_bit_cast(i32x4, *(const PG8_LAS v4u*)(lo_)), __builtin_bit_cast(i32x4, *(const PG8_LAS v4u*)(hi_)), 0, 1, 2, 3, 4, 5, 6, 7)
#define PG8_LDA(dst, b, h) do { _Pragma("unroll") for (int m = 0; m < 4; ++m) dst[m] = PG8_LDF(lds + PG8_SA(b, h) + aoff0 + m * 2048, lds + PG8_SA(b, h) + aoff0 + m * 2048 + CH1); } while (0)
#define PG8_LDB(dst, b, h) do { _Pragma("unroll") for (int n = 0; n < 2; ++n) dst[n] = PG8_LDF(lds + PG8_SB(b, h) + boff0 + n * 2048, lds + PG8_SB(b, h) + boff0 + n * 2048 + CH1); } while (0)
#define PG8_LO(x) __builtin_bit_cast(v4u, __builtin_shufflevector(x, x, 0, 1, 2, 3))
#define PG8_HI(x) __builtin_bit_cast(v4u, __builtin_shufflevector(x, x, 4, 5, 6, 7))
#define PG8_MMA(ai, bj, At, Bt) do { __builtin_amdgcn_s_setprio(1); _Pragma("unroll") for (int m = 0; m < 4; ++m) _Pragma("unroll") for (int n = 0; n < 2; ++n) { \
        if constexpr (ESZ == 2) { acc[ai][bj][m][n] = mma_bf16(PG8_LO(Bt[n]), PG8_LO(At[m]), acc[ai][bj][m][n]); acc[ai][bj][m][n] = mma_bf16(PG8_HI(Bt[n]), PG8_HI(At[m]), acc[ai][bj][m][n]); } \
        else acc[ai][bj][m][n] = mma_fp8(Bt[n], At[m], acc[ai][bj][m][n]); } __builtin_amdgcn_s_setprio(0); } while (0)
#define PG8_WAIT_V(n) asm volatile("s_waitcnt vmcnt(" #n ")" ::: "memory")
#define PG8_WAIT_L(n) asm volatile("s_waitcnt lgkmcnt(" #n ")" ::: "memory")
#define PG8_BAR __builtin_amdgcn_s_barrier()
#define PG8_SCHED __builtin_amdgcn_sched_barrier(0)
    Unit cur, nxt; int ui = 0;
    if (!S.next(0, cur)) return;
    f32x4 acc[2][2][4][2];
#pragma unroll
    for (int a = 0; a < 2; ++a)
#pragma unroll
        for (int b = 0; b < 2; ++b)
#pragma unroll
            for (int m = 0; m < 4; ++m)
#pragma unroll
                for (int n = 0; n < 2; ++n) acc[a][b][m][n] = (f32x4){0.f, 0.f, 0.f, 0.f};
    i32x8 At[4], B0[2], B1[2];
    const char* cA = cur.A; const char* cB = cur.B;
    if constexpr (!GATHER) PG8_SETVA(cvA0, cvA1, 0);
#define PG8_STAGE_A(bufoff, gbase, h_, ui_) do { if constexpr (GATHER) { unsigned _v[2]; PG8_GVA(_v, ui_, h_); PG8_STAGE(bufoff, gbase, _v); } else { if ((h_) == 0) PG8_STAGE(bufoff, gbase, cvA0); else PG8_STAGE(bufoff, gbase, cvA1); } } while (0)
    PG8_STAGE(PG8_SB(0, 0), cB, voffB); PG8_STAGE(PG8_SB(0, 1), cB + hstep, voffB); PG8_STAGE_A(PG8_SA(0, 0), cA, 0, 0); PG8_STAGE_A(PG8_SA(0, 1), cA, 1, 0);
    if (wr == 1) PG8_BAR;
    PG8_WAIT_V(2); PG8_BAR;
    PG8_STAGE(PG8_SB(1, 0), cB + kstep, voffB); PG8_STAGE_A(PG8_SA(1, 0), cA + kstep, 0, 0); PG8_STAGE(PG8_SB(1, 1), cB + hstep + kstep, voffB);
    PG8_WAIT_V(6); PG8_BAR;
    for (;;) {
        const bool has_next = S.next(ui + 1, nxt);
        const char* nA = has_next ? nxt.A : cA; const char* nB = has_next ? nxt.B : cB;
#pragma unroll 1
        for (int t = 0; t < nt; t += 2) {
            const bool last = (t == nt - 2);
            const char* a1 = cA + (size_t)(t + 1) * kstep;
            const char* a2 = last ? nA : cA + (size_t)(t + 2) * kstep; const char* b2 = last ? nB : cB + (size_t)(t + 2) * kstep;
            const char* a3 = a2 + kstep; const char* b3 = b2 + kstep;
            const int un = (last && has_next) ? ui + 1 : ui;
            PG8_LDB(B0, 0, 0); PG8_LDB(B1, 0, 1); PG8_SCHED; PG8_LDA(At, 0, 0); PG8_STAGE_A(PG8_SA(1, 1), a1, 1, ui);
            PG8_WAIT_V(8); PG8_WAIT_L(0); PG8_BAR; PG8_MMA(0, 0, At, B0); PG8_MMA(0, 1, At, B1); PG8_BAR; PG8_SCHED;
            PG8_LDA(At, 0, 1); PG8_STAGE(PG8_SB(0, 0), b2, voffB); PG8_STAGE(PG8_SB(0, 1), b2 + hstep, voffB); PG8_STAGE_A(PG8_SA(0, 0), a2, 0, un);
            PG8_WAIT_V(8); PG8_WAIT_L(0); PG8_BAR; PG8_MMA(1, 0, At, B0); PG8_MMA(1, 1, At, B1); PG8_BAR; PG8_SCHED;
            PG8_LDB(B0, 1, 0); PG8_LDB(B1, 1, 1); PG8_SCHED; PG8_LDA(At, 1, 0); PG8_STAGE_A(PG8_SA(0, 1), a2, 1, un);
            PG8_WAIT_V(8); PG8_WAIT_L(0); PG8_BAR; PG8_MMA(0, 0, At, B0); PG8_MMA(0, 1, At, B1); PG8_BAR; PG8_SCHED;
            PG8_LDA(At, 1, 1); PG8_STAGE(PG8_SB(1, 0), b3, voffB); PG8_STAGE(PG8_SB(1, 1), b3 + hstep, voffB); PG8_STAGE_A(PG8_SA(1, 0), a3, 0, un);
            PG8_WAIT_V(8); PG8_WAIT_L(0); PG8_BAR; PG8_MMA(1, 0, At, B0); PG8_MMA(1, 1, At, B1); PG8_BAR; PG8_SCHED;
        }
        if constexpr (ALIGN_EPI) { if (wr == 0) PG8_BAR; }
        PG8_SCHED; asm volatile("s_nop 15\n\ts_nop 15"); PG8_SCHED;
        E(acc, cur, wr, wc, fr, fq);
        if (!has_next) break;
#pragma unroll
        for (int a = 0; a < 2; ++a)
#pragma unroll
            for (int b = 0; b < 2; ++b)
#pragma unroll
                for (int m = 0; m < 4; ++m)
#pragma unroll
                    for (int n = 0; n < 2; ++n) acc[a][b][m][n] = (f32x4){0.f, 0.f, 0.f, 0.f};
        cur = nxt; cA = nA; cB = nB; ++ui;
        if constexpr (ALIGN_EPI) { if (wr == 1) PG8_BAR; }
    }
    PG8_WAIT_V(0);
    if constexpr (!ALIGN_EPI) { if (wr == 0) PG8_BAR; }
    PG8_BAR;
#undef PG8_SETVA
#undef PG8_GVA
#undef PG8_STAGE_A
#undef PG8_SA
#undef PG8_SB
#undef PG8_STAGE
#undef PG8_LDA
#undef PG8_LDF
#undef PG8_LO
#undef PG8_HI
#undef PG8_LDB
#undef PG8_MMA
#undef PG8_WAIT_V
#undef PG8_WAIT_L
#undef PG8_BAR
#undef PG8_SCHED
}

struct EpiVU {
    static constexpr bool PERM = true;
    bf16* vu;
    __device__ __forceinline__ void operator()(const f32x4 (&acc)[2][2][4][2], const Unit& u, int wr, int wc, int fr, int fq) const {
        const int row0 = u.pm * BM + wr * 64 + fr, cw = wc * 32 + 8 * fq;
#pragma unroll
        for (int ai = 0; ai < 2; ++ai)
#pragma unroll
            for (int m = 0; m < 4; ++m) { bf16* rowp = vu + (size_t)(row0 + ai * HALF + m * 16) * D;
                if (u.pn < 4) {
                    f32x4 a0 = acc[ai][0][m][0], a1 = acc[ai][0][m][1]; const f32x4 g0 = acc[ai][1][m][0], g1 = acc[ai][1][m][1];
#pragma unroll
                    for (int j = 0; j < 4; ++j) { a0[j] *= sigmoidf_(g0[j]); a1[j] *= sigmoidf_(g1[j]); }
                    v4u w; w.x = cvt_pk_bf16(a0[0], a0[1]); w.y = cvt_pk_bf16(a0[2], a0[3]); w.z = cvt_pk_bf16(a1[0], a1[1]); w.w = cvt_pk_bf16(a1[2], a1[3]);
                    *(v4u*)(rowp + u.pn * 128 + cw) = w;
                } else {
#pragma unroll
                    for (int bj = 0; bj < 2; ++bj) { const f32x4 v0 = acc[ai][bj][m][0], v1 = acc[ai][bj][m][1];
                        v4u w; w.x = cvt_pk_bf16(v0[0], v0[1]); w.y = cvt_pk_bf16(v0[2], v0[3]); w.z = cvt_pk_bf16(v1[0], v1[1]); w.w = cvt_pk_bf16(v1[2], v1[3]);
                        *(v4u*)(rowp + 512 + (u.pn - 4) * 256 + bj * HALF + cw) = w; }
                }
            }
    }
};
struct EpiBf16Plain {
    static constexpr bool PERM = true;
    bf16* O; int ldc;
    __device__ __forceinline__ void operator()(const f32x4 (&acc)[2][2][4][2], const Unit& u, int wr, int wc, int fr, int fq) const {
        const int row0 = u.pm * BM + wr * 64 + fr, col0 = u.pn * BM + wc * 32 + 8 * fq;
#pragma unroll
        for (int ai = 0; ai < 2; ++ai)
#pragma unroll
            for (int m = 0; m < 4; ++m) { bf16* rowp = O + (size_t)(row0 + ai * HALF + m * 16) * ldc + col0;
#pragma unroll
                for (int bj = 0; bj < 2; ++bj) { const f32x4 v0 = acc[ai][bj][m][0], v1 = acc[ai][bj][m][1];
                    v4u w; w.x = cvt_pk_bf16(v0[0], v0[1]); w.y = cvt_pk_bf16(v0[2], v0[3]); w.z = cvt_pk_bf16(v1[0], v1[1]); w.w = cvt_pk_bf16(v1[2], v1[3]);
                    *(v4u*)(rowp + bj * HALF) = w; } }
    }
};

constexpr int MOE_TP_OFF = 131072, MOE_DESC_OFF = 131072 + 512, MOE_ROWS_OFF = 131072 + 1024, MOE_MAX_UNITS = 6, MOE_W_OFF = MOE_ROWS_OFF + MOE_MAX_UNITS * 1024;
struct MoeSched {
    const char* Abase; const char* Bbase; PG8_LAS unsigned char* lds; int nlocal, K, mode, esz;
    __device__ bool next(int i, Unit& u) const {
        if (i >= nlocal) return false;
        const int it = mode == 0 ? i : (i >> 1);
        const PG8_LAS int* d = (const PG8_LAS int*)(lds + MOE_DESC_OFF) + it * 8;
        u.e = __builtin_amdgcn_readfirstlane(d[0]); u.pm = __builtin_amdgcn_readfirstlane(d[1]); u.pn = __builtin_amdgcn_readfirstlane(d[2]); u.nvalid = __builtin_amdgcn_readfirstlane(d[3]); u.slot = it;
        if (mode == 0) { u.A = Abase; u.B = Bbase + ((size_t)u.e * 512 + (size_t)u.pn * 256) * 1024 * esz; }
        else { u.pn = 2 * u.pn + (i & 1); u.A = Abase + (size_t)u.pm * 256 * 256 * esz; u.B = Bbase + ((size_t)u.e * 1024 + (size_t)u.pn * 256) * 256 * esz; }
        return true;
    }
    __device__ const PG8_LAS int* rowsA(int i) const { return (const PG8_LAS int*)(lds + MOE_ROWS_OFF) + i * 256; }
};
struct EpiAct {
    static constexpr bool PERM = true;
    unsigned char* act8; float isc;
    __device__ __forceinline__ void operator()(const f32x4 (&acc)[2][2][4][2], const Unit& u, int wr, int wc, int fr, int fq) const {
        const size_t row0 = (size_t)u.pm * BM + wr * 64 + fr; const int col0 = u.pn * 128 + wc * 32 + 8 * fq;
#pragma unroll
        for (int ai = 0; ai < 2; ++ai)
#pragma unroll
            for (int m = 0; m < 4; ++m) {
                float a[8];
#pragma unroll
                for (int j = 0; j < 8; ++j) { const float g = acc[ai][0][m][j >> 2][j & 3] * isc, uu = acc[ai][1][m][j >> 2][j & 3] * (8.0f * isc);
                    a[j] = g * __builtin_amdgcn_rcpf(1.0f + __expf(-g)) * uu; }
                int lo = __builtin_amdgcn_cvt_pk_fp8_f32(a[0], a[1], 0, false); lo = __builtin_amdgcn_cvt_pk_fp8_f32(a[2], a[3], lo, true);
                int hi = __builtin_amdgcn_cvt_pk_fp8_f32(a[4], a[5], 0, false); hi = __builtin_amdgcn_cvt_pk_fp8_f32(a[6], a[7], hi, true);
                *(v2u*)(act8 + (row0 + ai * HALF + m * 16) * 256 + col0) = (v2u){(unsigned)lo, (unsigned)hi};
                asm volatile("" ::: "memory");
            }
    }
};
struct EpiDown {
    static constexpr bool PERM = true;
    unsigned char* yk8; bf16* ycomb; PG8_LAS unsigned char* lds;
    __device__ __forceinline__ void operator()(const f32x4 (&acc)[2][2][4][2], const Unit& u, int wr_, int wc_, int fr_, int fq_) const {
        int t_ = threadIdx.x; asm volatile("" : "+v"(t_));
        const int fr = t_ & 15, fq = (t_ >> 4) & 3, wc = (t_ >> 6) & 3, wr = t_ >> 8;
        const PG8_LAS int* rows = (const PG8_LAS int*)(lds + MOE_ROWS_OFF) + u.slot * 256;
        const PG8_LAS float* wts = (const PG8_LAS float*)(lds + MOE_W_OFF) + u.slot * 256;
        const int col = u.pn * 256 + wc * 32 + 8 * fq;
#pragma unroll
        for (int ai = 0; ai < 2; ++ai)
#pragma unroll
            for (int m = 0; m < 4; ++m) {
                const int id = rows[ai * HALF + wr * 64 + m * 16 + fr];
                if (id >= 0) {
                    if (u.e < 64) {
                        const float w = wts[ai * HALF + wr * 64 + m * 16 + fr] * (16.0f / 128.0f);
                        unsigned char* dst = yk8 + ((unsigned)id * 1024u + (unsigned)col);
#pragma unroll
                        for (int bj = 0; bj < 2; ++bj) { const f32x4 v0 = acc[ai][bj][m][0] * w, v1 = acc[ai][bj][m][1] * w;
                            int lo = __builtin_amdgcn_cvt_pk_fp8_f32(v0[0], v0[1], 0, false); lo = __builtin_amdgcn_cvt_pk_fp8_f32(v0[2], v0[3], lo, true);
                            int hi = __builtin_amdgcn_cvt_pk_fp8_f32(v1[0], v1[1], 0, false); hi = __builtin_amdgcn_cvt_pk_fp8_f32(v1[2], v1[3], hi, true);
                            *(v2u*)(dst + bj * HALF) = (v2u){(unsigned)lo, (unsigned)hi}; }
                    } else {
                        bf16* dst = ycomb + ((unsigned)id * 1024u + (unsigned)col);
#pragma unroll
                        for (int bj = 0; bj < 2; ++bj) { const f32x4 v0 = acc[ai][bj][m][0] * (1.0f / 128.0f), v1 = acc[ai][bj][m][1] * (1.0f / 128.0f);
                            v4u o; o.x = cvt_pk_bf16(v0[0], v0[1]); o.y = cvt_pk_bf16(v0[2], v0[3]); o.z = cvt_pk_bf16(v1[0], v1[1]); o.w = cvt_pk_bf16(v1[2], v1[3]);
                            *(v4u*)(dst + bj * HALF) = o; }
                    }
                }
            }
    }
};
}

struct Params {
    const float* in[34];
    float* out;
    unsigned char* ws;
    int ph_lo, ph_hi, li, flags;
};

__device__ __forceinline__ void transpose_item(const float* W, int ldw, bf16* WT, int ldt, LAS float* scr, int lane) {
#pragma unroll 8
    for (int i = 0; i < 32; ++i) { const int kk = 2 * i + (lane >> 5); scr[kk * 33 + (lane & 31)] = W[(size_t)kk * ldw + (lane & 31)]; }
    LDS_WAIT(); asm volatile("" ::: "memory");
    const int c = lane & 7;
#pragma unroll
    for (int j = 0; j < 4; ++j) { const int n = (lane >> 3) + 8 * j; const LAS float* s = scr + (8 * c) * 33 + n;
        v4u o; o.x = pk2(s[0 * 33], s[1 * 33]); o.y = pk2(s[2 * 33], s[3 * 33]); o.z = pk2(s[4 * 33], s[5 * 33]); o.w = pk2(s[6 * 33], s[7 * 33]);
        *(GAS v4u*)(WT + (size_t)n * ldt + 8 * c) = o; }
    LDS_WAIT(); asm volatile("" ::: "memory");
}

__device__ __forceinline__ void transpose_item_glu(const float* W, int k0, int n0, bf16* WF, LAS float* scr, int lane) {
#pragma unroll 8
    for (int i = 0; i < 32; ++i) { const int kk = 2 * i + (lane >> 5); scr[kk * 33 + (lane & 31)] = W[(size_t)(k0 + kk) * CC + n0 + (lane & 31)]; }
    LDS_WAIT(); asm volatile("" ::: "memory");
    const int c = lane & 7;
#pragma unroll
    for (int j = 0; j < 4; ++j) { const int nl = (lane >> 3) + 8 * j; const LAS float* s = scr + (8 * c) * 33 + nl;
        v4u o; o.x = pk2(s[0 * 33], s[1 * 33]); o.y = pk2(s[2 * 33], s[3 * 33]); o.z = pk2(s[4 * 33], s[5 * 33]); o.w = pk2(s[6 * 33], s[7 * 33]);
        const int n = n0 + nl, k = k0 + 8 * c;
        const int blk = (((n >> 6) * 16 + (k >> 5)) * 4 + ((n >> 4) & 3)), ln = ((k >> 3) & 3) * 16 + (n & 15);
        *(GAS v4u*)(WF + (size_t)blk * 512 + ln * 8) = o; }
    LDS_WAIT(); asm volatile("" ::: "memory");
}

__device__ __forceinline__ void transpose_item8(const float* W, int ldw, unsigned char* WT8, int ldt, float sc, LAS float* scr, int lane) {
#pragma unroll 8
    for (int i = 0; i < 32; ++i) { const int kk = 2 * i + (lane >> 5); scr[kk * 33 + (lane & 31)] = W[(size_t)kk * ldw + (lane & 31)]; }
    LDS_WAIT(); asm volatile("" ::: "memory");
    const int n = lane >> 1, h = lane & 1;
    const LAS float* s = scr + (32 * h) * 33 + n;
    unsigned w[8];
#pragma unroll
    for (int d = 0; d < 8; ++d) { int v = __builtin_amdgcn_cvt_pk_fp8_f32(s[(4 * d) * 33] * sc, s[(4 * d + 1) * 33] * sc, 0, false);
        v = __builtin_amdgcn_cvt_pk_fp8_f32(s[(4 * d + 2) * 33] * sc, s[(4 * d + 3) * 33] * sc, v, true); w[d] = (unsigned)v; }
    *(GAS v4u*)(WT8 + (size_t)n * ldt + 32 * h) = (v4u){w[0], w[1], w[2], w[3]};
    *(GAS v4u*)(WT8 + (size_t)n * ldt + 32 * h + 16) = (v4u){w[4], w[5], w[6], w[7]};
    LDS_WAIT(); asm volatile("" ::: "memory");
}
constexpr int IT_EG = 64 * 128, IT_EU = 64 * 128, IT_ED = 64 * 128, IT_SG = 128, IT_SU = 128, IT_SD = 128, IT_IN = 16 * 48, IT_OUT = 16 * 32, IT_GLU = 8 * 16, IT_RT = 16 * 2;
constexpr int NITEMS_T = IT_EG + IT_EU + IT_ED + IT_SG + IT_SU + IT_SD + IT_IN + IT_OUT + IT_GLU + IT_RT;

__device__ __forceinline__ void p0_convert_item(const Params& p, int it, LAS float* scr, int lane) {
    unsigned char* ws = p.ws;
    bf16* Wgu = (bf16*)(ws + WS_WGU_T); bf16* Wd = (bf16*)(ws + WS_WD_T);
    int r = it;
    if (r < IT_EG + IT_EU) {
        const int up = r >= IT_EG; if (up) r -= IT_EG;
        const int e = r >> 7, q = r & 127, kb = q >> 3, nb = q & 7, k0 = 64 * kb, n0 = 32 * nb;
        const float* src = (up ? p.in[29] : p.in[28]) + (size_t)e * D * DE + (size_t)k0 * DE + n0;
        const int drow = 256 * (n0 >> 7) + (n0 & 127) + (up ? 128 : 0);
        transpose_item8(src, DE, (unsigned char*)Wgu + (size_t)e * 512 * D + (size_t)drow * D + k0, D, 32.0f, scr, lane); return; }
    r -= IT_EG + IT_EU;
    if (r < IT_ED) {
        const int e = r >> 7, q = r & 127, kb = q >> 5, nb = q & 31, k0 = 64 * kb, n0 = 32 * nb;
        transpose_item8(p.in[30] + (size_t)e * DE * D + (size_t)k0 * D + n0, D, (unsigned char*)Wd + (size_t)e * D * DE + (size_t)n0 * DE + k0, DE, 16.0f, scr, lane); return; }
    r -= IT_ED;
    if (r < IT_SG + IT_SU) {
        const int up = r >= IT_SG; if (up) r -= IT_SG;
        const int kb = r >> 3, nb = r & 7, k0 = 64 * kb, n0 = 32 * nb;
        const float* src = (up ? p.in[32] : p.in[31]) + (size_t)k0 * DE + n0;
        const int drow = 256 * (n0 >> 7) + (n0 & 127) + (up ? 128 : 0);
        transpose_item8(src, DE, (unsigned char*)Wgu + (size_t)64 * 512 * D + (size_t)drow * D + k0, D, 32.0f, scr, lane); return; }
    r -= IT_SG + IT_SU;
    if (r < IT_SD) { const int kb = r >> 5, nb = r & 31, k0 = 64 * kb, n0 = 32 * nb;
        transpose_item8(p.in[33] + (size_t)k0 * D + n0, D, (unsigned char*)Wd + (size_t)64 * D * DE + (size_t)n0 * DE + k0, DE, 16.0f, scr, lane); return; }
    r -= IT_SD;
    if (r < IT_IN) { const int kb = r / 48, nb = r % 48, k0 = 64 * kb, n0 = 32 * nb;
        int drow; if (n0 < 512) drow = 256 * (n0 >> 7) + (n0 & 127); else if (n0 < 1024) { const int c = n0 - 512; drow = 256 * (c >> 7) + 128 + (c & 127); } else drow = n0;
        transpose_item(p.in[6] + (size_t)k0 * DIN + n0, DIN, (bf16*)(ws + WS_W_IN_T) + (size_t)drow * D + k0, D, scr, lane); return; }
    r -= IT_IN;
    if (r < IT_OUT) { const int kb = r >> 5, nb = r & 31, k0 = 64 * kb, n0 = 32 * nb;
        transpose_item(p.in[23] + (size_t)k0 * D + n0, D, (bf16*)(ws + WS_W_OUT_T) + (size_t)n0 * D + k0, D, scr, lane); return; }
    r -= IT_OUT;
    if (r < IT_GLU) { const int kb = r >> 4, nb = r & 15, k0 = 64 * kb, n0 = 32 * nb;
        transpose_item_glu(p.in[19], k0, n0, (bf16*)(ws + WS_W_GLU_T), scr, lane); return; }
    r -= IT_GLU;
    { const int kb = r >> 1, nb = r & 1, k0 = 64 * kb, n0 = 32 * nb;
      transpose_item(p.in[26] + (size_t)k0 * NE + n0, NE, (bf16*)(ws + WS_W_RT_T) + (size_t)n0 * D + k0, D, scr, lane); }
}

__device__ __forceinline__ void p0_mod_item(const Params& p, int item, LAS float* red, int tid) {
    const int cg = tid & 7, kr = tid >> 3, j0 = item * 32 + cg * 4;
    const float* c = p.in[1]; const float* w = p.in[2];
    f32x4 a0 = {0.f, 0.f, 0.f, 0.f}, a1 = {0.f, 0.f, 0.f, 0.f};
#pragma unroll 4
    for (int ps = 0; ps < 16; ++ps) { const int k = ps * 64 + kr;
        const f32x4 w4 = *(const f32x4*)(w + (size_t)k * 6 * D + j0);
        const float s0 = siluf_(c[k]), s1 = siluf_(c[D + k]);
        a0 += w4 * s0; a1 += w4 * s1; }
    LAS float* my = red + (kr * 8 + cg) * 8;
    my[0] = a0[0]; my[1] = a0[1]; my[2] = a0[2]; my[3] = a0[3]; my[4] = a1[0]; my[5] = a1[1]; my[6] = a1[2]; my[7] = a1[3];
    __syncthreads();
    if (tid < 64) { const int g = tid >> 3, q = tid & 7; float s = 0.f;
        for (int k2 = 0; k2 < 64; ++k2) s += red[(k2 * 8 + g) * 8 + q];
        const int b = q >> 2, j = item * 32 + g * 4 + (q & 3);
        ((float*)(p.ws + WS_MOD))[b * 6 * D + j] = s + p.in[3][j]; }
    __syncthreads();
}

__device__ __forceinline__ void p1_row(const Params& p, int m, int lane) {
    const int b = m / SEQL;
    const float* mod = (const float*)(p.ws + WS_MOD) + b * 6 * D;
    const GAS f32x4* xr = (const GAS f32x4*)(p.in[0] + (size_t)m * D) + lane;
    f32x4 v[4]; float s = 0.f;
#pragma unroll
    for (int j = 0; j < 4; ++j) { v[j] = xr[64 * j]; s += (v[j].x * v[j].x + v[j].y * v[j].y) + (v[j].z * v[j].z + v[j].w * v[j].w); }
    const float rstd = rsqrtf(wave_sum(s) * (1.f / D) + EPS);
    GAS unsigned long long* o8 = (GAS unsigned long long*)((bf16*)(p.ws + WS_ABUF) + (size_t)m * D) + lane;
#pragma unroll
    for (int j = 0; j < 4; ++j) { const int n = 4 * lane + 256 * j;
        const f32x4 g = *(const f32x4*)(p.in[4] + n), sc = *(const f32x4*)(mod + D + n), sh = *(const f32x4*)(mod + n);
        const f32x4 o = v[j] * rstd * g * (sc + 1.0f) + sh;
        o8[64 * j] = (unsigned long long)pk2(o.x, o.y) | ((unsigned long long)pk2(o.z, o.w) << 32); }
}

typedef float f32x16 __attribute__((ext_vector_type(16)));
__device__ __forceinline__ void p0_ssm_tables_gp(const Params& p, int q  ) {
    const int g = q >> 6;
    const double ar = p.in[11][q], ai = p.in[12][q], dt = exp((double)p.in[13][g]);
    const double mag = exp(ar * dt), lr = mag * cos(ai * dt), li = mag * sin(ai * dt);
    const double den = ar * ar + ai * ai, nr = lr - 1.0;
    const double kr = (nr * ar + li * ai) / den, ki = (li * ar - nr * ai) / den;
    ((f32x2*)(p.ws + WS_LAM))[q] = (f32x2){(float)lr, (float)li};
    double pr = lr, pi = li;
#pragma unroll
    for (int s = 0; s < 5; ++s) { const double nr2 = pr * pr - pi * pi, ni2 = 2.0 * pr * pi; pr = nr2; pi = ni2; }
    ((f32x2*)(p.ws + WS_LAM32))[q] = (f32x2){(float)pr, (float)pi};
    bf16* Bb = (bf16*)(p.ws + WS_BB);
    const int pp = q & 63;
    for (int h = 0; h < 16; ++h) { const double br = p.in[14][q * 16 + h], bi = p.in[15][q * 16 + h];
        Bb[((g * 2 + 0) * 64 + pp) * 16 + h] = (bf16)f2bf((float)(kr * br - ki * bi));
        Bb[((g * 2 + 1) * 64 + pp) * 16 + h] = (bf16)f2bf((float)(kr * bi + ki * br)); }
}
__device__ __forceinline__ void p0_ssm_tables_ct(const Params& p, int idx  ) {
    const int k = idx & 127, gh = idx >> 7;
    const float v = (k < 64) ? p.in[16][gh * 64 + k] : -p.in[17][gh * 64 + (k - 64)];
    ((bf16*)(p.ws + WS_CT))[idx] = (bf16)f2bf(v);
}

__device__ __forceinline__ bf16x8 ssm_load_u(const bf16* vu, int tokA, int tokB, int g, int lane) {
    const int i = lane & 31, kh = lane >> 5;
    const int hf = (i >> 2) & 1, r = (i & 3) + 4 * (i >> 3);
    const int tok = (hf ? tokB : tokA) + r;
    return *(const bf16x8*)(vu + (size_t)tok * D + CC + g * 16 + 8 * kh);
}
#define KEEP_V(x) asm volatile("" :: "v"(x))
#define MFMA_SETTLE1(x) asm volatile("s_nop 15\n\ts_nop 7" : "+v"(x))
#define MFMA_SETTLE_ALL() do { __builtin_amdgcn_sched_barrier(0); asm volatile("s_nop 15\n\ts_nop 15\n\ts_nop 15\n\ts_nop 15"); __builtin_amdgcn_sched_barrier(0); } while (0)
#define MFMA_SETTLE2(x, y) asm volatile("s_nop 15\n\ts_nop 7" : "+v"(x), "+v"(y))
__device__ __forceinline__ f32x16 mfma32(bf16x8 a, bf16x8 b, f32x16 c) { return __builtin_amdgcn_mfma_f32_32x32x16_bf16(a, b, c, 0, 0, 0); }
__device__ __forceinline__ void mfma_roundtrip2(f32x16& x, f32x16& y, LAS float* scr, int lane) {
#pragma unroll
    for (int k = 0; k < 16; ++k) { scr[k * 64 + lane] = x[k]; scr[(16 + k) * 64 + lane] = y[k]; }
    LDS_WAIT(); asm volatile("" ::: "memory");
#pragma unroll
    for (int k = 0; k < 16; ++k) { x[k] = scr[k * 64 + lane]; y[k] = scr[(16 + k) * 64 + lane]; }
    LDS_WAIT(); asm volatile("" ::: "memory");
}
__device__ __forceinline__ void mfma_roundtrip1(f32x16& x, LAS float* scr, int lane) {
#pragma unroll
    for (int k = 0; k < 16; ++k) scr[k * 64 + lane] = x[k];
    LDS_WAIT(); asm volatile("" ::: "memory");
#pragma unroll
    for (int k = 0; k < 16; ++k) x[k] = scr[k * 64 + lane];
    LDS_WAIT(); asm volatile("" ::: "memory");
}
struct SsmGroup { bf16x8 bb[2][2]; f32x2 lam[2]; };
__device__ __forceinline__ void ssm_group_load(const unsigned char* ws, int g, int lane, SsmGroup& G) {
    const bf16* Bb = (const bf16*)(ws + WS_BB);
#pragma unroll
    for (int ri = 0; ri < 2; ++ri)
#pragma unroll
        for (int pb = 0; pb < 2; ++pb) G.bb[ri][pb] = *(const bf16x8*)(Bb + ((g * 2 + ri) * 64 + pb * 32 + (lane & 31)) * 16 + 8 * (lane >> 5));
#pragma unroll
    for (int pb = 0; pb < 2; ++pb) G.lam[pb] = ((const f32x2*)(ws + WS_LAM))[g * 64 + pb * 32 + (lane & 31)];
}

__device__ __forceinline__ void p3a_items(const Params& p, int gw0, int NGW, int lane) {
    const int g = gw0 & 31;
    const bf16* vu = (const bf16*)(p.ws + WS_BBUF);
    SsmGroup G; ssm_group_load(p.ws, g, lane, G);
    const f32x16 z16 = {0.f, 0.f, 0.f, 0.f, 0.f, 0.f, 0.f, 0.f, 0.f, 0.f, 0.f, 0.f, 0.f, 0.f, 0.f, 0.f};
    f32x2* E = (f32x2*)(p.ws + WS_E);
    bf16x8 an[2];
    { const int i0 = gw0 >> 5; an[0] = ssm_load_u(vu, 64 * i0, 64 * i0 + 32, g, lane); an[1] = ssm_load_u(vu, 64 * i0 + 16, 64 * i0 + 48, g, lane); }
    for (int item = gw0; item < 256 * 32; item += NGW) {
        const int i = item >> 5;
        bf16x8 a[2] = {an[0], an[1]};
        if (item + NGW < 256 * 32) { const int i1 = (item + NGW) >> 5; an[0] = ssm_load_u(vu, 64 * i1, 64 * i1 + 32, g, lane); an[1] = ssm_load_u(vu, 64 * i1 + 16, 64 * i1 + 48, g, lane); }
        float sr[2] = {0.f, 0.f}, si[2] = {0.f, 0.f};
#pragma unroll
        for (int blk = 0; blk < 2; ++blk) {
#pragma unroll
            for (int pb = 0; pb < 2; ++pb) {
                f32x16 bur = mfma32(a[blk], G.bb[0][pb], z16);
                f32x16 bui = mfma32(a[blk], G.bb[1][pb], z16);
                MFMA_SETTLE2(bur, bui);
                const float lr = G.lam[pb].x, li = G.lam[pb].y;
#pragma unroll
                for (int r = 0; r < 16; ++r) { float nsr = fmaf(lr, sr[pb], fmaf(-li, si[pb], bur[r])), nsi = fmaf(lr, si[pb], fmaf(li, sr[pb], bui[r])); asm volatile("" : "+v"(nsr)); asm volatile("" : "+v"(nsi)); sr[pb] = nsr; si[pb] = nsi; }
            }
        }
        const int sc = 2 * i + (lane >> 5);
#pragma unroll
        for (int pb = 0; pb < 2; ++pb) E[(size_t)sc * 2048 + g * 64 + pb * 32 + (lane & 31)] = (f32x2){sr[pb], si[pb]};
        asm volatile("" :: "v"(a[0]), "v"(a[1]) : "memory");
    }
    asm volatile("" :: "v"(G.bb[0][0]), "v"(G.bb[0][1]), "v"(G.bb[1][0]), "v"(G.bb[1][1]) : "memory");
}

__device__ __forceinline__ float wave_reduce_scatter16(const float (&v)[16], int lane) {
    float a[8], b[4], c[2], d;
    const bool s5 = (lane & 32) != 0, s4 = (lane & 16) != 0, s3 = (lane & 8) != 0, s2 = (lane & 4) != 0;
#pragma unroll
    for (int i = 0; i < 8; ++i) { const float mine = s5 ? v[8 + i] : v[i], theirs = s5 ? v[i] : v[8 + i]; a[i] = mine + __shfl_xor(theirs, 32); }
#pragma unroll
    for (int i = 0; i < 4; ++i) { const float mine = s4 ? a[4 + i] : a[i], theirs = s4 ? a[i] : a[4 + i]; b[i] = mine + __shfl_xor(theirs, 16); }
#pragma unroll
    for (int i = 0; i < 2; ++i) { const float mine = s3 ? b[2 + i] : b[i], theirs = s3 ? b[i] : b[2 + i]; c[i] = mine + __shfl_xor(theirs, 8); }
    { const float mine = s2 ? c[1] : c[0], theirs = s2 ? c[0] : c[1]; d = mine + __shfl_xor(theirs, 4); }
    d += __shfl_xor(d, 2); d += __shfl_xor(d, 1);
    return d;
}
__device__ __forceinline__ int rs16_token(int lane) { return ((lane >> 5) & 1) * 8 + ((lane >> 4) & 1) * 4 + ((lane >> 3) & 1) * 2 + ((lane >> 2) & 1); }

constexpr int CONV_ROWS = 62, CONV_RED_OFF = CONV_ROWS * 1024, CONV_STAT_OFF = CONV_RED_OFF + 1024, CONV_PART_OFF = CONV_STAT_OFF + 256;
__device__ __forceinline__ void p3_conv_tile(const Params& p, int tile, LAS unsigned char* lds, int tid) {
    const int lane = tid & 63, wave = tid >> 6, cp = tid & 255, th = tid >> 8;
    const int t0 = tile * 32, tl0 = t0 % SEQL;
    const bf16* vu = (const bf16*)(p.ws + WS_BBUF);
    LAS unsigned char* vt = lds;
    LAS float* red = (LAS float*)(lds + CONV_RED_OFF);
    LAS float* stat = (LAS float*)(lds + CONV_STAT_OFF);
    for (int r = wave; r < CONV_ROWS; r += NWAVES) {
        v4u val = {0u, 0u, 0u, 0u};
        if (tl0 + r - 30 >= 0) val = *(const v4u*)(vu + (size_t)(t0 + r - 30) * D + lane * 8);
        *(LAS v4u*)(vt + r * 1024 + lane * 16) = val;
    }
    f32x2 w[31];
#pragma unroll
    for (int j = 0; j < 31; ++j) w[j] = *(const f32x2*)(p.in[7] + j * CC + 2 * cp);
    const f32x2 bias = *(const f32x2*)(p.in[8] + 2 * cp);
    __syncthreads();
    f32x2 acc[16];
#pragma unroll
    for (int o = 0; o < 16; ++o) acc[o] = bias;
#pragma unroll
    for (int s = 0; s < 46; ++s) {
        const unsigned pr = *(const LAS unsigned*)(vt + (16 * th + s) * 1024 + cp * 4);
        const f32x2 v = {bflo(pr), bfhi(pr)};
#pragma unroll
        for (int o = 0; o < 16; ++o) { const int j = s - o; if (j >= 0 && j <= 30) acc[o] += v * w[j]; }
    }
    LAS f32x2* part = (LAS f32x2*)(lds + CONV_PART_OFF);
#pragma unroll
    for (int o = 0; o < 16; ++o) part[(16 * th + o) * 257 + cp] = (f32x2){acc[o].x + acc[o].y, acc[o].x * acc[o].x + acc[o].y * acc[o].y};
    __syncthreads();
    { const int tk = tid >> 4, sub = tid & 15; float s = 0.f, q = 0.f;
#pragma unroll
      for (int i = 0; i < 16; ++i) { const f32x2 v = part[tk * 257 + sub + 16 * i]; s += v.x; q += v.y; }
#pragma unroll
      for (int o = 1; o < 16; o <<= 1) { s += __shfl_xor(s, o); q += __shfl_xor(q, o); }
      if (sub == 0) { const float mu = s * (1.f / CC), var = q * (1.f / CC) - mu * mu; stat[tk * 2] = mu; stat[tk * 2 + 1] = rsqrtf(var + EPS); } }
    __syncthreads();
    const f32x2 lg = *(const f32x2*)(p.in[9] + 2 * cp), lb = *(const f32x2*)(p.in[10] + 2 * cp);
#pragma unroll
    for (int o = 0; o < 16; ++o) { const float mu = stat[(16 * th + o) * 2], rs = stat[(16 * th + o) * 2 + 1];
        f32x2 y = (acc[o] - mu) * rs * lg + lb; y.x = siluf_(y.x); y.y = siluf_(y.y); acc[o] = y;
        part[(16 * th + o) * 257 + cp].x = y.x * y.x + y.y * y.y; }
    __syncthreads();
    { const int tk = tid >> 4, sub = tid & 15; float q = 0.f;
#pragma unroll
      for (int i = 0; i < 16; ++i) q += part[tk * 257 + sub + 16 * i].x;
#pragma unroll
      for (int o = 1; o < 16; o <<= 1) q += __shfl_xor(q, o);
      if (sub == 0) stat[tk * 2] = rsqrtf(q * (1.f / CC) + EPS); }
    __syncthreads();
    const f32x2 go = *(const f32x2*)(p.in[21] + 2 * cp);
    bf16* mixed = (bf16*)(p.ws + WS_ABUF);
#pragma unroll
    for (int o = 0; o < 16; ++o) { const float rs = stat[(16 * th + o) * 2]; const f32x2 y = acc[o] * rs * go;
        *(unsigned*)(mixed + (size_t)(t0 + 16 * th + o) * D + 2 * cp) = pk2(y.x, y.y); }
    __syncthreads();
}

__device__ __forceinline__ void p3b_block(const Params& p, int blk, LAS unsigned char* lds, int tid) {
    const int sl = tid & 15, seg = tid >> 4;
    const int idx = blk * 16 + sl, b = idx >> 11, q = idx & 2047;
    const f32x2 L = ((const f32x2*)(p.ws + WS_LAM32))[q];
    const f32x2* E = (const f32x2*)(p.ws + WS_E) + (size_t)b * 256 * 2048 + q + (size_t)(8 * seg) * 2048;
    f32x2* S = (f32x2*)(p.ws + WS_SINIT) + (size_t)b * 256 * 2048 + q + (size_t)(8 * seg) * 2048;
    f32x2 e[8];
#pragma unroll
    for (int j = 0; j < 8; ++j) e[j] = E[(size_t)j * 2048];
    float pr = L.x, pi = L.y;
#pragma unroll
    for (int s = 0; s < 3; ++s) { const float nr = pr * pr - pi * pi, ni = 2.0f * pr * pi; pr = nr; pi = ni; }
    float xr = 0.f, xi = 0.f;
#pragma unroll
    for (int j = 0; j < 8; ++j) { float nr = fmaf(L.x, xr, fmaf(-L.y, xi, e[j].x)), ni = fmaf(L.x, xi, fmaf(L.y, xr, e[j].y)); asm volatile("" : "+v"(nr)); asm volatile("" : "+v"(ni)); xr = nr; xi = ni; }
    LAS f32x2* xs = (LAS f32x2*)lds;
    xs[sl * 33 + seg] = (f32x2){xr, xi};
    __syncthreads();
    if (tid < 16) {
        f32x2 x[32];
#pragma unroll
        for (int k = 0; k < 32; ++k) x[k] = xs[tid * 33 + k];
        float cr = 0.f, ci = 0.f;
#pragma unroll
        for (int k = 0; k < 32; ++k) { xs[tid * 33 + k] = (f32x2){cr, ci};
            float nr = fmaf(pr, cr, fmaf(-pi, ci, x[k].x)), ni = fmaf(pr, ci, fmaf(pi, cr, x[k].y)); asm volatile("" : "+v"(nr)); asm volatile("" : "+v"(ni)); cr = nr; ci = ni; }
    }
    __syncthreads();
    const f32x2 in = xs[sl * 33 + seg];
    float sr = in.x, si = in.y;
#pragma unroll
    for (int j = 0; j < 8; ++j) { S[(size_t)j * 2048] = (f32x2){sr, si};
        float nr = fmaf(L.x, sr, fmaf(-L.y, si, e[j].x)), ni = fmaf(L.x, si, fmaf(L.y, sr, e[j].y)); asm volatile("" : "+v"(nr)); asm volatile("" : "+v"(ni)); sr = nr; si = ni; }
    __syncthreads();
}

constexpr int P3C_STILE = 32 * 272, P3C_G_OFF = 8 * P3C_STILE, P3C_G_STRIDE = 1040, P3C_RED_OFF = P3C_G_OFF + 64 * P3C_G_STRIDE;
__device__ __forceinline__ void p3c_chunk(const Params& p, int chunk, LAS unsigned char* lds, int tid) {
    const int lane = tid & 63, wave = __builtin_amdgcn_readfirstlane(tid >> 6);
    const int t0 = chunk * 64;
    const bf16* vu = (const bf16*)(p.ws + WS_BBUF);
    LAS unsigned char* st = lds + wave * P3C_STILE;
    LAS unsigned char* gt = lds + P3C_G_OFF;
    const int hf = lane >> 5, j = lane & 31;
    const f32x16 z16 = {0.f, 0.f, 0.f, 0.f, 0.f, 0.f, 0.f, 0.f, 0.f, 0.f, 0.f, 0.f, 0.f, 0.f, 0.f, 0.f};
    const bf16* Ct = (const bf16*)(p.ws + WS_CT);
    for (int gi = 0; gi < ((p.flags & 2) ? 0 : 4); ++gi) {
        const int g = wave * 4 + gi;
        SsmGroup G; ssm_group_load(p.ws, g, lane, G);
        float sr[2], si[2];
        { const f32x2* S0 = (const f32x2*)(p.ws + WS_SINIT) + (size_t)(2 * chunk + hf) * 2048 + g * 64 + j;
          const f32x2 s0 = S0[0], s1 = S0[32]; sr[0] = s0.x; si[0] = s0.y; sr[1] = s1.x; si[1] = s1.y; }
        bf16x8 cb[8];
#pragma unroll
        for (int ks = 0; ks < 8; ++ks) { bf16x8 v = {0, 0, 0, 0, 0, 0, 0, 0}; if (j < 16) v = *(const bf16x8*)(Ct + (size_t)(g * 16 + j) * 128 + ks * 16 + 8 * hf); cb[ks] = v; }
        bf16x8 db = {0, 0, 0, 0, 0, 0, 0, 0};
        if (j < 16 && (j >> 3) == hf) { const unsigned short dv = (unsigned short)f2bf(p.in[18][g * 16 + j]);
#pragma unroll
            for (int e = 0; e < 8; ++e) if ((j & 7) == e) db[e] = (short)dv; }
#pragma unroll
        for (int blk = 0; blk < 2; ++blk) {
            const bf16x8 a = ssm_load_u(vu, t0 + 16 * blk, t0 + 32 + 16 * blk, g, lane);
            f32x16 bur[2], bui[2];
#pragma unroll
            for (int pb = 0; pb < 2; ++pb) {
                bur[pb] = mfma32(a, G.bb[0][pb], z16);
                bui[pb] = mfma32(a, G.bb[1][pb], z16);
                MFMA_SETTLE2(bur[pb], bui[pb]);
            }
#pragma unroll
            for (int pb = 0; pb < 2; ++pb) {
                const float lr = G.lam[pb].x, li = G.lam[pb].y;
#pragma unroll
                for (int r = 0; r < 16; ++r) {
                    float nsr = fmaf(lr, sr[pb], fmaf(-li, si[pb], bur[pb][r])), nsi = fmaf(lr, si[pb], fmaf(li, sr[pb], bui[pb][r])); asm volatile("" : "+v"(nsr)); asm volatile("" : "+v"(nsi)); sr[pb] = nsr; si[pb] = nsi;
                    const int row = (r & 3) + 8 * (r >> 2) + 4 * hf;
                    const unsigned wri = pk2(nsr, nsi);
                    *(LAS unsigned short*)(st + row * 272 + (pb * 32 + j) * 2) = (unsigned short)wri;
                    *(LAS unsigned short*)(st + row * 272 + (64 + pb * 32 + j) * 2) = (unsigned short)(wri >> 16);
                }
            }
            LDS_WAIT(); asm volatile("" ::: "memory");
            f32x16 y = mfma32(a, db, z16);
#pragma unroll
            for (int ks = 0; ks < 8; ++ks) { const bf16x8 sa = *(const LAS bf16x8*)(st + j * 272 + (ks * 16 + 8 * hf) * 2); y = mfma32(sa, cb[ks], y); KEEP_V(sa); }
            MFMA_SETTLE1(y);
            LDS_WAIT(); asm volatile("" ::: "memory");
#pragma unroll
            for (int r = 0; r < 16; ++r) { float yr = y[r]; asm volatile("" : "+v"(yr)); y[r] = yr; }
            KEEP_V(a);
            if (j < 16) {
#pragma unroll
                for (int r = 0; r < 16; r += 2) { const int tokl = 32 * hf + 16 * blk + r; const unsigned w2 = pk2(gelu_tanh(y[r]), gelu_tanh(y[r + 1]));
                    *(LAS unsigned short*)(gt + tokl * P3C_G_STRIDE + (g * 16 + j) * 2) = (unsigned short)w2;
                    *(LAS unsigned short*)(gt + (tokl + 1) * P3C_G_STRIDE + (g * 16 + j) * 2) = (unsigned short)(w2 >> 16); }
            }
            LDS_WAIT(); asm volatile("" ::: "memory");
        }
        KEEP_V(db); KEEP_V(G.bb[0][0]); KEEP_V(G.bb[0][1]); KEEP_V(G.bb[1][0]); KEEP_V(G.bb[1][1]);
#pragma unroll
        for (int ks = 0; ks < 8; ++ks) KEEP_V(cb[ks]);
    }
    __syncthreads();
    if (p.flags & 4) return;
    const int fr = lane & 15, fq = lane >> 4;
    f32x4 acc[4][4];
#pragma unroll
    for (int mf = 0; mf < 4; ++mf)
#pragma unroll
        for (int nf = 0; nf < 4; ++nf) acc[mf][nf] = (f32x4){0.f, 0.f, 0.f, 0.f};
    const bf16* Wg = (const bf16*)(p.ws + WS_W_GLU_T);
#pragma unroll 4
    for (int ks = 0; ks < 16; ++ks) {
        bf16x8 af[4], bfr[4];
#pragma unroll
        for (int nf = 0; nf < 4; ++nf) bfr[nf] = *(const bf16x8*)(Wg + (size_t)((wave * 16 + ks) * 4 + nf) * 512 + lane * 8);
#pragma unroll
        for (int mf = 0; mf < 4; ++mf) af[mf] = *(const LAS bf16x8*)(gt + (16 * mf + fr) * P3C_G_STRIDE + (32 * ks + 8 * fq) * 2);
#pragma unroll
        for (int mf = 0; mf < 4; ++mf)
#pragma unroll
            for (int nf = 0; nf < 4; ++nf) acc[mf][nf] = __builtin_amdgcn_mfma_f32_16x16x32_bf16(bfr[nf], af[mf], acc[mf][nf], 0, 0, 0);
    }
    MFMA_SETTLE_ALL();
    float ssq[4] = {0.f, 0.f, 0.f, 0.f};
#pragma unroll
    for (int nf = 0; nf < 4; ++nf) { const int n0 = 64 * wave + 16 * nf + 4 * fq; const f32x4 bg = *(const f32x4*)(p.in[20] + n0);
#pragma unroll
        for (int mf = 0; mf < 4; ++mf) { const v2u gw = *(const LAS v2u*)(gt + (16 * mf + fr) * P3C_G_STRIDE + n0 * 2);
            const f32x4 gv = {bflo(gw.x), bfhi(gw.x), bflo(gw.y), bfhi(gw.y)}; f32x4 o;
#pragma unroll
            for (int e = 0; e < 4; ++e) { o[e] = gv[e] * sigmoidf_(acc[mf][nf][e] + bg[e]); ssq[mf] += o[e] * o[e]; }
            acc[mf][nf] = o; } }
    LAS float* red = (LAS float*)(lds + P3C_RED_OFF);
#pragma unroll
    for (int mf = 0; mf < 4; ++mf) { float s = ssq[mf]; s += __shfl_xor(s, 16); s += __shfl_xor(s, 32); if (fq == 0) red[wave * 64 + 16 * mf + fr] = s; }
    __syncthreads();
    float rs[4];
#pragma unroll
    for (int mf = 0; mf < 4; ++mf) { float s = 0.f;
#pragma unroll
        for (int wv = 0; wv < 8; ++wv) s += red[wv * 64 + 16 * mf + fr];
        rs[mf] = rsqrtf(s * (1.f / CC) + EPS); }
    bf16* mixed = (bf16*)(p.ws + WS_ABUF);
#pragma unroll
    for (int nf = 0; nf < 4; ++nf) { const int n0 = 64 * wave + 16 * nf + 4 * fq; const f32x4 go = *(const f32x4*)(p.in[22] + n0);
#pragma unroll
        for (int mf = 0; mf < 4; ++mf) { const f32x4 o = acc[mf][nf] * rs[mf] * go;
            v2u w; w.x = pk2(o[0], o[1]); w.y = pk2(o[2], o[3]);
            *(v2u*)(mixed + (size_t)(t0 + 16 * mf + fr) * D + CC + n0) = w; } }
    __syncthreads();
}


constexpr int P4B_HSTRIDE = 2064, P4B_LOGIT_OFF = 32 * P4B_HSTRIDE;
__device__ __forceinline__ float wave_max(float v) {
#pragma unroll
    for (int o = 1; o < 64; o <<= 1) v = fmaxf(v, __shfl_xor(v, o));
    return v;
}
__device__ __forceinline__ void p4b_tile(const Params& p, int tile, LAS unsigned char* lds, int tid) {
    const int lane = tid & 63, wave = __builtin_amdgcn_readfirstlane(tid >> 6);
    const int t0 = tile * 32, b = t0 / SEQL;
    const float* mod = (const float*)(p.ws + WS_MOD) + b * 6 * D;
    const bf16* obuf = (const bf16*)(p.ws + WS_BBUF);
    bf16* h2 = (bf16*)(p.ws + WS_ABUF);
    LAS unsigned char* ht = lds;
    LAS float* logits = (LAS float*)(lds + P4B_LOGIT_OFF);
    const int n0 = 8 * lane, n1 = 512 + 8 * lane;
    {
        f32x4 gp[4], gt[4], gq[4], sc[4], sh[4];
#pragma unroll
        for (int q = 0; q < 4; ++q) { const int n = (q < 2 ? n0 : n1) + 4 * (q & 1);
            gp[q] = *(const f32x4*)(p.in[5] + n); gt[q] = *(const f32x4*)(mod + 2 * D + n); gq[q] = *(const f32x4*)(p.in[24] + n);
            sc[q] = *(const f32x4*)(mod + 4 * D + n) + 1.0f; sh[q] = *(const f32x4*)(mod + 3 * D + n); }
        for (int rr = 0; rr < 4; ++rr) {
            const int row = 4 * wave + rr; const size_t t = (size_t)(t0 + row);
            const v4u o0 = *(const v4u*)(obuf + t * D + n0), o1 = *(const v4u*)(obuf + t * D + n1);
            f32x4 ov[4] = {{bflo(o0.x), bfhi(o0.x), bflo(o0.y), bfhi(o0.y)}, {bflo(o0.z), bfhi(o0.z), bflo(o0.w), bfhi(o0.w)},
                           {bflo(o1.x), bfhi(o1.x), bflo(o1.y), bfhi(o1.y)}, {bflo(o1.z), bfhi(o1.z), bflo(o1.w), bfhi(o1.w)}};
            f32x4 xv[4];
#pragma unroll
            for (int q = 0; q < 4; ++q) xv[q] = *(const f32x4*)(p.in[0] + t * D + (q < 2 ? n0 : n1) + 4 * (q & 1));
            float ss = 0.f;
#pragma unroll
            for (int q = 0; q < 4; ++q) ss += (ov[q].x * ov[q].x + ov[q].y * ov[q].y) + (ov[q].z * ov[q].z + ov[q].w * ov[q].w);
            const float rstd = rsqrtf(wave_sum(ss) * (1.f / D) + EPS);
            float s2 = 0.f;
#pragma unroll
            for (int q = 0; q < 4; ++q) { xv[q] = xv[q] + gt[q] * (ov[q] * rstd * gp[q]); s2 += (xv[q].x * xv[q].x + xv[q].y * xv[q].y) + (xv[q].z * xv[q].z + xv[q].w * xv[q].w);
                *(f32x4*)(p.out + t * D + (q < 2 ? n0 : n1) + 4 * (q & 1)) = xv[q]; }
            const float r2 = rsqrtf(wave_sum(s2) * (1.f / D) + EPS);
            f32x4 hv[4];
#pragma unroll
            for (int q = 0; q < 4; ++q) hv[q] = xv[q] * r2 * gq[q] * sc[q] + sh[q];
            v4u w0, w1;
            w0.x = pk2(hv[0].x, hv[0].y); w0.y = pk2(hv[0].z, hv[0].w); w0.z = pk2(hv[1].x, hv[1].y); w0.w = pk2(hv[1].z, hv[1].w);
            w1.x = pk2(hv[2].x, hv[2].y); w1.y = pk2(hv[2].z, hv[2].w); w1.z = pk2(hv[3].x, hv[3].y); w1.w = pk2(hv[3].z, hv[3].w);
            *(v4u*)(h2 + t * D + n0) = w0; *(v4u*)(h2 + t * D + n1) = w1;
            { unsigned char* h8 = p.ws + WS_H8 + t * D;
              int a0 = __builtin_amdgcn_cvt_pk_fp8_f32(hv[0].x, hv[0].y, 0, false); a0 = __builtin_amdgcn_cvt_pk_fp8_f32(hv[0].z, hv[0].w, a0, true);
              int a1 = __builtin_amdgcn_cvt_pk_fp8_f32(hv[1].x, hv[1].y, 0, false); a1 = __builtin_amdgcn_cvt_pk_fp8_f32(hv[1].z, hv[1].w, a1, true);
              int b0 = __builtin_amdgcn_cvt_pk_fp8_f32(hv[2].x, hv[2].y, 0, false); b0 = __builtin_amdgcn_cvt_pk_fp8_f32(hv[2].z, hv[2].w, b0, true);
              int b1 = __builtin_amdgcn_cvt_pk_fp8_f32(hv[3].x, hv[3].y, 0, false); b1 = __builtin_amdgcn_cvt_pk_fp8_f32(hv[3].z, hv[3].w, b1, true);
              *(v2u*)(h8 + n0) = (v2u){(unsigned)a0, (unsigned)a1}; *(v2u*)(h8 + n1) = (v2u){(unsigned)b0, (unsigned)b1}; }
            *(LAS v4u*)(ht + row * P4B_HSTRIDE + n0 * 2) = w0; *(LAS v4u*)(ht + row * P4B_HSTRIDE + n1 * 2) = w1;
        }
    }
    __syncthreads();
    {
        const int fr = lane & 15, fq = lane >> 4, mf = wave & 1, nf = wave >> 1;
        const bf16* Wr = (const bf16*)(p.ws + WS_W_RT_T);
        f32x4 acc = {0.f, 0.f, 0.f, 0.f};
#pragma unroll 8
        for (int ks = 0; ks < 32; ++ks) {
            const bf16x8 a = *(const LAS bf16x8*)(ht + (16 * mf + fr) * P4B_HSTRIDE + (32 * ks + 8 * fq) * 2);
            const bf16x8 bb = *(const bf16x8*)(Wr + (size_t)(16 * nf + fr) * D + 32 * ks + 8 * fq);
            acc = __builtin_amdgcn_mfma_f32_16x16x32_bf16(a, bb, acc, 0, 0, 0);
        }
        MFMA_SETTLE1(acc);
#pragma unroll
        for (int r = 0; r < 4; ++r) logits[(16 * mf + 4 * fq + r) * 64 + 16 * nf + fr] = acc[r];
    }
    __syncthreads();
    {
        unsigned* cnt = (unsigned*)(p.ws + WS_CTL) + CW_CNT;
        int* list = (int*)(p.ws + WS_LIST);
        int* top_idx = (int*)(p.ws + WS_TOPIDX); float* gate_w = (float*)(p.ws + WS_GATEW);
        LAS unsigned* lcnt = (LAS unsigned*)(lds + P4B_LOGIT_OFF + 8192);
        LAS int* lsel = (LAS int*)(lds + P4B_LOGIT_OFF + 8192 + 256);
        if (tid < 64) lcnt[tid] = 0u;
        __syncthreads();
        const float brt = p.in[27][lane];
        const float NEG = -3.0e38f;
        {
            float s[4], bsc[4], gs[4], masked[4], mysel[4], ssum[4]; int myidx[4];
            const int g = lane >> 3;
#pragma unroll
            for (int rr = 0; rr < 4; ++rr) { s[rr] = sigmoidf_(logits[(4 * wave + rr) * 64 + lane]); bsc[rr] = s[rr] + brt; myidx[rr] = 0; mysel[rr] = 0.f; ssum[rr] = 0.f; }
            float m1[4], m2[4];
#pragma unroll
            for (int rr = 0; rr < 4; ++rr) m1[rr] = bsc[rr];
#pragma unroll
            for (int o = 1; o < 8; o <<= 1) {
#pragma unroll
                for (int rr = 0; rr < 4; ++rr) m1[rr] = fmaxf(m1[rr], __shfl_xor(m1[rr], o)); }
#pragma unroll
            for (int rr = 0; rr < 4; ++rr) { const unsigned long long eq = __ballot(bsc[rr] == m1[rr]);
                const int first = __ffsll((long long)(eq & (0xFFull << (8 * g)))) - 1; m2[rr] = (lane == first) ? NEG : bsc[rr]; }
#pragma unroll
            for (int o = 1; o < 8; o <<= 1) {
#pragma unroll
                for (int rr = 0; rr < 4; ++rr) m2[rr] = fmaxf(m2[rr], __shfl_xor(m2[rr], o)); }
#pragma unroll
            for (int rr = 0; rr < 4; ++rr) gs[rr] = m1[rr] + m2[rr];
            int rank[4] = {0, 0, 0, 0};
#pragma unroll
            for (int j = 0; j < 8; ++j) {
#pragma unroll
                for (int rr = 0; rr < 4; ++rr) { const float gj = __shfl(gs[rr], 8 * j); rank[rr] += (gj > gs[rr] || (gj == gs[rr] && j < g)) ? 1 : 0; } }
#pragma unroll
            for (int rr = 0; rr < 4; ++rr) masked[rr] = (rank[rr] < 4) ? bsc[rr] : NEG;
#pragma unroll
            for (int r = 0; r < 8; ++r) {
                float m[4];
#pragma unroll
                for (int rr = 0; rr < 4; ++rr) m[rr] = masked[rr];
#pragma unroll
                for (int o = 1; o < 64; o <<= 1) {
#pragma unroll
                    for (int rr = 0; rr < 4; ++rr) m[rr] = fmaxf(m[rr], __shfl_xor(m[rr], o)); }
#pragma unroll
                for (int rr = 0; rr < 4; ++rr) {
                    const unsigned long long eb = __ballot(masked[rr] == m[rr]);
                    const int idx = __ffsll((long long)eb) - 1;
                    const float sv = __shfl(s[rr], idx);
                    ssum[rr] += sv;
                    if (lane == r) { myidx[rr] = idx; mysel[rr] = sv; }
                    if (lane == idx) masked[rr] = NEG;
                }
            }
            if (lane < 8) {
#pragma unroll
                for (int rr = 0; rr < 4; ++rr) { const int row = 4 * wave + rr, t = t0 + row;
                    const float w = mysel[rr] / (ssum[rr] + 1e-20f) * 2.5f;
                    top_idx[t * 8 + lane] = myidx[rr]; gate_w[t * 8 + lane] = w;
                    const unsigned lp = __hip_atomic_fetch_add(&lcnt[myidx[rr]], 1u, __ATOMIC_RELAXED, __HIP_MEMORY_SCOPE_WORKGROUP);
                    lsel[row * 8 + lane] = myidx[rr] | ((int)lp << 8); }
            }
        }
        __syncthreads();
        if (tid < 64) { const unsigned c = lcnt[tid]; unsigned base = 0u; if (c) base = atomicAdd(&cnt[tid * CNT_STRIDE], c); lcnt[tid] = base; }
        __syncthreads();
        if (tid < 256) { const int v = lsel[tid], e = v & 255, lp = v >> 8; list[(size_t)e * T + lcnt[e] + lp] = (t0 + (tid >> 3)) * 8 + (tid & 7); }
    }
    __syncthreads();
}


__device__ __forceinline__ int moe_build_units(const Params& p, LAS unsigned char* lds, int tid, int bid, int G, int mode) {
    LAS int* tp = (LAS int*)(lds + pg8::MOE_TP_OFF);
    LAS int* desc = (LAS int*)(lds + pg8::MOE_DESC_OFF);
    LAS int* rows = (LAS int*)(lds + pg8::MOE_ROWS_OFF);
    const unsigned* cnt = (const unsigned*)(p.ws + WS_CTL) + CW_CNT;
    if (tid < 64) {
        const int nt_e = ((int)cnt[tid * CNT_STRIDE] + 255) >> 8; int s = nt_e;
#pragma unroll
        for (int o = 1; o < 64; o <<= 1) { const int v = __shfl_up(s, o); if (tid >= o) s += v; }
        tp[tid] = s - nt_e; if (tid == 63) { tp[64] = s; tp[65] = s + 64; } }
    __syncthreads();
    const int NU = tp[65] * 2;
    int nlocal = 0; for (int u = bid; u < NU; u += G) ++nlocal;
    if (nlocal > pg8::MOE_MAX_UNITS) nlocal = pg8::MOE_MAX_UNITS;
    if (tid < nlocal) { const int u = bid + tid * G, ti = u >> 1, pn = u & 1;
        int e = 0; for (int q = 1; q <= 64; ++q) if (tp[q] <= ti) e = q;
        const int tile = ti - tp[e], n = (e < 64) ? (int)cnt[e * CNT_STRIDE] : T, nv = n - tile * 256;
        desc[tid * 8 + 0] = e; desc[tid * 8 + 1] = ti; desc[tid * 8 + 2] = pn; desc[tid * 8 + 3] = nv > 256 ? 256 : nv; desc[tid * 8 + 4] = tile; }
    __syncthreads();
    const int* list = (const int*)(p.ws + WS_LIST);
    for (int q = tid; q < nlocal * 256; q += NTHREADS) { const int s = q >> 8, r = q & 255;
        const int e = desc[s * 8], tile = desc[s * 8 + 4], nv = desc[s * 8 + 3];
        int id = -1;
        if (r < nv) id = (e < 64) ? list[(size_t)e * T + tile * 256 + r] : tile * 256 + r;
        rows[q] = (mode == 0) ? (id < 0 ? 0 : (e < 64 ? (id >> 3) : id)) : id;
        if (mode == 1) ((LAS float*)(lds + pg8::MOE_W_OFF))[q] = (id >= 0 && e < 64) ? ((const float*)(p.ws + WS_GATEW))[id] : 1.0f; }
    __syncthreads();
    return nlocal;
}

__device__ __forceinline__ void moe_combine_row(const Params& p, int t, int lane) {
    const unsigned char* yk8 = p.ws + WS_WGU_T;
    const bf16* ycomb = (const bf16*)(p.ws + WS_ABUF);
    const int c0 = 16 * lane;
    float a[16];
    { const v4u w0 = *(const v4u*)(ycomb + (size_t)t * D + c0), w1 = *(const v4u*)(ycomb + (size_t)t * D + c0 + 8);
      a[0] = bflo(w0.x); a[1] = bfhi(w0.x); a[2] = bflo(w0.y); a[3] = bfhi(w0.y); a[4] = bflo(w0.z); a[5] = bfhi(w0.z); a[6] = bflo(w0.w); a[7] = bfhi(w0.w);
      a[8] = bflo(w1.x); a[9] = bfhi(w1.x); a[10] = bflo(w1.y); a[11] = bfhi(w1.y); a[12] = bflo(w1.z); a[13] = bfhi(w1.z); a[14] = bflo(w1.w); a[15] = bfhi(w1.w); }
    v4u q[8];
#pragma unroll
    for (int k = 0; k < 8; ++k) q[k] = *(const v4u*)(yk8 + ((size_t)t * 8 + k) * 1024 + c0);
    float r[16];
#pragma unroll
    for (int j = 0; j < 16; ++j) r[j] = 0.f;
#pragma unroll
    for (int k = 0; k < 8; ++k) {
        const unsigned w4[4] = {q[k].x, q[k].y, q[k].z, q[k].w};
#pragma unroll
        for (int d = 0; d < 4; ++d) { const f32x2 lo = __builtin_amdgcn_cvt_pk_f32_fp8((int)w4[d], false), hi = __builtin_amdgcn_cvt_pk_f32_fp8((int)w4[d], true);
            r[4 * d + 0] += lo.x; r[4 * d + 1] += lo.y; r[4 * d + 2] += hi.x; r[4 * d + 3] += hi.y; }
    }
    float ss = 0.f;
#pragma unroll
    for (int j = 0; j < 16; ++j) { a[j] += r[j] * (1.0f / 16.0f); ss += a[j] * a[j]; }
    const float rstd = rsqrtf(wave_sum(ss) * (1.f / D) + EPS);
    const int b = t / SEQL;
    const float* gtf = (const float*)(p.ws + WS_MOD) + b * 6 * D + 5 * D;
    float* o = p.out + (size_t)t * D + c0;
#pragma unroll
    for (int qd = 0; qd < 4; ++qd) { const f32x4 g = *(const f32x4*)(p.in[25] + c0 + 4 * qd), gt = *(const f32x4*)(gtf + c0 + 4 * qd); f32x4 x1 = *(const f32x4*)(o + 4 * qd);
        x1.x += gt.x * (a[4 * qd + 0] * rstd * g.x); x1.y += gt.y * (a[4 * qd + 1] * rstd * g.y); x1.z += gt.z * (a[4 * qd + 2] * rstd * g.z); x1.w += gt.w * (a[4 * qd + 3] * rstd * g.w);
        *(f32x4*)(o + 4 * qd) = x1; }
}

__global__ void __launch_bounds__(NTHREADS, 2) mega(Params p) {
    extern __shared__ __attribute__((aligned(16))) unsigned char lds_raw[];
    LAS unsigned char* lds = (LAS unsigned char*)lds_raw;
    volatile LAS unsigned* MISC = (volatile LAS unsigned*)(lds + MISC_OFF);
    const int tid = threadIdx.x, lane = tid & 63, wave = __builtin_amdgcn_readfirstlane(tid >> 6);
    const int G = gridDim.x, bid = blockIdx.x;
    if (tid < 32) MISC[tid] = 0u;
    __syncthreads();
    unsigned* ctl = (unsigned*)(p.ws + WS_CTL);
    XcdBarrier bar = xcd_barrier_post(ctl + CW_BAR + p.li * XCD_BAR_WORDS, MISC + 8);
    const int gw = bid * NWAVES + wave, NGW = G * NWAVES;

    if (RUN(0)) {
    if (bid < 192) p0_mod_item(p, bid, (LAS float*)lds, tid);
    else if (bid < 196) p0_ssm_tables_gp(p, (bid - 192) * NTHREADS + tid);
    else if (bid < 200) { for (int i = 0; i < 32; ++i) p0_ssm_tables_ct(p, ((bid - 196) * NTHREADS + tid) * 32 + i); }
    {
        LAS float* scr = (LAS float*)(lds + wave * 16384);
        for (int it = gw; it < NITEMS_T; it += NGW) p0_convert_item(p, it, scr, lane);
    }
    }
    xcd_barrier(bar);
    if (RUN(1)) for (int m = gw; m < T; m += NGW) p1_row(p, m, lane);
    xcd_barrier(bar);
    if (RUN(2)) {
        pg8::StaticOrder S; S.init(p.ws + WS_ABUF, p.ws + WS_W_IN_T, T, DIN, D, G, bid);
        pg8::EpiVU E{(bf16*)(p.ws + WS_BBUF)};
        pg8::gemm_phase<pg8::EpiVU, pg8::StaticOrder, true>(lds, D, S, E);
    }
    xcd_barrier(bar);
    if (RUN(3)) {
    p3a_items(p, gw, NGW, lane);
    __syncthreads();
    if (!(p.flags & 8)) for (int tile = bid; tile < T / 32; tile += G) p3_conv_tile(p, tile, lds, tid);
    }
    xcd_barrier(bar);
    if (RUN(4)) for (int blk = bid; blk < 256; blk += G) p3b_block(p, blk, lds, tid);
    xcd_barrier(bar);
    if (RUN(5)) for (int c = bid; c < T / 64; c += G) p3c_chunk(p, c, lds, tid);
    xcd_barrier(bar);
    if (RUN(6)) {
        pg8::StaticOrder S; S.init(p.ws + WS_ABUF, p.ws + WS_W_OUT_T, T, D, D, G, bid);
        pg8::EpiBf16Plain E{(bf16*)(p.ws + WS_BBUF), D};
        pg8::gemm_phase<pg8::EpiBf16Plain, pg8::StaticOrder, true>(lds, D, S, E);
    }
    xcd_barrier(bar);
    if (RUN(7)) for (int tile = bid; tile < T / 32; tile += G) p4b_tile(p, tile, lds, tid);
    xcd_barrier(bar);
    if (RUN(8)) {
        const int nl = moe_build_units(p, lds, tid, bid, G, 0);
        pg8::MoeSched S{(const char*)(p.ws + WS_H8), (const char*)(p.ws + WS_WGU_T), lds, nl, D, 0, 1};
        pg8::EpiAct E{p.ws + WS_ACT, 1.0f / 32.0f};
        pg8::gemm_phase<pg8::EpiAct, pg8::MoeSched, true, true, 1>(lds, D, S, E);
    }
    xcd_barrier(bar);
    if (RUN(9)) {
        const int nl = moe_build_units(p, lds, tid, bid, G, 1);
        pg8::MoeSched S{(const char*)(p.ws + WS_ACT), (const char*)(p.ws + WS_WD_T), lds, 2 * nl, DE, 1, 1};
        pg8::EpiDown E{p.ws + WS_WGU_T, (bf16*)(p.ws + WS_ABUF), lds};
        pg8::gemm_phase<pg8::EpiDown, pg8::MoeSched, true, false, 1>(lds, DE, S, E);
    }
    xcd_barrier(bar);
    if (RUN(10)) { int l10 = lane; asm volatile("" : "+v"(l10));
        for (int t = gw; t < T; t += NGW) moe_combine_row(p, t, l10); }
}

extern "C" void kernel_launch(void* const* d_in, const int* in_sizes, int n_in, void* d_out, int out_size, void* d_ws, size_t ws_size, hipStream_t stream) {
    static int grid = 0;
    if (grid == 0) {
        int dev = 0, cus = 0;
        if (n_in != 34 || out_size != T * D || ws_size < WS_END) { grid = -1; return; }
        if (hipGetDevice(&dev) != hipSuccess || hipDeviceGetAttribute(&cus, hipDeviceAttributeMultiprocessorCount, dev) != hipSuccess) { grid = -1; return; }
        if (hipFuncSetAttribute((const void*)mega, hipFuncAttributeMaxDynamicSharedMemorySize, LDS_BYTES) != hipSuccess) { grid = -1; return; }
        (void)hipGetLastError();
        grid = cus;
    }
    if (grid < 0) return;
    (void)hipMemsetAsync((char*)d_ws + WS_CTL, 0, CTL_ZERO_BYTES, stream);
    Params p{};
    for (int i = 0; i < 34; ++i) p.in[i] = (const float*)d_in[i];
    p.out = (float*)d_out; p.ws = (unsigned char*)d_ws; p.ph_lo = 0; p.ph_hi = 99;
    hipLaunchKernelGGL(mega, dim3(grid), dim3(NTHREADS), LDS_BYTES, stream, p);
    if (PROBE_K >= 0 && PROBE_K < 60) { Params q = p; q.ph_lo = PROBE_K; q.ph_hi = PROBE_K + 1; q.li = 1; q.flags = PROBE_FLAGS; hipLaunchKernelGGL(mega, dim3(grid), dim3(NTHREADS), LDS_BYTES, stream, q); }

}
```

```cpp
#include <hip/hip_runtime.h>
#include <cstdio>
#include <cstdint>

#define GAS __attribute__((address_space(1)))
#define LAS __attribute__((address_space(3)))
typedef unsigned short bf16;
typedef unsigned v4u __attribute__((ext_vector_type(4)));
typedef unsigned v2u __attribute__((ext_vector_type(2)));
typedef float f32x4 __attribute__((ext_vector_type(4)));
typedef float f32x2 __attribute__((ext_vector_type(2)));
typedef short bf16x8 __attribute__((ext_vector_type(8)));
typedef int i32x8 __attribute__((ext_vector_type(8)));

constexpr int T = 16384, D = 1024, SEQL = 8192, DIN = 1536, CC = 512, NE = 64, DE = 256;
constexpr float EPS = 1e-6f;
constexpr int NTHREADS = 512, NWAVES = 8;
constexpr int LDS_BYTES = 147456;
constexpr int RING_BYTES = 131072, MISC_OFF = LDS_BYTES - 512;

constexpr size_t MiB = 1u << 20;
constexpr size_t WS_CTL = 0, CTL_ZERO_BYTES = 1 * MiB;
constexpr size_t WS_MOD = 1 * MiB;
constexpr size_t WS_LAM = WS_MOD + 64 * 1024;
constexpr size_t WS_LAM32 = WS_MOD + 80 * 1024;
constexpr size_t WS_BB = WS_MOD + 96 * 1024;
constexpr size_t WS_CT = WS_MOD + 224 * 1024;
constexpr size_t WS_WD_T = 2 * MiB;
constexpr size_t WS_LISTS = 35 * MiB;
constexpr size_t WS_ABUF = 41 * MiB;
constexpr size_t WS_ACT = 73 * MiB;
constexpr size_t WS_WGU_T = 153 * MiB;
constexpr size_t WS_W_IN_T = 218 * MiB;
constexpr size_t WS_W_OUT_T = 221 * MiB;
constexpr size_t WS_W_GLU_T = 223 * MiB;
constexpr size_t WS_W_RT_T = 223 * MiB + 512 * 1024;
constexpr size_t WS_H8 = 190 * MiB;
constexpr size_t WS_E = 224 * MiB;
constexpr size_t WS_SINIT = 232 * MiB;
constexpr size_t WS_BBUF = 240 * MiB;
constexpr size_t WS_END = 281 * MiB;
constexpr size_t WS_NAIVE = 2 * MiB;

constexpr int CW_BAR = 4096;
constexpr int PROBE_K = -1;
constexpr int PROBE_FLAGS = 0;
#define RUN(k) (p.ph_lo <= (k) && (k) < p.ph_hi)
constexpr int CW_CNT = 16384, CNT_STRIDE = 64;
constexpr size_t WS_LIST = WS_LISTS;
constexpr size_t WS_TOPIDX = WS_LISTS + 4 * MiB;
constexpr size_t WS_GATEW = WS_LISTS + 4 * MiB + 512 * 1024;

__device__ __forceinline__ float sigmoidf_(float x) { return 1.0f / (1.0f + __expf(-x)); }
__device__ __forceinline__ float siluf_(float x) { return x * sigmoidf_(x); }
__device__ __forceinline__ float gelu_tanh(float x) {
    const float u = 0.7978845608028654f * (x + 0.044715f * x * x * x);
    return x * __builtin_amdgcn_rcpf(1.0f + __expf(-2.0f * u));
}
__device__ __forceinline__ unsigned pk2(float lo, float hi) { unsigned r; asm("v_cvt_pk_bf16_f32 %0, %1, %2" : "=v"(r) : "v"(lo), "v"(hi)); return r; }
__device__ __forceinline__ unsigned f2bf(float f) { return pk2(f, f) & 0xffffu; }
__device__ __forceinline__ float bf2f(unsigned short b) { return __builtin_bit_cast(float, ((unsigned)b) << 16); }
__device__ __forceinline__ float bflo(unsigned w) { return __builtin_bit_cast(float, w << 16); }
__device__ __forceinline__ float bfhi(unsigned w) { return __builtin_bit_cast(float, w & 0xffff0000u); }
#define LDS_WAIT() asm volatile("s_waitcnt lgkmcnt(0)" ::: "memory")
#define VM_WAIT() asm volatile("s_waitcnt vmcnt(0)" ::: "memory")

__device__ __forceinline__ float wave_sum(float v) {
#pragma unroll
    for (int o = 1; o < 64; o <<= 1) v += __shfl_xor(v, o);
    return v;
}
__device__ __forceinline__ float block_sum(float v, float* red) {
    v = wave_sum(v);
    const int w = threadIdx.x >> 6, nw = blockDim.x >> 6;
    __syncthreads();
    if ((threadIdx.x & 63) == 0) red[w] = v;
    __syncthreads();
    float s = 0.f;
    for (int i = 0; i < nw; ++i) s += red[i];
    return s;
}

#define XB_TMO      128
#define XB_XCNT(j)  (256  + 64 * (j))
#define XB_XSUB(j)  (1280 + 64 * (j))
#define XB_XGEN(j)  (2304 + 64 * (j))
#define XB_TOP      3328
#define XB_TOPGEN   3392
#define XCD_BAR_WORDS 3456
#define XB_SPIN_CAP (1u << 18)
__device__ __forceinline__ unsigned xb_ld(unsigned* p)              { return __hip_atomic_load(p, __ATOMIC_RELAXED, __HIP_MEMORY_SCOPE_AGENT); }
__device__ __forceinline__ unsigned xb_add(unsigned* p, unsigned v) { return __hip_atomic_fetch_add(p, v, __ATOMIC_RELAXED, __HIP_MEMORY_SCOPE_AGENT); }
__device__ __forceinline__ unsigned xb_xcc_id() { return (unsigned)__builtin_amdgcn_s_getreg((3 << 11) | 20) & 0xFu; }
#define XB_SPIN(cond, bar) do { unsigned _sp = 0; while (cond) { __builtin_amdgcn_s_sleep(1); \
    if ((++_sp & 255u) == 0u) { if (xb_ld(&(bar)[XB_TMO])) break; if (_sp > XB_SPIN_CAP) { atomicAdd(&(bar)[XB_TMO], 1u); break; } } } } while (0)
struct XcdBarrier { unsigned* bar; unsigned x; volatile LAS unsigned* st; };
__device__ __forceinline__ XcdBarrier xcd_barrier_post(unsigned* bar, volatile LAS unsigned* st) {
    XcdBarrier b; b.bar = bar; b.x = xb_xcc_id(); b.st = st;
    if (threadIdx.x == 0) (void)xb_add(&bar[XB_XCNT(b.x)], 1u);
    return b;
}
__device__ __forceinline__ void xcd_barrier_complete(unsigned* bar, unsigned x, unsigned& nloc, unsigned& nx) {
    const unsigned G = gridDim.x * gridDim.y * gridDim.z;
    unsigned sum, cnt, mine, sp = 0u;
    for (;;) {
        sum = 0u; cnt = 0u; mine = 0u;
#pragma unroll
        for (unsigned j = 0; j < 16; ++j) { const unsigned c = xb_ld(&bar[XB_XCNT(j)]); sum += c; cnt += (c > 0u) ? 1u : 0u; mine = (j == x) ? c : mine; }
        if (sum == G) break;
        __builtin_amdgcn_s_sleep(1);
        if ((++sp & 255u) == 0u) { if (xb_ld(&bar[XB_TMO])) break; if (sp > XB_SPIN_CAP) { atomicAdd(&bar[XB_TMO], 1u); break; } }
    }
    nloc = mine > 0u ? mine : 1u; nx = cnt > 0u ? cnt : 1u;
}
__device__ __forceinline__ void xcd_barrier(const XcdBarrier& b) {
    asm volatile("s_waitcnt vmcnt(0)" ::: "memory");
    __syncthreads();
    if (threadIdx.x == 0) {
        unsigned* bar = b.bar;
        __builtin_amdgcn_s_waitcnt(0);
        unsigned nloc = b.st[0], nx = b.st[1];
        if (nloc == 0u) { xcd_barrier_complete(bar, b.x, nloc, nx); b.st[0] = nloc; b.st[1] = nx; }
        const unsigned old = xb_add(&bar[XB_XSUB(b.x)], 1u);
        const unsigned gen = old / nloc;
        if (old + 1u == (gen + 1u) * nloc) {
            __builtin_amdgcn_fence(__ATOMIC_RELEASE, "agent");
            asm volatile("s_waitcnt vmcnt(0)" ::: "memory");
            const unsigned og = xb_add(&bar[XB_TOP], 1u);
            const unsigned tg = og / nx;
            if (og + 1u == (tg + 1u) * nx) xb_add(&bar[XB_TOPGEN], 1u);
            else XB_SPIN(xb_ld(&bar[XB_TOPGEN]) == tg, bar);
            __builtin_amdgcn_fence(__ATOMIC_ACQUIRE, "agent");
            xb_add(&bar[XB_XGEN(b.x)], 1u);
            asm volatile("s_waitcnt vmcnt(0)" ::: "memory");
        } else {
            XB_SPIN(xb_ld(&bar[XB_XGEN(b.x)]) == gen, bar);
            __builtin_amdgcn_fence(__ATOMIC_ACQUIRE, "agent");
            asm volatile("s_waitcnt vmcnt(0)" ::: "memory");
        }
    }
    __syncthreads();
}

namespace pg8 {
#define PG8_LAS __attribute__((address_space(3)))
constexpr int BM = 256, BK = 64, HALF = 128, HTB = HALF * BK * 2, STAGE_BYTES = 8 * HTB, NXCD = 8, WGM = 8;
__host__ __device__ __forceinline__ int lds_byte(int r, int c) { const int st = (r >> 4) * 2 + (c >> 5), rr = r & 15, cc = c & 31, ob = rr * 64 + cc * 2; return st * 1024 + (ob ^ (((ob >> 9) & 1) << 5)); }
__host__ __device__ __forceinline__ void stage_rc(int b, int& R, int& C) { const int st = b / 1024, sb = b % 1024, swz = sb ^ (((sb >> 9) & 1) << 5); R = (st >> 1) * 16 + swz / 64; C = (st & 1) * 32 + (swz % 64) / 2; }
__host__ __device__ __forceinline__ int perm32(int rho) { const int n = rho >> 4, i = rho & 15; return 8 * (i >> 2) + 4 * n + (i & 3); }

struct Unit { const char* A; const char* B; int pm, pn, e, nvalid, slot; };

struct StaticOrder {
    const char* A; const char* B; int K;
    int nM, nN, nwg, G, c;
    __device__ void init(const void* A_, const void* B_, int M, int N, int K_, int G_, int c_) { A = (const char*)A_; B = (const char*)B_; K = K_; nM = M / BM; nN = N / BM; nwg = nM * nN; G = G_; c = c_; }
    __device__ bool next(int i, Unit& u) const {
        const long L = (long)i * G + c; if (L >= nwg) return false;
        int wgid = (int)L; { const int q = nwg / NXCD, r = nwg % NXCD, xcd = wgid % NXCD, off = wgid / NXCD; wgid = (xcd < r ? xcd * (q + 1) : r * (q + 1) + (xcd - r) * q) + off; }
        const int nig = WGM * nN, gid = wgid / nig, fm = gid * WGM, gsz = (nM - fm) < WGM ? (nM - fm) : WGM;
        u.pm = fm + ((wgid % nig) % gsz); u.pn = (wgid % nig) / gsz; u.e = 0; u.nvalid = BM; u.slot = 0;
        u.A = A + (size_t)u.pm * BM * K * 2; u.B = B + (size_t)u.pn * BM * K * 2; return true;
    }
    __device__ const PG8_LAS int* rowsA(int) const { return nullptr; }
};

__device__ __forceinline__ unsigned cvt_pk_bf16(float lo, float hi) { unsigned r; asm volatile("v_cvt_pk_bf16_f32 %0, %1, %2" : "=v"(r) : "v"(lo), "v"(hi)); return r; }

__device__ __forceinline__ f32x4 mma_bf16(v4u b, v4u a, f32x4 c) { return __builtin_amdgcn_mfma_f32_16x16x32_bf16(__builtin_bit_cast(bf16x8, b), __builtin_bit_cast(bf16x8, a), c, 0, 0, 0); }
__device__ __forceinline__ f32x4 mma_fp8(i32x8 B, i32x8 A, f32x4 c) {
    return __builtin_amdgcn_mfma_scale_f32_16x16x128_f8f6f4(B, A, c, 0, 0, 0, 0x7f7f7f7f, 0, 0x7f7f7f7f);
}
typedef int i32x4 __attribute__((ext_vector_type(4)));
template <class Epi, class Sched, bool ALIGN_EPI, bool GATHER = false, int ESZ = 2>
__device__ __forceinline__ void gemm_phase(PG8_LAS unsigned char* lds, const int K, const Sched& S, const Epi& E) {
    const int tid = threadIdx.x, wid = __builtin_amdgcn_readfirstlane(tid >> 6), lane = tid & 63, wr = wid >> 2, wc = wid & 3, fr = lane & 15, fq = lane >> 4;
    const int rb = K * ESZ; int nt = rb / (BK * 2);
    asm volatile("" : "+s"(nt));
    unsigned voffB[2]; int RA[2], CA[2];
#pragma unroll
    for (int i = 0; i < 2; ++i) { int R, C; stage_rc(tid * 16 + i * 8192, R, C); const int Rb = Epi::PERM ? ((R & ~31) + perm32(R & 31)) : R;
        const int Cb = (ESZ == 2) ? C * 2 : (((C >> 3) & 3) * 32 + (C >> 5) * 16);
        RA[i] = R; CA[i] = Cb; voffB[i] = (unsigned)(Rb * rb + Cb); }
    unsigned cvA0[2], cvA1[2];
#define PG8_SETVA(v0, v1, ui_) do { _Pragma("unroll") for (int _i = 0; _i < 2; ++_i) { \
        v0[_i] = (unsigned)(RA[_i] * rb + CA[_i]); v1[_i] = (unsigned)((HALF + RA[_i]) * rb + CA[_i]); } } while (0)
#define PG8_GVA(v, ui_, h_) do { unsigned _t = threadIdx.x; asm volatile("" : "+v"(_t)); const PG8_LAS int* _rows = S.rowsA(ui_); \
          \
        const unsigned _b = _t * 16u, _st = _b >> 10, _sb = _b & 1023u, _sw = _sb ^ (((_sb >> 9) & 1u) << 5), _R = (_st >> 1) * 16u + (_sw >> 6), _C = (_st & 1u) * 32u + ((_sw & 63u) >> 1); \
        const unsigned _cb = (ESZ == 2) ? _C * 2u : (((_C >> 3) & 3u) * 32u + (_C >> 5) * 16u); \
        _Pragma("unroll") for (int _i = 0; _i < 2; ++_i) v[_i] = (unsigned)(_rows[(h_) * HALF + _R + 64 * _i] * rb) + _cb; } while (0)
    const size_t kstep = (size_t)(BK * 2);
    const size_t hstep = (size_t)HALF * rb;
    const unsigned ldsw = (unsigned)wid * 1024u;
    const int aoff0 = lds_byte(wr * 64 + fr, fq * 8), boff0 = lds_byte(wc * 32 + fr, fq * 8);
    constexpr int CH1 = 1024;
#define PG8_SA(b, h) (((b) * 2 + (h)) * HTB)
#define PG8_SB(b, h) ((4 + (b) * 2 + (h)) * HTB)
#define PG8_STAGE(bufoff, gbase, voff) do { const char* _g = (const char*)(gbase); asm volatile("" : "+s"(_g));     \
        _Pragma("unroll") for (int _i = 0; _i < 2; ++_i) { unsigned _vo = (voff)[_i]; asm volatile("" : "+v"(_vo)); \
        __builtin_amdgcn_global_load_lds((const unsigned*)(_g + _vo), (PG8_LAS unsigned*)(lds + (bufoff) + ldsw + _i * 8192), 16, 0, 0); } } while (0)
#define PG8_LDF(lo_, hi_) __builtin_shufflevector(__builtin_bit_cast(i32x4, *(const PG8_LAS v4u*)(lo_)), __builtin_bit_cast(i32x4, *(const PG8_LAS v4u*)(hi_)), 0, 1, 2, 3, 4, 5, 6, 7)
#define PG8_LDA(dst, b, h) do { _Pragma("unroll") for (int m = 0; m < 4; ++m) dst[m] = PG8_LDF(lds + PG8_SA(b, h) + aoff0 + m * 2048, lds + PG8_SA(b, h) + aoff0 + m * 2048 + CH1); } while (0)
#define PG8_LDB(dst, b, h) do { _Pragma("unroll") for (int n = 0; n < 2; ++n) dst[n] = PG8_LDF(lds + PG8_SB(b, h) + boff0 + n * 2048, lds + PG8_SB(b, h) + boff0 + n * 2048 + CH1); } while (0)
#define PG8_LO(x) __builtin_bit_cast(v4u, __builtin_shufflevector(x, x, 0, 1, 2, 3))
#define PG8_HI(x) __builtin_bit_cast(v4u, __builtin_shufflevector(x, x, 4, 5, 6, 7))
#define PG8_MMA(ai, bj, At, Bt) do { __builtin_amdgcn_s_setprio(1); _Pragma("unroll") for (int m = 0; m < 4; ++m) _Pragma("unroll") for (int n = 0; n < 2; ++n) { \
        if constexpr (ESZ == 2) { acc[ai][bj][m][n] = mma_bf16(PG8_LO(Bt[n]), PG8_LO(At[m]), acc[ai][bj][m][n]); acc[ai][bj][m][n] = mma_bf16(PG8_HI(Bt[n]), PG8_HI(At[m]), acc[ai][bj][m][n]); } \
        else acc[ai][bj][m][n] = mma_fp8(Bt[n], At[m], acc[ai][bj][m][n]); } __builtin_amdgcn_s_setprio(0); } while (0)
#define PG8_WAIT_V(n) asm volatile("s_waitcnt vmcnt(" #n ")" ::: "memory")
#define PG8_WAIT_L(n) asm volatile("s_waitcnt lgkmcnt(" #n ")" ::: "memory")
#define PG8_BAR __builtin_amdgcn_s_barrier()
#define PG8_SCHED __builtin_amdgcn_sched_barrier(0)
    Unit cur, nxt; int ui = 0;
    if (!S.next(0, cur)) return;
    f32x4 acc[2][2][4][2];
#pragma unroll
    for (int a = 0; a < 2; ++a)
#pragma unroll
        for (int b = 0; b < 2; ++b)
#pragma unroll
            for (int m = 0; m < 4; ++m)
#pragma unroll
                for (int n = 0; n < 2; ++n) acc[a][b][m][n] = (f32x4){0.f, 0.f, 0.f, 0.f};
    i32x8 At[4], B0[2], B1[2];
    const char* cA = cur.A; const char* cB = cur.B;
    if constexpr (!GATHER) PG8_SETVA(cvA0, cvA1, 0);
#define PG8_STAGE_A(bufoff, gbase, h_, ui_) do { if constexpr (GATHER) { unsigned _v[2]; PG8_GVA(_v, ui_, h_); PG8_STAGE(bufoff, gbase, _v); } else { if ((h_) == 0) PG8_STAGE(bufoff, gbase, cvA0); else PG8_STAGE(bufoff, gbase, cvA1); } } while (0)
    PG8_STAGE(PG8_SB(0, 0), cB, voffB); PG8_STAGE(PG8_SB(0, 1), cB + hstep, voffB); PG8_STAGE_A(PG8_SA(0, 0), cA, 0, 0); PG8_STAGE_A(PG8_SA(0, 1), cA, 1, 0);
    if (wr == 1) PG8_BAR;
    PG8_WAIT_V(2); PG8_BAR;
    PG8_STAGE(PG8_SB(1, 0), cB + kstep, voffB); PG8_STAGE_A(PG8_SA(1, 0), cA + kstep, 0, 0); PG8_STAGE(PG8_SB(1, 1), cB + hstep + kstep, voffB);
    PG8_WAIT_V(6); PG8_BAR;
    for (;;) {
        const bool has_next = S.next(ui + 1, nxt);
        const char* nA = has_next ? nxt.A : cA; const char* nB = has_next ? nxt.B : cB;
#pragma unroll 1
        for (int t = 0; t < nt; t += 2) {
            const bool last = (t == nt - 2);
            const char* a1 = cA + (size_t)(t + 1) * kstep;
            const char* a2 = last ? nA : cA + (size_t)(t + 2) * kstep; const char* b2 = last ? nB : cB + (size_t)(t + 2) * kstep;
            const char* a3 = a2 + kstep; const char* b3 = b2 + kstep;
            const int un = (last && has_next) ? ui + 1 : ui;
            PG8_LDB(B0, 0, 0); PG8_LDB(B1, 0, 1); PG8_SCHED; PG8_LDA(At, 0, 0); PG8_STAGE_A(PG8_SA(1, 1), a1, 1, ui);
            PG8_WAIT_V(8); PG8_WAIT_L(0); PG8_BAR; PG8_MMA(0, 0, At, B0); PG8_MMA(0, 1, At, B1); PG8_BAR; PG8_SCHED;
            PG8_LDA(At, 0, 1); PG8_STAGE(PG8_SB(0, 0), b2, voffB); PG8_STAGE(PG8_SB(0, 1), b2 + hstep, voffB); PG8_STAGE_A(PG8_SA(0, 0), a2, 0, un);
            PG8_WAIT_V(8); PG8_WAIT_L(0); PG8_BAR; PG8_MMA(1, 0, At, B0); PG8_MMA(1, 1, At, B1); PG8_BAR; PG8_SCHED;
            PG8_LDB(B0, 1, 0); PG8_LDB(B1, 1, 1); PG8_SCHED; PG8_LDA(At, 1, 0); PG8_STAGE_A(PG8_SA(0, 1), a2, 1, un);
            PG8_WAIT_V(8); PG8_WAIT_L(0); PG8_BAR; PG8_MMA(0, 0, At, B0); PG8_MMA(0, 1, At, B1); PG8_BAR; PG8_SCHED;
            PG8_LDA(At, 1, 1); PG8_STAGE(PG8_SB(1, 0), b3, voffB); PG8_STAGE(PG8_SB(1, 1), b3 + hstep, voffB); PG8_STAGE_A(PG8_SA(1, 0), a3, 0, un);
            PG8_WAIT_V(8); PG8_WAIT_L(0); PG8_BAR; PG8_MMA(1, 0, At, B0); PG8_MMA(1, 1, At, B1); PG8_BAR; PG8_SCHED;
        }
        if constexpr (ALIGN_EPI) { if (wr == 0) PG8_BAR; }
        PG8_SCHED; asm volatile("s_nop 15\n\ts_nop 15"); PG8_SCHED;
        E(acc, cur, wr, wc, fr, fq);
        if (!has_next) break;
#pragma unroll
        for (int a = 0; a < 2; ++a)
#pragma unroll
            for (int b = 0; b < 2; ++b)
#pragma unroll
                for (int m = 0; m < 4; ++m)
#pragma unroll
                    for (int n = 0; n < 2; ++n) acc[a][b][m][n] = (f32x4){0.f, 0.f, 0.f, 0.f};
        cur = nxt; cA = nA; cB = nB; ++ui;
        if constexpr (ALIGN_EPI) { if (wr == 1) PG8_BAR; }
    }
    PG8_WAIT_V(0);
    if constexpr (!ALIGN_EPI) { if (wr == 0) PG8_BAR; }
    PG8_BAR;
#undef PG8_SETVA
#undef PG8_GVA
#undef PG8_STAGE_A
#undef PG8_SA
#undef PG8_SB
#undef PG8_STAGE
#undef PG8_LDA
#undef PG8_LDF
#undef PG8_LO
#undef PG8_HI
#undef PG8_LDB
#undef PG8_MMA
#undef PG8_WAIT_V
#undef PG8_WAIT_L
#undef PG8_BAR
#undef PG8_SCHED
}

struct EpiVU {
    static constexpr bool PERM = true;
    bf16* vu;
    __device__ __forceinline__ void operator()(const f32x4 (&acc)[2][2][4][2], const Unit& u, int wr, int wc, int fr, int fq) const {
        const int row0 = u.pm * BM + wr * 64 + fr, cw = wc * 32 + 8 * fq;
#pragma unroll
        for (int ai = 0; ai < 2; ++ai)
#pragma unroll
            for (int m = 0; m < 4; ++m) { bf16* rowp = vu + (size_t)(row0 + ai * HALF + m * 16) * D;
                if (u.pn < 4) {
                    f32x4 a0 = acc[ai][0][m][0], a1 = acc[ai][0][m][1]; const f32x4 g0 = acc[ai][1][m][0], g1 = acc[ai][1][m][1];
#pragma unroll
                    for (int j = 0; j < 4; ++j) { a0[j] *= sigmoidf_(g0[j]); a1[j] *= sigmoidf_(g1[j]); }
                    v4u w; w.x = cvt_pk_bf16(a0[0], a0[1]); w.y = cvt_pk_bf16(a0[2], a0[3]); w.z = cvt_pk_bf16(a1[0], a1[1]); w.w = cvt_pk_bf16(a1[2], a1[3]);
                    *(v4u*)(rowp + u.pn * 128 + cw) = w;
                } else {
#pragma unroll
                    for (int bj = 0; bj < 2; ++bj) { const f32x4 v0 = acc[ai][bj][m][0], v1 = acc[ai][bj][m][1];
                        v4u w; w.x = cvt_pk_bf16(v0[0], v0[1]); w.y = cvt_pk_bf16(v0[2], v0[3]); w.z = cvt_pk_bf16(v1[0], v1[1]); w.w = cvt_pk_bf16(v1[2], v1[3]);
                        *(v4u*)(rowp + 512 + (u.pn - 4) * 256 + bj * HALF + cw) = w; }
                }
            }
    }
};
struct EpiBf16Plain {
    static constexpr bool PERM = true;
    bf16* O; int ldc;
    __device__ __forceinline__ void operator()(const f32x4 (&acc)[2][2][4][2], const Unit& u, int wr, int wc, int fr, int fq) const {
        const int row0 = u.pm * BM + wr * 64 + fr, col0 = u.pn * BM + wc * 32 + 8 * fq;
#pragma unroll
        for (int ai = 0; ai < 2; ++ai)
#pragma unroll
            for (int m = 0; m < 4; ++m) { bf16* rowp = O + (size_t)(row0 + ai * HALF + m * 16) * ldc + col0;
#pragma unroll
                for (int bj = 0; bj < 2; ++bj) { const f32x4 v0 = acc[ai][bj][m][0], v1 = acc[ai][bj][m][1];
                    v4u w; w.x = cvt_pk_bf16(v0[0], v0[1]); w.y = cvt_pk_bf16(v0[2], v0[3]); w.z = cvt_pk_bf16(v1[0], v1[1]); w.w = cvt_pk_bf16(v1[2], v1[3]);
                    *(v4u*)(rowp + bj * HALF) = w; } }
    }
};

constexpr int MOE_TP_OFF = 131072, MOE_DESC_OFF = 131072 + 512, MOE_ROWS_OFF = 131072 + 1024, MOE_MAX_UNITS = 6, MOE_W_OFF = MOE_ROWS_OFF + MOE_MAX_UNITS * 1024;
struct MoeSched {
    const char* Abase; const char* Bbase; PG8_LAS unsigned char* lds; int nlocal, K, mode, esz;
    __device__ bool next(int i, Unit& u) const {
        if (i >= nlocal) return false;
        const int it = mode == 0 ? i : (i >> 1);
        const PG8_LAS int* d = (const PG8_LAS int*)(lds + MOE_DESC_OFF) + it * 8;
        u.e = __builtin_amdgcn_readfirstlane(d[0]); u.pm = __builtin_amdgcn_readfirstlane(d[1]); u.pn = __builtin_amdgcn_readfirstlane(d[2]); u.nvalid = __builtin_amdgcn_readfirstlane(d[3]); u.slot = it;
        if (mode == 0) { u.A = Abase; u.B = Bbase + ((size_t)u.e * 512 + (size_t)u.pn * 256) * 1024 * esz; }
        else { u.pn = 2 * u.pn + (i & 1); u.A = Abase + (size_t)u.pm * 256 * 256 * esz; u.B = Bbase + ((size_t)u.e * 1024 + (size_t)u.pn * 256) * 256 * esz; }
        return true;
    }
    __device__ const PG8_LAS int* rowsA(int i) const { return (const PG8_LAS int*)(lds + MOE_ROWS_OFF) + i * 256; }
};
struct EpiAct {
    static constexpr bool PERM = true;
    unsigned char* act8; float isc;
    __device__ __forceinline__ void operator()(const f32x4 (&acc)[2][2][4][2], const Unit& u, int wr, int wc, int fr, int fq) const {
        const size_t row0 = (size_t)u.pm * BM + wr * 64 + fr; const int col0 = u.pn * 128 + wc * 32 + 8 * fq;
#pragma unroll
        for (int ai = 0; ai < 2; ++ai)
#pragma unroll
            for (int m = 0; m < 4; ++m) {
                float a[8];
#pragma unroll
                for (int j = 0; j < 8; ++j) { const float g = acc[ai][0][m][j >> 2][j & 3] * isc, uu = acc[ai][1][m][j >> 2][j & 3] * (8.0f * isc);
                    a[j] = g * __builtin_amdgcn_rcpf(1.0f + __expf(-g)) * uu; }
                int lo = __builtin_amdgcn_cvt_pk_fp8_f32(a[0], a[1], 0, false); lo = __builtin_amdgcn_cvt_pk_fp8_f32(a[2], a[3], lo, true);
                int hi = __builtin_amdgcn_cvt_pk_fp8_f32(a[4], a[5], 0, false); hi = __builtin_amdgcn_cvt_pk_fp8_f32(a[6], a[7], hi, true);
                *(v2u*)(act8 + (row0 + ai * HALF + m * 16) * 256 + col0) = (v2u){(unsigned)lo, (unsigned)hi};
                asm volatile("" ::: "memory");
            }
    }
};
struct EpiDown {
    static constexpr bool PERM = true;
    unsigned char* yk8; bf16* ycomb; PG8_LAS unsigned char* lds;
    __device__ __forceinline__ void operator()(const f32x4 (&acc)[2][2][4][2], const Unit& u, int wr_, int wc_, int fr_, int fq_) const {
        int t_ = threadIdx.x; asm volatile("" : "+v"(t_));
        const int fr = t_ & 15, fq = (t_ >> 4) & 3, wc = (t_ >> 6) & 3, wr = t_ >> 8;
        const PG8_LAS int* rows = (const PG8_LAS int*)(lds + MOE_ROWS_OFF) + u.slot * 256;
        const PG8_LAS float* wts = (const PG8_LAS float*)(lds + MOE_W_OFF) + u.slot * 256;
        const int col = u.pn * 256 + wc * 32 + 8 * fq;
#pragma unroll
        for (int ai = 0; ai < 2; ++ai)
#pragma unroll
            for (int m = 0; m < 4; ++m) {
                const int id = rows[ai * HALF + wr * 64 + m * 16 + fr];
                if (id >= 0) {
                    if (u.e < 64) {
                        const float w = wts[ai * HALF + wr * 64 + m * 16 + fr] * (16.0f / 128.0f);
                        unsigned char* dst = yk8 + ((unsigned)id * 1024u + (unsigned)col);
#pragma unroll
                        for (int bj = 0; bj < 2; ++bj) { const f32x4 v0 = acc[ai][bj][m][0] * w, v1 = acc[ai][bj][m][1] * w;
                            int lo = __builtin_amdgcn_cvt_pk_fp8_f32(v0[0], v0[1], 0, false); lo = __builtin_amdgcn_cvt_pk_fp8_f32(v0[2], v0[3], lo, true);
                            int hi = __builtin_amdgcn_cvt_pk_fp8_f32(v1[0], v1[1], 0, false); hi = __builtin_amdgcn_cvt_pk_fp8_f32(v1[2], v1[3], hi, true);
                            *(v2u*)(dst + bj * HALF) = (v2u){(unsigned)lo, (unsigned)hi}; }
                    } else {
                        bf16* dst = ycomb + ((unsigned)id * 1024u + (unsigned)col);
#pragma unroll
                        for (int bj = 0; bj < 2; ++bj) { const f32x4 v0 = acc[ai][bj][m][0] * (1.0f / 128.0f), v1 = acc[ai][bj][m][1] * (1.0f / 128.0f);
                            v4u o; o.x = cvt_pk_bf16(v0[0], v0[1]); o.y = cvt_pk_bf16(v0[2], v0[3]); o.z = cvt_pk_bf16(v1[0], v1[1]); o.w = cvt_pk_bf16(v1[2], v1[3]);
                            *(v4u*)(dst + bj * HALF) = o; }
                    }
                }
            }
    }
};
}

struct Params {
    const float* in[34];
    float* out;
    unsigned char* ws;
    int ph_lo, ph_hi, li, flags;
};

__device__ __forceinline__ void transpose_item(const float* W, int ldw, bf16* WT, int ldt, LAS float* scr, int lane) {
#pragma unroll 8
    for (int i = 0; i < 32; ++i) { const int kk = 2 * i + (lane >> 5); scr[kk * 33 + (lane & 31)] = W[(size_t)kk * ldw + (lane & 31)]; }
    LDS_WAIT(); asm volatile("" ::: "memory");
    const int c = lane & 7;
#pragma unroll
    for (int j = 0; j < 4; ++j) { const int n = (lane >> 3) + 8 * j; const LAS float* s = scr + (8 * c) * 33 + n;
        v4u o; o.x = pk2(s[0 * 33], s[1 * 33]); o.y = pk2(s[2 * 33], s[3 * 33]); o.z = pk2(s[4 * 33], s[5 * 33]); o.w = pk2(s[6 * 33], s[7 * 33]);
        *(GAS v4u*)(WT + (size_t)n * ldt + 8 * c) = o; }
    LDS_WAIT(); asm volatile("" ::: "memory");
}

__device__ __forceinline__ void transpose_item_glu(const float* W, int k0, int n0, bf16* WF, LAS float* scr, int lane) {
#pragma unroll 8
    for (int i = 0; i < 32; ++i) { const int kk = 2 * i + (lane >> 5); scr[kk * 33 + (lane & 31)] = W[(size_t)(k0 + kk) * CC + n0 + (lane & 31)]; }
    LDS_WAIT(); asm volatile("" ::: "memory");
    const int c = lane & 7;
#pragma unroll
    for (int j = 0; j < 4; ++j) { const int nl = (lane >> 3) + 8 * j; const LAS float* s = scr + (8 * c) * 33 + nl;
        v4u o; o.x = pk2(s[0 * 33], s[1 * 33]); o.y = pk2(s[2 * 33], s[3 * 33]); o.z = pk2(s[4 * 33], s[5 * 33]); o.w = pk2(s[6 * 33], s[7 * 33]);
        const int n = n0 + nl, k = k0 + 8 * c;
        const int blk = (((n >> 6) * 16 + (k >> 5)) * 4 + ((n >> 4) & 3)), ln = ((k >> 3) & 3) * 16 + (n & 15);
        *(GAS v4u*)(WF + (size_t)blk * 512 + ln * 8) = o; }
    LDS_WAIT(); asm volatile("" ::: "memory");
}

__device__ __forceinline__ void transpose_item8(const float* W, int ldw, unsigned char* WT8, int ldt, float sc, LAS float* scr, int lane) {
#pragma unroll 8
    for (int i = 0; i < 32; ++i) { const int kk = 2 * i + (lane >> 5); scr[kk * 33 + (lane & 31)] = W[(size_t)kk * ldw + (lane & 31)]; }
    LDS_WAIT(); asm volatile("" ::: "memory");
    const int n = lane >> 1, h = lane & 1;
    const LAS float* s = scr + (32 * h) * 33 + n;
    unsigned w[8];
#pragma unroll
    for (int d = 0; d < 8; ++d) { int v = __builtin_amdgcn_cvt_pk_fp8_f32(s[(4 * d) * 33] * sc, s[(4 * d + 1) * 33] * sc, 0, false);
        v = __builtin_amdgcn_cvt_pk_fp8_f32(s[(4 * d + 2) * 33] * sc, s[(4 * d + 3) * 33] * sc, v, true); w[d] = (unsigned)v; }
    *(GAS v4u*)(WT8 + (size_t)n * ldt + 32 * h) = (v4u){w[0], w[1], w[2], w[3]};
    *(GAS v4u*)(WT8 + (size_t)n * ldt + 32 * h + 16) = (v4u){w[4], w[5], w[6], w[7]};
    LDS_WAIT(); asm volatile("" ::: "memory");
}
constexpr int IT_EG = 64 * 128, IT_EU = 64 * 128, IT_ED = 64 * 128, IT_SG = 128, IT_SU = 128, IT_SD = 128, IT_IN = 16 * 48, IT_OUT = 16 * 32, IT_GLU = 8 * 16, IT_RT = 16 * 2;
constexpr int NITEMS_T = IT_EG + IT_EU + IT_ED + IT_SG + IT_SU + IT_SD + IT_IN + IT_OUT + IT_GLU + IT_RT;

__device__ __forceinline__ void p0_convert_item(const Params& p, int it, LAS float* scr, int lane) {
    unsigned char* ws = p.ws;
    bf16* Wgu = (bf16*)(ws + WS_WGU_T); bf16* Wd = (bf16*)(ws + WS_WD_T);
    int r = it;
    if (r < IT_EG + IT_EU) {
        const int up = r >= IT_EG; if (up) r -= IT_EG;
        const int e = r >> 7, q = r & 127, kb = q >> 3, nb = q & 7, k0 = 64 * kb, n0 = 32 * nb;
        const float* src = (up ? p.in[29] : p.in[28]) + (size_t)e * D * DE + (size_t)k0 * DE + n0;
        const int drow = 256 * (n0 >> 7) + (n0 & 127) + (up ? 128 : 0);
        transpose_item8(src, DE, (unsigned char*)Wgu + (size_t)e * 512 * D + (size_t)drow * D + k0, D, 32.0f, scr, lane); return; }
    r -= IT_EG + IT_EU;
    if (r < IT_ED) {
        const int e = r >> 7, q = r & 127, kb = q >> 5, nb = q & 31, k0 = 64 * kb, n0 = 32 * nb;
        transpose_item8(p.in[30] + (size_t)e * DE * D + (size_t)k0 * D + n0, D, (unsigned char*)Wd + (size_t)e * D * DE + (size_t)n0 * DE + k0, DE, 16.0f, scr, lane); return; }
    r -= IT_ED;
    if (r < IT_SG + IT_SU) {
        const int up = r >= IT_SG; if (up) r -= IT_SG;
        const int kb = r >> 3, nb = r & 7, k0 = 64 * kb, n0 = 32 * nb;
        const float* src = (up ? p.in[32] : p.in[31]) + (size_t)k0 * DE + n0;
        const int drow = 256 * (n0 >> 7) + (n0 & 127) + (up ? 128 : 0);
        transpose_item8(src, DE, (unsigned char*)Wgu + (size_t)64 * 512 * D + (size_t)drow * D + k0, D, 32.0f, scr, lane); return; }
    r -= IT_SG + IT_SU;
    if (r < IT_SD) { const int kb = r >> 5, nb = r & 31, k0 = 64 * kb, n0 = 32 * nb;
        transpose_item8(p.in[33] + (size_t)k0 * D + n0, D, (unsigned char*)Wd + (size_t)64 * D * DE + (size_t)n0 * DE + k0, DE, 16.0f, scr, lane); return; }
    r -= IT_SD;
    if (r < IT_IN) { const int kb = r / 48, nb = r % 48, k0 = 64 * kb, n0 = 32 * nb;
        int drow; if (n0 < 512) drow = 256 * (n0 >> 7) + (n0 & 127); else if (n0 < 1024) { const int c = n0 - 512; drow = 256 * (c >> 7) + 128 + (c & 127); } else drow = n0;
        transpose_item(p.in[6] + (size_t)k0 * DIN + n0, DIN, (bf16*)(ws + WS_W_IN_T) + (size_t)drow * D + k0, D, scr, lane); return; }
    r -= IT_IN;
    if (r < IT_OUT) { const int kb = r >> 5, nb = r & 31, k0 = 64 * kb, n0 = 32 * nb;
        transpose_item(p.in[23] + (size_t)k0 * D + n0, D, (bf16*)(ws + WS_W_OUT_T) + (size_t)n0 * D + k0, D, scr, lane); return; }
    r -= IT_OUT;
    if (r < IT_GLU) { const int kb = r >> 4, nb = r & 15, k0 = 64 * kb, n0 = 32 * nb;
        transpose_item_glu(p.in[19], k0, n0, (bf16*)(ws + WS_W_GLU_T), scr, lane); return; }
    r -= IT_GLU;
    { const int kb = r >> 1, nb = r & 1, k0 = 64 * kb, n0 = 32 * nb;
      transpose_item(p.in[26] + (size_t)k0 * NE + n0, NE, (bf16*)(ws + WS_W_RT_T) + (size_t)n0 * D + k0, D, scr, lane); }
}

__device__ __forceinline__ void p0_mod_item(const Params& p, int item, LAS float* red, int tid) {
    const int cg = tid & 7, kr = tid >> 3, j0 = item * 32 + cg * 4;
    const float* c = p.in[1]; const float* w = p.in[2];
    f32x4 a0 = {0.f, 0.f, 0.f, 0.f}, a1 = {0.f, 0.f, 0.f, 0.f};
#pragma unroll 4
    for (int ps = 0; ps < 16; ++ps) { const int k = ps * 64 + kr;
        const f32x4 w4 = *(const f32x4*)(w + (size_t)k * 6 * D + j0);
        const float s0 = siluf_(c[k]), s1 = siluf_(c[D + k]);
        a0 += w4 * s0; a1 += w4 * s1; }
    LAS float* my = red + (kr * 8 + cg) * 8;
    my[0] = a0[0]; my[1] = a0[1]; my[2] = a0[2]; my[3] = a0[3]; my[4] = a1[0]; my[5] = a1[1]; my[6] = a1[2]; my[7] = a1[3];
    __syncthreads();
    if (tid < 64) { const int g = tid >> 3, q = tid & 7; float s = 0.f;
        for (int k2 = 0; k2 < 64; ++k2) s += red[(k2 * 8 + g) * 8 + q];
        const int b = q >> 2, j = item * 32 + g * 4 + (q & 3);
        ((float*)(p.ws + WS_MOD))[b * 6 * D + j] = s + p.in[3][j]; }
    __syncthreads();
}

__device__ __forceinline__ void p1_rows(const Params& p, int gw0, int NGW, int lane) {
    if (gw0 >= T) return;
    f32x4 vn[4];
    { const GAS f32x4* xr = (const GAS f32x4*)(p.in[0] + (size_t)gw0 * D) + lane;
#pragma unroll
      for (int j = 0; j < 4; ++j) vn[j] = xr[64 * j]; }
    f32x4 g[4];
#pragma unroll
    for (int j = 0; j < 4; ++j) g[j] = *(const f32x4*)(p.in[4] + 4 * lane + 256 * j);
    for (int m = gw0; m < T; m += NGW) {
        f32x4 v[4]; float s = 0.f;
#pragma unroll
        for (int j = 0; j < 4; ++j) { v[j] = vn[j]; s += (v[j].x * v[j].x + v[j].y * v[j].y) + (v[j].z * v[j].z + v[j].w * v[j].w); }
        if (m + NGW < T) { const GAS f32x4* xr = (const GAS f32x4*)(p.in[0] + (size_t)(m + NGW) * D) + lane;
#pragma unroll
            for (int j = 0; j < 4; ++j) vn[j] = xr[64 * j]; }
        const int b = m / SEQL;
        const float* mod = (const float*)(p.ws + WS_MOD) + b * 6 * D;
        const float rstd = rsqrtf(wave_sum(s) * (1.f / D) + EPS);
        GAS unsigned long long* o8 = (GAS unsigned long long*)((bf16*)(p.ws + WS_ABUF) + (size_t)m * D) + lane;
#pragma unroll
        for (int j = 0; j < 4; ++j) { const int n = 4 * lane + 256 * j;
            const f32x4 sc = *(const f32x4*)(mod + D + n), sh = *(const f32x4*)(mod + n);
            const f32x4 o = v[j] * rstd * g[j] * (sc + 1.0f) + sh;
            o8[64 * j] = (unsigned long long)pk2(o.x, o.y) | ((unsigned long long)pk2(o.z, o.w) << 32); }
    }
}

typedef float f32x16 __attribute__((ext_vector_type(16)));
__device__ __forceinline__ void p0_ssm_tables_gp(const Params& p, int q  ) {
    const int g = q >> 6;
    const double ar = p.in[11][q], ai = p.in[12][q], dt = exp((double)p.in[13][g]);
    const double mag = exp(ar * dt), lr = mag * cos(ai * dt), li = mag * sin(ai * dt);
    const double den = ar * ar + ai * ai, nr = lr - 1.0;
    const double kr = (nr * ar + li * ai) / den, ki = (li * ar - nr * ai) / den;
    ((f32x2*)(p.ws + WS_LAM))[q] = (f32x2){(float)lr, (float)li};
    double pr = lr, pi = li;
#pragma unroll
    for (int s = 0; s < 5; ++s) { const double nr2 = pr * pr - pi * pi, ni2 = 2.0 * pr * pi; pr = nr2; pi = ni2; }
    ((f32x2*)(p.ws + WS_LAM32))[q] = (f32x2){(float)pr, (float)pi};
    bf16* Bb = (bf16*)(p.ws + WS_BB);
    const int pp = q & 63;
    for (int h = 0; h < 16; ++h) { const double br = p.in[14][q * 16 + h], bi = p.in[15][q * 16 + h];
        Bb[((g * 2 + 0) * 64 + pp) * 16 + h] = (bf16)f2bf((float)(kr * br - ki * bi));
        Bb[((g * 2 + 1) * 64 + pp) * 16 + h] = (bf16)f2bf((float)(kr * bi + ki * br)); }
}
__device__ __forceinline__ void p0_ssm_tables_ct(const Params& p, int idx  ) {
    const int k = idx & 127, gh = idx >> 7;
    const float v = (k < 64) ? p.in[16][gh * 64 + k] : -p.in[17][gh * 64 + (k - 64)];
    ((bf16*)(p.ws + WS_CT))[idx] = (bf16)f2bf(v);
}

__device__ __forceinline__ bf16x8 ssm_load_u(const bf16* vu, int tokA, int tokB, int g, int lane) {
    const int i = lane & 31, kh = lane >> 5;
    const int hf = (i >> 2) & 1, r = (i & 3) + 4 * (i >> 3);
    const int tok = (hf ? tokB : tokA) + r;
    return *(const bf16x8*)(vu + (size_t)tok * D + CC + g * 16 + 8 * kh);
}
#define KEEP_V(x) asm volatile("" :: "v"(x))
#define MFMA_SETTLE1(x) asm volatile("s_nop 15\n\ts_nop 7" : "+v"(x))
#define MFMA_SETTLE_ALL() do { __builtin_amdgcn_sched_barrier(0); asm volatile("s_nop 15\n\ts_nop 15\n\ts_nop 15\n\ts_nop 15"); __builtin_amdgcn_sched_barrier(0); } while (0)
#define MFMA_SETTLE2(x, y) asm volatile("s_nop 15\n\ts_nop 7" : "+v"(x), "+v"(y))
__device__ __forceinline__ f32x16 mfma32(bf16x8 a, bf16x8 b, f32x16 c) { return __builtin_amdgcn_mfma_f32_32x32x16_bf16(a, b, c, 0, 0, 0); }
__device__ __forceinline__ void mfma_roundtrip2(f32x16& x, f32x16& y, LAS float* scr, int lane) {
#pragma unroll
    for (int k = 0; k < 16; ++k) { scr[k * 64 + lane] = x[k]; scr[(16 + k) * 64 + lane] = y[k]; }
    LDS_WAIT(); asm volatile("" ::: "memory");
#pragma unroll
    for (int k = 0; k < 16; ++k) { x[k] = scr[k * 64 + lane]; y[k] = scr[(16 + k) * 64 + lane]; }
    LDS_WAIT(); asm volatile("" ::: "memory");
}
__device__ __forceinline__ void mfma_roundtrip1(f32x16& x, LAS float* scr, int lane) {
#pragma unroll
    for (int k = 0; k < 16; ++k) scr[k * 64 + lane] = x[k];
    LDS_WAIT(); asm volatile("" ::: "memory");
#pragma unroll
    for (int k = 0; k < 16; ++k) x[k] = scr[k * 64 + lane];
    LDS_WAIT(); asm volatile("" ::: "memory");
}
struct SsmGroup { bf16x8 bb[2][2]; f32x2 lam[2]; };
__device__ __forceinline__ void ssm_group_load(const unsigned char* ws, int g, int lane, SsmGroup& G) {
    const bf16* Bb = (const bf16*)(ws + WS_BB);
#pragma unroll
    for (int ri = 0; ri < 2; ++ri)
#pragma unroll
        for (int pb = 0; pb < 2; ++pb) G.bb[ri][pb] = *(const bf16x8*)(Bb + ((g * 2 + ri) * 64 + pb * 32 + (lane & 31)) * 16 + 8 * (lane >> 5));
#pragma unroll
    for (int pb = 0; pb < 2; ++pb) G.lam[pb] = ((const f32x2*)(ws + WS_LAM))[g * 64 + pb * 32 + (lane & 31)];
}

__device__ __forceinline__ void p3a_items(const Params& p, int gw0, int NGW, int lane) {
    const int g = gw0 & 31;
    const bf16* vu = (const bf16*)(p.ws + WS_BBUF);
    SsmGroup G; ssm_group_load(p.ws, g, lane, G);
    const f32x16 z16 = {0.f, 0.f, 0.f, 0.f, 0.f, 0.f, 0.f, 0.f, 0.f, 0.f, 0.f, 0.f, 0.f, 0.f, 0.f, 0.f};
    f32x2* E = (f32x2*)(p.ws + WS_E);
    bf16x8 an[2];
    { const int i0 = gw0 >> 5; an[0] = ssm_load_u(vu, 64 * i0, 64 * i0 + 32, g, lane); an[1] = ssm_load_u(vu, 64 * i0 + 16, 64 * i0 + 48, g, lane); }
    for (int item = gw0; item < 256 * 32; item += NGW) {
        const int i = item >> 5;
        bf16x8 a[2] = {an[0], an[1]};
        if (item + NGW < 256 * 32) { const int i1 = (item + NGW) >> 5; an[0] = ssm_load_u(vu, 64 * i1, 64 * i1 + 32, g, lane); an[1] = ssm_load_u(vu, 64 * i1 + 16, 64 * i1 + 48, g, lane); }
        float sr[2] = {0.f, 0.f}, si[2] = {0.f, 0.f};
#pragma unroll
        for (int blk = 0; blk < 2; ++blk) {
#pragma unroll
            for (int pb = 0; pb < 2; ++pb) {
                f32x16 bur = mfma32(a[blk], G.bb[0][pb], z16);
                f32x16 bui = mfma32(a[blk], G.bb[1][pb], z16);
                MFMA_SETTLE2(bur, bui);
                const float lr = G.lam[pb].x, li = G.lam[pb].y;
#pragma unroll
                for (int r = 0; r < 16; ++r) { float nsr = fmaf(lr, sr[pb], fmaf(-li, si[pb], bur[r])), nsi = fmaf(lr, si[pb], fmaf(li, sr[pb], bui[r])); asm volatile("" : "+v"(nsr)); asm volatile("" : "+v"(nsi)); sr[pb] = nsr; si[pb] = nsi; }
            }
        }
        const int sc = 2 * i + (lane >> 5);
#pragma unroll
        for (int pb = 0; pb < 2; ++pb) E[(size_t)sc * 2048 + g * 64 + pb * 32 + (lane & 31)] = (f32x2){sr[pb], si[pb]};
        asm volatile("" :: "v"(a[0]), "v"(a[1]) : "memory");
    }
    asm volatile("" :: "v"(G.bb[0][0]), "v"(G.bb[0][1]), "v"(G.bb[1][0]), "v"(G.bb[1][1]) : "memory");
}

__device__ __forceinline__ float wave_reduce_scatter16(const float (&v)[16], int lane) {
    float a[8], b[4], c[2], d;
    const bool s5 = (lane & 32) != 0, s4 = (lane & 16) != 0, s3 = (lane & 8) != 0, s2 = (lane & 4) != 0;
#pragma unroll
    for (int i = 0; i < 8; ++i) { const float mine = s5 ? v[8 + i] : v[i], theirs = s5 ? v[i] : v[8 + i]; a[i] = mine + __shfl_xor(theirs, 32); }
#pragma unroll
    for (int i = 0; i < 4; ++i) { const float mine = s4 ? a[4 + i] : a[i], theirs = s4 ? a[i] : a[4 + i]; b[i] = mine + __shfl_xor(theirs, 16); }
#pragma unroll
    for (int i = 0; i < 2; ++i) { const float mine = s3 ? b[2 + i] : b[i], theirs = s3 ? b[i] : b[2 + i]; c[i] = mine + __shfl_xor(theirs, 8); }
    { const float mine = s2 ? c[1] : c[0], theirs = s2 ? c[0] : c[1]; d = mine + __shfl_xor(theirs, 4); }
    d += __shfl_xor(d, 2); d += __shfl_xor(d, 1);
    return d;
}
__device__ __forceinline__ int rs16_token(int lane) { return ((lane >> 5) & 1) * 8 + ((lane >> 4) & 1) * 4 + ((lane >> 3) & 1) * 2 + ((lane >> 2) & 1); }

constexpr int CONV_ROWS = 62, CONV_RED_OFF = CONV_ROWS * 1024, CONV_STAT_OFF = CONV_RED_OFF + 1024, CONV_PART_OFF = CONV_STAT_OFF + 256;
__device__ __forceinline__ void p3_conv_tile(const Params& p, int tile, LAS unsigned char* lds, int tid) {
    const int lane = tid & 63, wave = tid >> 6, cp = tid & 255, th = tid >> 8;
    const int t0 = tile * 32, tl0 = t0 % SEQL;
    const bf16* vu = (const bf16*)(p.ws + WS_BBUF);
    LAS unsigned char* vt = lds;
    LAS float* red = (LAS float*)(lds + CONV_RED_OFF);
    LAS float* stat = (LAS float*)(lds + CONV_STAT_OFF);
    for (int r = wave; r < CONV_ROWS; r += NWAVES) {
        v4u val = {0u, 0u, 0u, 0u};
        if (tl0 + r - 30 >= 0) val = *(const v4u*)(vu + (size_t)(t0 + r - 30) * D + lane * 8);
        *(LAS v4u*)(vt + r * 1024 + lane * 16) = val;
    }
    f32x2 w[31];
#pragma unroll
    for (int j = 0; j < 31; ++j) w[j] = *(const f32x2*)(p.in[7] + j * CC + 2 * cp);
    const f32x2 bias = *(const f32x2*)(p.in[8] + 2 * cp);
    __syncthreads();
    f32x2 acc[16];
#pragma unroll
    for (int o = 0; o < 16; ++o) acc[o] = bias;
#pragma unroll
    for (int s = 0; s < 46; ++s) {
        const unsigned pr = *(const LAS unsigned*)(vt + (16 * th + s) * 1024 + cp * 4);
        const f32x2 v = {bflo(pr), bfhi(pr)};
#pragma unroll
        for (int o = 0; o < 16; ++o) { const int j = s - o; if (j >= 0 && j <= 30) acc[o] += v * w[j]; }
    }
    LAS f32x2* part = (LAS f32x2*)(lds + CONV_PART_OFF);
#pragma unroll
    for (int o = 0; o < 16; ++o) part[(16 * th + o) * 257 + cp] = (f32x2){acc[o].x + acc[o].y, acc[o].x * acc[o].x + acc[o].y * acc[o].y};
    __syncthreads();
    { const int tk = tid >> 4, sub = tid & 15; float s = 0.f, q = 0.f;
#pragma unroll
      for (int i = 0; i < 16; ++i) { const f32x2 v = part[tk * 257 + sub + 16 * i]; s += v.x; q += v.y; }
#pragma unroll
      for (int o = 1; o < 16; o <<= 1) { s += __shfl_xor(s, o); q += __shfl_xor(q, o); }
      if (sub == 0) { const float mu = s * (1.f / CC), var = q * (1.f / CC) - mu * mu; stat[tk * 2] = mu; stat[tk * 2 + 1] = rsqrtf(var + EPS); } }
    __syncthreads();
    const f32x2 lg = *(const f32x2*)(p.in[9] + 2 * cp), lb = *(const f32x2*)(p.in[10] + 2 * cp);
#pragma unroll
    for (int o = 0; o < 16; ++o) { const float mu = stat[(16 * th + o) * 2], rs = stat[(16 * th + o) * 2 + 1];
        f32x2 y = (acc[o] - mu) * rs * lg + lb; y.x = siluf_(y.x); y.y = siluf_(y.y); acc[o] = y;
        part[(16 * th + o) * 257 + cp].x = y.x * y.x + y.y * y.y; }
    __syncthreads();
    { const int tk = tid >> 4, sub = tid & 15; float q = 0.f;
#pragma unroll
      for (int i = 0; i < 16; ++i) q += part[tk * 257 + sub + 16 * i].x;
#pragma unroll
      for (int o = 1; o < 16; o <<= 1) q += __shfl_xor(q, o);
      if (sub == 0) stat[tk * 2] = rsqrtf(q * (1.f / CC) + EPS); }
    __syncthreads();
    const f32x2 go = *(const f32x2*)(p.in[21] + 2 * cp);
    bf16* mixed = (bf16*)(p.ws + WS_ABUF);
#pragma unroll
    for (int o = 0; o < 16; ++o) { const float rs = stat[(16 * th + o) * 2]; const f32x2 y = acc[o] * rs * go;
        *(unsigned*)(mixed + (size_t)(t0 + 16 * th + o) * D + 2 * cp) = pk2(y.x, y.y); }
    __syncthreads();
}

__device__ __forceinline__ void p3b_block(const Params& p, int blk, LAS unsigned char* lds, int tid) {
    const int sl = tid & 15, seg = tid >> 4;
    const int idx = blk * 16 + sl, b = idx >> 11, q = idx & 2047;
    const f32x2 L = ((const f32x2*)(p.ws + WS_LAM32))[q];
    const f32x2* E = (const f32x2*)(p.ws + WS_E) + (size_t)b * 256 * 2048 + q + (size_t)(8 * seg) * 2048;
    f32x2* S = (f32x2*)(p.ws + WS_SINIT) + (size_t)b * 256 * 2048 + q + (size_t)(8 * seg) * 2048;
    f32x2 e[8];
#pragma unroll
    for (int j = 0; j < 8; ++j) e[j] = E[(size_t)j * 2048];
    float pr = L.x, pi = L.y;
#pragma unroll
    for (int s = 0; s < 3; ++s) { const float nr = pr * pr - pi * pi, ni = 2.0f * pr * pi; pr = nr; pi = ni; }
    float xr = 0.f, xi = 0.f;
#pragma unroll
    for (int j = 0; j < 8; ++j) { float nr = fmaf(L.x, xr, fmaf(-L.y, xi, e[j].x)), ni = fmaf(L.x, xi, fmaf(L.y, xr, e[j].y)); asm volatile("" : "+v"(nr)); asm volatile("" : "+v"(ni)); xr = nr; xi = ni; }
    LAS f32x2* xs = (LAS f32x2*)lds;
    xs[sl * 33 + seg] = (f32x2){xr, xi};
    __syncthreads();
    if (tid < 16) {
        f32x2 x[32];
#pragma unroll
        for (int k = 0; k < 32; ++k) x[k] = xs[tid * 33 + k];
        float cr = 0.f, ci = 0.f;
#pragma unroll
        for (int k = 0; k < 32; ++k) { xs[tid * 33 + k] = (f32x2){cr, ci};
            float nr = fmaf(pr, cr, fmaf(-pi, ci, x[k].x)), ni = fmaf(pr, ci, fmaf(pi, cr, x[k].y)); asm volatile("" : "+v"(nr)); asm volatile("" : "+v"(ni)); cr = nr; ci = ni; }
    }
    __syncthreads();
    const f32x2 in = xs[sl * 33 + seg];
    float sr = in.x, si = in.y;
#pragma unroll
    for (int j = 0; j < 8; ++j) { S[(size_t)j * 2048] = (f32x2){sr, si};
        float nr = fmaf(L.x, sr, fmaf(-L.y, si, e[j].x)), ni = fmaf(L.x, si, fmaf(L.y, sr, e[j].y)); asm volatile("" : "+v"(nr)); asm volatile("" : "+v"(ni)); sr = nr; si = ni; }
    __syncthreads();
}

constexpr int P3C_STILE = 32 * 272, P3C_G_OFF = 8 * P3C_STILE, P3C_G_STRIDE = 1040, P3C_RED_OFF = P3C_G_OFF + 64 * P3C_G_STRIDE;
__device__ __forceinline__ void p3c_chunk(const Params& p, int chunk, LAS unsigned char* lds, int tid) {
    const int lane = tid & 63, wave = __builtin_amdgcn_readfirstlane(tid >> 6);
    const int t0 = chunk * 64;
    const bf16* vu = (const bf16*)(p.ws + WS_BBUF);
    LAS unsigned char* st = lds + wave * P3C_STILE;
    LAS unsigned char* gt = lds + P3C_G_OFF;
    const int hf = lane >> 5, j = lane & 31;
    const f32x16 z16 = {0.f, 0.f, 0.f, 0.f, 0.f, 0.f, 0.f, 0.f, 0.f, 0.f, 0.f, 0.f, 0.f, 0.f, 0.f, 0.f};
    const bf16* Ct = (const bf16*)(p.ws + WS_CT);
    for (int gi = 0; gi < ((p.flags & 2) ? 0 : 4); ++gi) {
        const int g = wave * 4 + gi;
        SsmGroup G; ssm_group_load(p.ws, g, lane, G);
        float sr[2], si[2];
        { const f32x2* S0 = (const f32x2*)(p.ws + WS_SINIT) + (size_t)(2 * chunk + hf) * 2048 + g * 64 + j;
          const f32x2 s0 = S0[0], s1 = S0[32]; sr[0] = s0.x; si[0] = s0.y; sr[1] = s1.x; si[1] = s1.y; }
        bf16x8 cb[8];
#pragma unroll
        for (int ks = 0; ks < 8; ++ks) { bf16x8 v = {0, 0, 0, 0, 0, 0, 0, 0}; if (j < 16) v = *(const bf16x8*)(Ct + (size_t)(g * 16 + j) * 128 + ks * 16 + 8 * hf); cb[ks] = v; }
        bf16x8 db = {0, 0, 0, 0, 0, 0, 0, 0};
        if (j < 16 && (j >> 3) == hf) { const unsigned short dv = (unsigned short)f2bf(p.in[18][g * 16 + j]);
#pragma unroll
            for (int e = 0; e < 8; ++e) if ((j & 7) == e) db[e] = (short)dv; }
#pragma unroll
        for (int blk = 0; blk < 2; ++blk) {
            const bf16x8 a = ssm_load_u(vu, t0 + 16 * blk, t0 + 32 + 16 * blk, g, lane);
            f32x16 bur[2], bui[2];
#pragma unroll
            for (int pb = 0; pb < 2; ++pb) {
                bur[pb] = mfma32(a, G.bb[0][pb], z16);
                bui[pb] = mfma32(a, G.bb[1][pb], z16);
                MFMA_SETTLE2(bur[pb], bui[pb]);
            }
#pragma unroll
            for (int pb = 0; pb < 2; ++pb) {
                const float lr = G.lam[pb].x, li = G.lam[pb].y;
#pragma unroll
                for (int r = 0; r < 16; ++r) {
                    float nsr = fmaf(lr, sr[pb], fmaf(-li, si[pb], bur[pb][r])), nsi = fmaf(lr, si[pb], fmaf(li, sr[pb], bui[pb][r])); asm volatile("" : "+v"(nsr)); asm volatile("" : "+v"(nsi)); sr[pb] = nsr; si[pb] = nsi;
                    const int row = (r & 3) + 8 * (r >> 2) + 4 * hf;
                    const unsigned wri = pk2(nsr, nsi);
                    *(LAS unsigned short*)(st + row * 272 + (pb * 32 + j) * 2) = (unsigned short)wri;
                    *(LAS unsigned short*)(st + row * 272 + (64 + pb * 32 + j) * 2) = (unsigned short)(wri >> 16);
                }
            }
            LDS_WAIT(); asm volatile("" ::: "memory");
            f32x16 y = mfma32(a, db, z16);
#pragma unroll
            for (int ks = 0; ks < 8; ++ks) { const bf16x8 sa = *(const LAS bf16x8*)(st + j * 272 + (ks * 16 + 8 * hf) * 2); y = mfma32(sa, cb[ks], y); KEEP_V(sa); }
            MFMA_SETTLE1(y);
            LDS_WAIT(); asm volatile("" ::: "memory");
#pragma unroll
            for (int r = 0; r < 16; ++r) { float yr = y[r]; asm volatile("" : "+v"(yr)); y[r] = yr; }
            KEEP_V(a);
            if (j < 16) {
#pragma unroll
                for (int r = 0; r < 16; r += 2) { const int tokl = 32 * hf + 16 * blk + r; const unsigned w2 = pk2(gelu_tanh(y[r]), gelu_tanh(y[r + 1]));
                    *(LAS unsigned short*)(gt + tokl * P3C_G_STRIDE + (g * 16 + j) * 2) = (unsigned short)w2;
                    *(LAS unsigned short*)(gt + (tokl + 1) * P3C_G_STRIDE + (g * 16 + j) * 2) = (unsigned short)(w2 >> 16); }
            }
            LDS_WAIT(); asm volatile("" ::: "memory");
        }
        KEEP_V(db); KEEP_V(G.bb[0][0]); KEEP_V(G.bb[0][1]); KEEP_V(G.bb[1][0]); KEEP_V(G.bb[1][1]);
#pragma unroll
        for (int ks = 0; ks < 8; ++ks) KEEP_V(cb[ks]);
    }
    __syncthreads();
    if (p.flags & 4) return;
    const int fr = lane & 15, fq = lane >> 4;
    f32x4 acc[4][4];
#pragma unroll
    for (int mf = 0; mf < 4; ++mf)
#pragma unroll
        for (int nf = 0; nf < 4; ++nf) acc[mf][nf] = (f32x4){0.f, 0.f, 0.f, 0.f};
    const bf16* Wg = (const bf16*)(p.ws + WS_W_GLU_T);
#pragma unroll 4
    for (int ks = 0; ks < 16; ++ks) {
        bf16x8 af[4], bfr[4];
#pragma unroll
        for (int nf = 0; nf < 4; ++nf) bfr[nf] = *(const bf16x8*)(Wg + (size_t)((wave * 16 + ks) * 4 + nf) * 512 + lane * 8);
#pragma unroll
        for (int mf = 0; mf < 4; ++mf) af[mf] = *(const LAS bf16x8*)(gt + (16 * mf + fr) * P3C_G_STRIDE + (32 * ks + 8 * fq) * 2);
#pragma unroll
        for (int mf = 0; mf < 4; ++mf)
#pragma unroll
            for (int nf = 0; nf < 4; ++nf) acc[mf][nf] = __builtin_amdgcn_mfma_f32_16x16x32_bf16(bfr[nf], af[mf], acc[mf][nf], 0, 0, 0);
    }
    MFMA_SETTLE_ALL();
    float ssq[4] = {0.f, 0.f, 0.f, 0.f};
#pragma unroll
    for (int nf = 0; nf < 4; ++nf) { const int n0 = 64 * wave + 16 * nf + 4 * fq; const f32x4 bg = *(const f32x4*)(p.in[20] + n0);
#pragma unroll
        for (int mf = 0; mf < 4; ++mf) { const v2u gw = *(const LAS v2u*)(gt + (16 * mf + fr) * P3C_G_STRIDE + n0 * 2);
            const f32x4 gv = {bflo(gw.x), bfhi(gw.x), bflo(gw.y), bfhi(gw.y)}; f32x4 o;
#pragma unroll
            for (int e = 0; e < 4; ++e) { o[e] = gv[e] * sigmoidf_(acc[mf][nf][e] + bg[e]); ssq[mf] += o[e] * o[e]; }
            acc[mf][nf] = o; } }
    LAS float* red = (LAS float*)(lds + P3C_RED_OFF);
#pragma unroll
    for (int mf = 0; mf < 4; ++mf) { float s = ssq[mf]; s += __shfl_xor(s, 16); s += __shfl_xor(s, 32); if (fq == 0) red[wave * 64 + 16 * mf + fr] = s; }
    __syncthreads();
    float rs[4];
#pragma unroll
    for (int mf = 0; mf < 4; ++mf) { float s = 0.f;
#pragma unroll
        for (int wv = 0; wv < 8; ++wv) s += red[wv * 64 + 16 * mf + fr];
        rs[mf] = rsqrtf(s * (1.f / CC) + EPS); }
    bf16* mixed = (bf16*)(p.ws + WS_ABUF);
#pragma unroll
    for (int nf = 0; nf < 4; ++nf) { const int n0 = 64 * wave + 16 * nf + 4 * fq; const f32x4 go = *(const f32x4*)(p.in[22] + n0);
#pragma unroll
        for (int mf = 0; mf < 4; ++mf) { const f32x4 o = acc[mf][nf] * rs[mf] * go;
            v2u w; w.x = pk2(o[0], o[1]); w.y = pk2(o[2], o[3]);
            *(v2u*)(mixed + (size_t)(t0 + 16 * mf + fr) * D + CC + n0) = w; } }
    __syncthreads();
}


constexpr int P4B_HSTRIDE = 2064, P4B_LOGIT_OFF = 32 * P4B_HSTRIDE;
__device__ __forceinline__ float wave_max(float v) {
#pragma unroll
    for (int o = 1; o < 64; o <<= 1) v = fmaxf(v, __shfl_xor(v, o));
    return v;
}
__device__ __forceinline__ void p4b_tile(const Params& p, int tile, LAS unsigned char* lds, int tid) {
    const int lane = tid & 63, wave = __builtin_amdgcn_readfirstlane(tid >> 6);
    const int t0 = tile * 32, b = t0 / SEQL;
    const float* mod = (const float*)(p.ws + WS_MOD) + b * 6 * D;
    const bf16* obuf = (const bf16*)(p.ws + WS_BBUF);
    bf16* h2 = (bf16*)(p.ws + WS_ABUF);
    LAS unsigned char* ht = lds;
    LAS float* logits = (LAS float*)(lds + P4B_LOGIT_OFF);
    const int n0 = 8 * lane, n1 = 512 + 8 * lane;
    {
        f32x4 gp[4], gt[4], gq[4], sc[4], sh[4];
#pragma unroll
        for (int q = 0; q < 4; ++q) { const int n = (q < 2 ? n0 : n1) + 4 * (q & 1);
            gp[q] = *(const f32x4*)(p.in[5] + n); gt[q] = *(const f32x4*)(mod + 2 * D + n); gq[q] = *(const f32x4*)(p.in[24] + n);
            sc[q] = *(const f32x4*)(mod + 4 * D + n) + 1.0f; sh[q] = *(const f32x4*)(mod + 3 * D + n); }
        for (int rr = 0; rr < 4; ++rr) {
            const int row = 4 * wave + rr; const size_t t = (size_t)(t0 + row);
            const v4u o0 = *(const v4u*)(obuf + t * D + n0), o1 = *(const v4u*)(obuf + t * D + n1);
            f32x4 ov[4] = {{bflo(o0.x), bfhi(o0.x), bflo(o0.y), bfhi(o0.y)}, {bflo(o0.z), bfhi(o0.z), bflo(o0.w), bfhi(o0.w)},
                           {bflo(o1.x), bfhi(o1.x), bflo(o1.y), bfhi(o1.y)}, {bflo(o1.z), bfhi(o1.z), bflo(o1.w), bfhi(o1.w)}};
            f32x4 xv[4];
#pragma unroll
            for (int q = 0; q < 4; ++q) xv[q] = *(const f32x4*)(p.in[0] + t * D + (q < 2 ? n0 : n1) + 4 * (q & 1));
            float ss = 0.f;
#pragma unroll
            for (int q = 0; q < 4; ++q) ss += (ov[q].x * ov[q].x + ov[q].y * ov[q].y) + (ov[q].z * ov[q].z + ov[q].w * ov[q].w);
            const float rstd = rsqrtf(wave_sum(ss) * (1.f / D) + EPS);
            float s2 = 0.f;
#pragma unroll
            for (int q = 0; q < 4; ++q) { xv[q] = xv[q] + gt[q] * (ov[q] * rstd * gp[q]); s2 += (xv[q].x * xv[q].x + xv[q].y * xv[q].y) + (xv[q].z * xv[q].z + xv[q].w * xv[q].w);
                *(f32x4*)(p.out + t * D + (q < 2 ? n0 : n1) + 4 * (q & 1)) = xv[q]; }
            const float r2 = rsqrtf(wave_sum(s2) * (1.f / D) + EPS);
            f32x4 hv[4];
#pragma unroll
            for (int q = 0; q < 4; ++q) hv[q] = xv[q] * r2 * gq[q] * sc[q] + sh[q];
            v4u w0, w1;
            w0.x = pk2(hv[0].x, hv[0].y); w0.y = pk2(hv[0].z, hv[0].w); w0.z = pk2(hv[1].x, hv[1].y); w0.w = pk2(hv[1].z, hv[1].w);
            w1.x = pk2(hv[2].x, hv[2].y); w1.y = pk2(hv[2].z, hv[2].w); w1.z = pk2(hv[3].x, hv[3].y); w1.w = pk2(hv[3].z, hv[3].w);
            *(v4u*)(h2 + t * D + n0) = w0; *(v4u*)(h2 + t * D + n1) = w1;
            { unsigned char* h8 = p.ws + WS_H8 + t * D;
              int a0 = __builtin_amdgcn_cvt_pk_fp8_f32(hv[0].x, hv[0].y, 0, false); a0 = __builtin_amdgcn_cvt_pk_fp8_f32(hv[0].z, hv[0].w, a0, true);
              int a1 = __builtin_amdgcn_cvt_pk_fp8_f32(hv[1].x, hv[1].y, 0, false); a1 = __builtin_amdgcn_cvt_pk_fp8_f32(hv[1].z, hv[1].w, a1, true);
              int b0 = __builtin_amdgcn_cvt_pk_fp8_f32(hv[2].x, hv[2].y, 0, false); b0 = __builtin_amdgcn_cvt_pk_fp8_f32(hv[2].z, hv[2].w, b0, true);
              int b1 = __builtin_amdgcn_cvt_pk_fp8_f32(hv[3].x, hv[3].y, 0, false); b1 = __builtin_amdgcn_cvt_pk_fp8_f32(hv[3].z, hv[3].w, b1, true);
              *(v2u*)(h8 + n0) = (v2u){(unsigned)a0, (unsigned)a1}; *(v2u*)(h8 + n1) = (v2u){(unsigned)b0, (unsigned)b1}; }
            *(LAS v4u*)(ht + row * P4B_HSTRIDE + n0 * 2) = w0; *(LAS v4u*)(ht + row * P4B_HSTRIDE + n1 * 2) = w1;
        }
    }
    __syncthreads();
    {
        const int fr = lane & 15, fq = lane >> 4, mf = wave & 1, nf = wave >> 1;
        const bf16* Wr = (const bf16*)(p.ws + WS_W_RT_T);
        f32x4 acc = {0.f, 0.f, 0.f, 0.f};
#pragma unroll 8
        for (int ks = 0; ks < 32; ++ks) {
            const bf16x8 a = *(const LAS bf16x8*)(ht + (16 * mf + fr) * P4B_HSTRIDE + (32 * ks + 8 * fq) * 2);
            const bf16x8 bb = *(const bf16x8*)(Wr + (size_t)(16 * nf + fr) * D + 32 * ks + 8 * fq);
            acc = __builtin_amdgcn_mfma_f32_16x16x32_bf16(a, bb, acc, 0, 0, 0);
        }
        MFMA_SETTLE1(acc);
#pragma unroll
        for (int r = 0; r < 4; ++r) logits[(16 * mf + 4 * fq + r) * 64 + 16 * nf + fr] = acc[r];
    }
    __syncthreads();
    {
        unsigned* cnt = (unsigned*)(p.ws + WS_CTL) + CW_CNT;
        int* list = (int*)(p.ws + WS_LIST);
        int* top_idx = (int*)(p.ws + WS_TOPIDX); float* gate_w = (float*)(p.ws + WS_GATEW);
        LAS unsigned* lcnt = (LAS unsigned*)(lds + P4B_LOGIT_OFF + 8192);
        LAS int* lsel = (LAS int*)(lds + P4B_LOGIT_OFF + 8192 + 256);
        if (tid < 64) lcnt[tid] = 0u;
        __syncthreads();
        const float brt = p.in[27][lane];
        const float NEG = -3.0e38f;
        {
            float s[4], bsc[4], gs[4], masked[4], mysel[4], ssum[4]; int myidx[4];
            const int g = lane >> 3;
#pragma unroll
            for (int rr = 0; rr < 4; ++rr) { s[rr] = sigmoidf_(logits[(4 * wave + rr) * 64 + lane]); bsc[rr] = s[rr] + brt; myidx[rr] = 0; mysel[rr] = 0.f; ssum[rr] = 0.f; }
            float m1[4], m2[4];
#pragma unroll
            for (int rr = 0; rr < 4; ++rr) m1[rr] = bsc[rr];
#pragma unroll
            for (int o = 1; o < 8; o <<= 1) {
#pragma unroll
                for (int rr = 0; rr < 4; ++rr) m1[rr] = fmaxf(m1[rr], __shfl_xor(m1[rr], o)); }
#pragma unroll
            for (int rr = 0; rr < 4; ++rr) { const unsigned long long eq = __ballot(bsc[rr] == m1[rr]);
                const int first = __ffsll((long long)(eq & (0xFFull << (8 * g)))) - 1; m2[rr] = (lane == first) ? NEG : bsc[rr]; }
#pragma unroll
            for (int o = 1; o < 8; o <<= 1) {
#pragma unroll
                for (int rr = 0; rr < 4; ++rr) m2[rr] = fmaxf(m2[rr], __shfl_xor(m2[rr], o)); }
#pragma unroll
            for (int rr = 0; rr < 4; ++rr) gs[rr] = m1[rr] + m2[rr];
            int rank[4] = {0, 0, 0, 0};
#pragma unroll
            for (int j = 0; j < 8; ++j) {
#pragma unroll
                for (int rr = 0; rr < 4; ++rr) { const float gj = __shfl(gs[rr], 8 * j); rank[rr] += (gj > gs[rr] || (gj == gs[rr] && j < g)) ? 1 : 0; } }
#pragma unroll
            for (int rr = 0; rr < 4; ++rr) masked[rr] = (rank[rr] < 4) ? bsc[rr] : NEG;
#pragma unroll
            for (int r = 0; r < 8; ++r) {
                float m[4];
#pragma unroll
                for (int rr = 0; rr < 4; ++rr) m[rr] = masked[rr];
#pragma unroll
                for (int o = 1; o < 64; o <<= 1) {
#pragma unroll
                    for (int rr = 0; rr < 4; ++rr) m[rr] = fmaxf(m[rr], __shfl_xor(m[rr], o)); }
#pragma unroll
                for (int rr = 0; rr < 4; ++rr) {
                    const unsigned long long eb = __ballot(masked[rr] == m[rr]);
                    const int idx = __ffsll((long long)eb) - 1;
                    const float sv = __shfl(s[rr], idx);
                    ssum[rr] += sv;
                    if (lane == r) { myidx[rr] = idx; mysel[rr] = sv; }
                    if (lane == idx) masked[rr] = NEG;
                }
            }
            if (lane < 8) {
#pragma unroll
                for (int rr = 0; rr < 4; ++rr) { const int row = 4 * wave + rr, t = t0 + row;
                    const float w = mysel[rr] / (ssum[rr] + 1e-20f) * 2.5f;
                    top_idx[t * 8 + lane] = myidx[rr]; gate_w[t * 8 + lane] = w;
                    const unsigned lp = __hip_atomic_fetch_add(&lcnt[myidx[rr]], 1u, __ATOMIC_RELAXED, __HIP_MEMORY_SCOPE_WORKGROUP);
                    lsel[row * 8 + lane] = myidx[rr] | ((int)lp << 8); }
            }
        }
        __syncthreads();
        if (tid < 64) { const unsigned c = lcnt[tid]; unsigned base = 0u; if (c) base = atomicAdd(&cnt[tid * CNT_STRIDE], c); lcnt[tid] = base; }
        __syncthreads();
        if (tid < 256) { const int v = lsel[tid], e = v & 255, lp = v >> 8; list[(size_t)e * T + lcnt[e] + lp] = (t0 + (tid >> 3)) * 8 + (tid & 7); }
    }
    __syncthreads();
}


__device__ __forceinline__ int moe_build_units(const Params& p, LAS unsigned char* lds, int tid, int bid, int G, int mode) {
    LAS int* tp = (LAS int*)(lds + pg8::MOE_TP_OFF);
    LAS int* desc = (LAS int*)(lds + pg8::MOE_DESC_OFF);
    LAS int* rows = (LAS int*)(lds + pg8::MOE_ROWS_OFF);
    const unsigned* cnt = (const unsigned*)(p.ws + WS_CTL) + CW_CNT;
    if (tid < 64) {
        const int nt_e = ((int)cnt[tid * CNT_STRIDE] + 255) >> 8; int s = nt_e;
#pragma unroll
        for (int o = 1; o < 64; o <<= 1) { const int v = __shfl_up(s, o); if (tid >= o) s += v; }
        tp[tid] = s - nt_e; if (tid == 63) { tp[64] = s; tp[65] = s + 64; } }
    __syncthreads();
    const int NU = tp[65] * 2;
    int nlocal = 0; for (int u = bid; u < NU; u += G) ++nlocal;
    if (nlocal > pg8::MOE_MAX_UNITS) nlocal = pg8::MOE_MAX_UNITS;
    if (tid < nlocal) { const int u = bid + tid * G, ti = u >> 1, pn = u & 1;
        int e = 0; for (int q = 1; q <= 64; ++q) if (tp[q] <= ti) e = q;
        const int tile = ti - tp[e], n = (e < 64) ? (int)cnt[e * CNT_STRIDE] : T, nv = n - tile * 256;
        desc[tid * 8 + 0] = e; desc[tid * 8 + 1] = ti; desc[tid * 8 + 2] = pn; desc[tid * 8 + 3] = nv > 256 ? 256 : nv; desc[tid * 8 + 4] = tile; }
    __syncthreads();
    const int* list = (const int*)(p.ws + WS_LIST);
    for (int q = tid; q < nlocal * 256; q += NTHREADS) { const int s = q >> 8, r = q & 255;
        const int e = desc[s * 8], tile = desc[s * 8 + 4], nv = desc[s * 8 + 3];
        int id = -1;
        if (r < nv) id = (e < 64) ? list[(size_t)e * T + tile * 256 + r] : tile * 256 + r;
        rows[q] = (mode == 0) ? (id < 0 ? 0 : (e < 64 ? (id >> 3) : id)) : id;
        if (mode == 1) ((LAS float*)(lds + pg8::MOE_W_OFF))[q] = (id >= 0 && e < 64) ? ((const float*)(p.ws + WS_GATEW))[id] : 1.0f; }
    __syncthreads();
    return nlocal;
}

struct CombLoads { v4u w0, w1; v4u q[8]; f32x4 x1[4]; };
__device__ __forceinline__ void moe_combine_load(const Params& p, int t, int lane, CombLoads& L) {
    const unsigned char* yk8 = p.ws + WS_WGU_T;
    const bf16* ycomb = (const bf16*)(p.ws + WS_ABUF);
    const int c0 = 16 * lane;
    L.w0 = *(const v4u*)(ycomb + (size_t)t * D + c0); L.w1 = *(const v4u*)(ycomb + (size_t)t * D + c0 + 8);
#pragma unroll
    for (int k = 0; k < 8; ++k) L.q[k] = *(const v4u*)(yk8 + ((size_t)t * 8 + k) * 1024 + c0);
    const float* o = p.out + (size_t)t * D + c0;
#pragma unroll
    for (int qd = 0; qd < 4; ++qd) L.x1[qd] = *(const f32x4*)(o + 4 * qd);
}
__device__ __forceinline__ void moe_combine_rows(const Params& p, int gw0, int NGW, int lane) {
    if (gw0 >= T) return;
    const int c0 = 16 * lane;
    f32x4 g[4];
#pragma unroll
    for (int qd = 0; qd < 4; ++qd) g[qd] = *(const f32x4*)(p.in[25] + c0 + 4 * qd);
    CombLoads N; moe_combine_load(p, gw0, lane, N);
    for (int t = gw0; t < T; t += NGW) {
        CombLoads L = N;
        if (t + NGW < T) moe_combine_load(p, t + NGW, lane, N);
        float a[16];
        { const v4u w0 = L.w0, w1 = L.w1;
          a[0] = bflo(w0.x); a[1] = bfhi(w0.x); a[2] = bflo(w0.y); a[3] = bfhi(w0.y); a[4] = bflo(w0.z); a[5] = bfhi(w0.z); a[6] = bflo(w0.w); a[7] = bfhi(w0.w);
          a[8] = bflo(w1.x); a[9] = bfhi(w1.x); a[10] = bflo(w1.y); a[11] = bfhi(w1.y); a[12] = bflo(w1.z); a[13] = bfhi(w1.z); a[14] = bflo(w1.w); a[15] = bfhi(w1.w); }
        float r[16];
#pragma unroll
        for (int j = 0; j < 16; ++j) r[j] = 0.f;
#pragma unroll
        for (int k = 0; k < 8; ++k) {
            const unsigned w4[4] = {L.q[k].x, L.q[k].y, L.q[k].z, L.q[k].w};
#pragma unroll
            for (int d = 0; d < 4; ++d) { const f32x2 lo = __builtin_amdgcn_cvt_pk_f32_fp8((int)w4[d], false), hi = __builtin_amdgcn_cvt_pk_f32_fp8((int)w4[d], true);
                r[4 * d + 0] += lo.x; r[4 * d + 1] += lo.y; r[4 * d + 2] += hi.x; r[4 * d + 3] += hi.y; }
        }
        float ss = 0.f;
#pragma unroll
        for (int j = 0; j < 16; ++j) { a[j] += r[j] * (1.0f / 16.0f); ss += a[j] * a[j]; }
        const float rstd = rsqrtf(wave_sum(ss) * (1.f / D) + EPS);
        const int b = t / SEQL;
        const float* gtf = (const float*)(p.ws + WS_MOD) + b * 6 * D + 5 * D;
        float* o = p.out + (size_t)t * D + c0;
#pragma unroll
        for (int qd = 0; qd < 4; ++qd) { const f32x4 gt = *(const f32x4*)(gtf + c0 + 4 * qd); f32x4 x1 = L.x1[qd];
            x1.x += gt.x * (a[4 * qd + 0] * rstd * g[qd].x); x1.y += gt.y * (a[4 * qd + 1] * rstd * g[qd].y); x1.z += gt.z * (a[4 * qd + 2] * rstd * g[qd].z); x1.w += gt.w * (a[4 * qd + 3] * rstd * g[qd].w);
            *(f32x4*)(o + 4 * qd) = x1; }
    }
}

__global__ void __launch_bounds__(NTHREADS, 2) mega(Params p) {
    extern __shared__ __attribute__((aligned(16))) unsigned char lds_raw[];
    LAS unsigned char* lds = (LAS unsigned char*)lds_raw;
    volatile LAS unsigned* MISC = (volatile LAS unsigned*)(lds + MISC_OFF);
    const int tid = threadIdx.x, lane = tid & 63, wave = __builtin_amdgcn_readfirstlane(tid >> 6);
    const int G = gridDim.x, bid = blockIdx.x;
    if (tid < 32) MISC[tid] = 0u;
    __syncthreads();
    unsigned* ctl = (unsigned*)(p.ws + WS_CTL);
    XcdBarrier bar = xcd_barrier_post(ctl + CW_BAR + p.li * XCD_BAR_WORDS, MISC + 8);
    const int gw = bid * NWAVES + wave, NGW = G * NWAVES;

    if (RUN(0)) {
    if (bid < 192) p0_mod_item(p, bid, (LAS float*)lds, tid);
    else if (bid < 196) p0_ssm_tables_gp(p, (bid - 192) * NTHREADS + tid);
    else if (bid < 200) { for (int i = 0; i < 32; ++i) p0_ssm_tables_ct(p, ((bid - 196) * NTHREADS + tid) * 32 + i); }
    {
        LAS float* scr = (LAS float*)(lds + wave * 16384);
        for (int it = gw; it < NITEMS_T; it += NGW) p0_convert_item(p, it, scr, lane);
    }
    }
    xcd_barrier(bar);
    if (RUN(1)) p1_rows(p, gw, NGW, lane);
    xcd_barrier(bar);
    if (RUN(2)) {
        pg8::StaticOrder S; S.init(p.ws + WS_ABUF, p.ws + WS_W_IN_T, T, DIN, D, G, bid);
        pg8::EpiVU E{(bf16*)(p.ws + WS_BBUF)};
        pg8::gemm_phase<pg8::EpiVU, pg8::StaticOrder, true>(lds, D, S, E);
    }
    xcd_barrier(bar);
    if (RUN(3)) {
    p3a_items(p, gw, NGW, lane);
    __syncthreads();
    if (!(p.flags & 8)) for (int tile = bid; tile < T / 32; tile += G) p3_conv_tile(p, tile, lds, tid);
    }
    xcd_barrier(bar);
    if (RUN(4)) for (int blk = bid; blk < 256; blk += G) p3b_block(p, blk, lds, tid);
    xcd_barrier(bar);
    if (RUN(5)) for (int c = bid; c < T / 64; c += G) p3c_chunk(p, c, lds, tid);
    xcd_barrier(bar);
    if (RUN(6)) {
        pg8::StaticOrder S; S.init(p.ws + WS_ABUF, p.ws + WS_W_OUT_T, T, D, D, G, bid);
        pg8::EpiBf16Plain E{(bf16*)(p.ws + WS_BBUF), D};
        pg8::gemm_phase<pg8::EpiBf16Plain, pg8::StaticOrder, true>(lds, D, S, E);
    }
    xcd_barrier(bar);
    if (RUN(7)) for (int tile = bid; tile < T / 32; tile += G) p4b_tile(p, tile, lds, tid);
    xcd_barrier(bar);
    if (RUN(8)) {
        const int nl = moe_build_units(p, lds, tid, bid, G, 0);
        pg8::MoeSched S{(const char*)(p.ws + WS_H8), (const char*)(p.ws + WS_WGU_T), lds, nl, D, 0, 1};
        pg8::EpiAct E{p.ws + WS_ACT, 1.0f / 32.0f};
        pg8::gemm_phase<pg8::EpiAct, pg8::MoeSched, true, true, 1>(lds, D, S, E);
    }
    xcd_barrier(bar);
    if (RUN(9)) {
        const int nl = moe_build_units(p, lds, tid, bid, G, 1);
        pg8::MoeSched S{(const char*)(p.ws + WS_ACT), (const char*)(p.ws + WS_WD_T), lds, 2 * nl, DE, 1, 1};
        pg8::EpiDown E{p.ws + WS_WGU_T, (bf16*)(p.ws + WS_ABUF), lds};
        pg8::gemm_phase<pg8::EpiDown, pg8::MoeSched, true, false, 1>(lds, DE, S, E);
    }
    xcd_barrier(bar);
    if (RUN(10)) { int l10 = lane; asm volatile("" : "+v"(l10));
        moe_combine_rows(p, gw, NGW, l10); }
}

extern "C" void kernel_launch(void* const* d_in, const int* in_sizes, int n_in, void* d_out, int out_size, void* d_ws, size_t ws_size, hipStream_t stream) {
    static int grid = 0;
    if (grid == 0) {
        int dev = 0, cus = 0;
        if (n_in != 34 || out_size != T * D || ws_size < WS_END) { grid = -1; return; }
        if (hipGetDevice(&dev) != hipSuccess || hipDeviceGetAttribute(&cus, hipDeviceAttributeMultiprocessorCount, dev) != hipSuccess) { grid = -1; return; }
        if (hipFuncSetAttribute((const void*)mega, hipFuncAttributeMaxDynamicSharedMemorySize, LDS_BYTES) != hipSuccess) { grid = -1; return; }
        (void)hipGetLastError();
        grid = cus;
    }
    if (grid < 0) return;
    (void)hipMemsetAsync((char*)d_ws + WS_CTL, 0, CTL_ZERO_BYTES, stream);
    Params p{};
    for (int i = 0; i < 34; ++i) p.in[i] = (const float*)d_in[i];
    p.out = (float*)d_out; p.ws = (unsigned char*)d_ws; p.ph_lo = 0; p.ph_hi = 99;
    hipLaunchKernelGGL(mega, dim3(grid), dim3(NTHREADS), LDS_BYTES, stream, p);
    if (PROBE_K >= 0 && PROBE_K < 60) { Params q = p; q.ph_lo = PROBE_K; q.ph_hi = PROBE_K + 1; q.li = 1; q.flags = PROBE_FLAGS; hipLaunchKernelGGL(mega, dim3(grid), dim3(NTHREADS), LDS_BYTES, stream, q); }

}
```

```cpp
#include <hip/hip_runtime.h>
#include <cstdio>
#include <cstdint>

#define GAS __attribute__((address_space(1)))
#define LAS __attribute__((address_space(3)))
typedef unsigned short bf16;
typedef unsigned v4u __attribute__((ext_vector_type(4)));
typedef unsigned v2u __attribute__((ext_vector_type(2)));
typedef float f32x4 __attribute__((ext_vector_type(4)));
typedef float f32x2 __attribute__((ext_vector_type(2)));
typedef short bf16x8 __attribute__((ext_vector_type(8)));
typedef int i32x8 __attribute__((ext_vector_type(8)));

constexpr int T = 16384, D = 1024, SEQL = 8192, DIN = 1536, CC = 512, NE = 64, DE = 256;
constexpr float EPS = 1e-6f;
constexpr int NTHREADS = 512, NWAVES = 8;
constexpr int LDS_BYTES = 147456;
constexpr int RING_BYTES = 131072, MISC_OFF = LDS_BYTES - 512;

constexpr size_t MiB = 1u << 20;
constexpr size_t WS_CTL = 0, CTL_ZERO_BYTES = 128 * 1024;
constexpr size_t WS_MOD = 1 * MiB;
constexpr size_t WS_LAM = WS_MOD + 64 * 1024;
constexpr size_t WS_LAM32 = WS_MOD + 80 * 1024;
constexpr size_t WS_BB = WS_MOD + 96 * 1024;
constexpr size_t WS_CT = WS_MOD + 224 * 1024;
constexpr size_t WS_WD_T = 2 * MiB;
constexpr size_t WS_LISTS = 35 * MiB;
constexpr size_t WS_ABUF = 41 * MiB;
constexpr size_t WS_ACT = 73 * MiB;
constexpr size_t WS_X1B = 114 * MiB;
constexpr size_t WS_SSMU = 73 * MiB;
constexpr size_t WS_WGU_T = 153 * MiB;
constexpr size_t WS_W_IN_T = 218 * MiB;
constexpr size_t WS_W_OUT_T = 221 * MiB;
constexpr size_t WS_W_GLU_T = 223 * MiB;
constexpr size_t WS_W_RT_T = 223 * MiB + 512 * 1024;
constexpr size_t WS_H8 = 190 * MiB;
constexpr size_t WS_E = 224 * MiB;
constexpr size_t WS_SINIT = 232 * MiB;
constexpr size_t WS_BBUF = 240 * MiB;
constexpr size_t WS_END = 281 * MiB;
constexpr size_t WS_NAIVE = 2 * MiB;

constexpr int CW_BAR = 4096;
constexpr int PROBE_K = -1;
constexpr int PROBE_FLAGS = 0;
#define RUN(k) (p.ph_lo <= (k) && (k) < p.ph_hi)
constexpr int CW_CNT = 16384, CNT_STRIDE = 64;
constexpr size_t WS_LIST = WS_LISTS;
constexpr size_t WS_TOPIDX = WS_LISTS + 4 * MiB;
constexpr size_t WS_GATEW = WS_LISTS + 4 * MiB + 512 * 1024;

__device__ __forceinline__ float sigmoidf_(float x) { return __builtin_amdgcn_rcpf(1.0f + __expf(-x)); }
__device__ __forceinline__ float siluf_(float x) { return x * sigmoidf_(x); }
__device__ __forceinline__ float gelu_tanh(float x) {
    const float c1 = -2.0f * 0.7978845608028654f * 1.4426950408889634f, c3 = c1 * 0.044715f;
    const float pw = x * fmaf(x * x, c3, c1);
    return x * __builtin_amdgcn_rcpf(1.0f + __builtin_amdgcn_exp2f(pw));
}
__device__ __forceinline__ unsigned pk2(float lo, float hi) { unsigned r; asm("v_cvt_pk_bf16_f32 %0, %1, %2" : "=v"(r) : "v"(lo), "v"(hi)); return r; }
__device__ __forceinline__ unsigned f2bf(float f) { return pk2(f, f) & 0xffffu; }
__device__ __forceinline__ float bf2f(unsigned short b) { return __builtin_bit_cast(float, ((unsigned)b) << 16); }
__device__ __forceinline__ float bflo(unsigned w) { return __builtin_bit_cast(float, w << 16); }
__device__ __forceinline__ float bfhi(unsigned w) { return __builtin_bit_cast(float, w & 0xffff0000u); }
#define LDS_WAIT() asm volatile("s_waitcnt lgkmcnt(0)" ::: "memory")
#define VM_WAIT() asm volatile("s_waitcnt vmcnt(0)" ::: "memory")

template <int CTRL> __device__ __forceinline__ float dpp_mov(float v) { return __builtin_bit_cast(float, __builtin_amdgcn_update_dpp(0, __builtin_bit_cast(int, v), CTRL, 0xF, 0xF, true)); }
__device__ __forceinline__ float lane_bcast(float v, int l) { return __builtin_bit_cast(float, __builtin_amdgcn_readlane(__builtin_bit_cast(int, v), l)); }
__device__ __forceinline__ float wave_sum(float v) {
    v += dpp_mov<0xB1>(v); v += dpp_mov<0x4E>(v); v += dpp_mov<0x141>(v); v += dpp_mov<0x140>(v);
    return (lane_bcast(v, 0) + lane_bcast(v, 16)) + (lane_bcast(v, 32) + lane_bcast(v, 48));
}
__device__ __forceinline__ float group8_max(float v) { v = fmaxf(v, dpp_mov<0xB1>(v)); v = fmaxf(v, dpp_mov<0x4E>(v)); v = fmaxf(v, dpp_mov<0x141>(v)); return v; }
__device__ __forceinline__ float wave_max(float v) {
    v = group8_max(v); v = fmaxf(v, dpp_mov<0x140>(v));
    return fmaxf(fmaxf(lane_bcast(v, 0), lane_bcast(v, 16)), fmaxf(lane_bcast(v, 32), lane_bcast(v, 48)));
}
__device__ __forceinline__ float block_sum(float v, float* red) {
    v = wave_sum(v);
    const int w = threadIdx.x >> 6, nw = blockDim.x >> 6;
    __syncthreads();
    if ((threadIdx.x & 63) == 0) red[w] = v;
    __syncthreads();
    float s = 0.f;
    for (int i = 0; i < nw; ++i) s += red[i];
    return s;
}

#define XB_TMO      128
#define XB_XCNT(j)  (256  + 64 * (j))
#define XB_XSUB(j)  (1280 + 64 * (j))
#define XB_XGEN(j)  (2304 + 64 * (j))
#define XB_TOP      3328
#define XB_TOPGEN   3392
#define XCD_BAR_WORDS 3456
#define XB_SPIN_CAP (1u << 18)
__device__ __forceinline__ unsigned xb_ld(unsigned* p)              { return __hip_atomic_load(p, __ATOMIC_RELAXED, __HIP_MEMORY_SCOPE_AGENT); }
__device__ __forceinline__ unsigned xb_add(unsigned* p, unsigned v) { return __hip_atomic_fetch_add(p, v, __ATOMIC_RELAXED, __HIP_MEMORY_SCOPE_AGENT); }
__device__ __forceinline__ unsigned xb_xcc_id() { return (unsigned)__builtin_amdgcn_s_getreg((3 << 11) | 20) & 0xFu; }
#define XB_SPIN(cond, bar) do { unsigned _sp = 0; while (cond) { __builtin_amdgcn_s_sleep(1); \
    if ((++_sp & 255u) == 0u) { if (xb_ld(&(bar)[XB_TMO])) break; if (_sp > XB_SPIN_CAP) { atomicAdd(&(bar)[XB_TMO], 1u); break; } } } } while (0)
struct XcdBarrier { unsigned* bar; unsigned x; volatile LAS unsigned* st; };
__device__ __forceinline__ XcdBarrier xcd_barrier_post(unsigned* bar, volatile LAS unsigned* st) {
    XcdBarrier b; b.bar = bar; b.x = xb_xcc_id(); b.st = st;
    if (threadIdx.x == 0) (void)xb_add(&bar[XB_XCNT(b.x)], 1u);
    return b;
}
__device__ __forceinline__ void xcd_barrier_complete(unsigned* bar, unsigned x, unsigned& nloc, unsigned& nx) {
    const unsigned G = gridDim.x * gridDim.y * gridDim.z;
    unsigned sum, cnt, mine, sp = 0u;
    for (;;) {
        sum = 0u; cnt = 0u; mine = 0u;
#pragma unroll
        for (unsigned j = 0; j < 16; ++j) { const unsigned c = xb_ld(&bar[XB_XCNT(j)]); sum += c; cnt += (c > 0u) ? 1u : 0u; mine = (j == x) ? c : mine; }
        if (sum == G) break;
        __builtin_amdgcn_s_sleep(1);
        if ((++sp & 255u) == 0u) { if (xb_ld(&bar[XB_TMO])) break; if (sp > XB_SPIN_CAP) { atomicAdd(&bar[XB_TMO], 1u); break; } }
    }
    nloc = mine > 0u ? mine : 1u; nx = cnt > 0u ? cnt : 1u;
}
__device__ __forceinline__ void xcd_barrier(const XcdBarrier& b) {
    asm volatile("s_waitcnt vmcnt(0)" ::: "memory");
    __syncthreads();
    if (threadIdx.x == 0) {
        unsigned* bar = b.bar;
        __builtin_amdgcn_s_waitcnt(0);
        unsigned nloc = b.st[0], nx = b.st[1];
        if (nloc == 0u) { xcd_barrier_complete(bar, b.x, nloc, nx); b.st[0] = nloc; b.st[1] = nx; }
        const unsigned old = xb_add(&bar[XB_XSUB(b.x)], 1u);
        const unsigned gen = old / nloc;
        if (old + 1u == (gen + 1u) * nloc) {
            __builtin_amdgcn_fence(__ATOMIC_RELEASE, "agent");
            asm volatile("s_waitcnt vmcnt(0)" ::: "memory");
            const unsigned og = xb_add(&bar[XB_TOP], 1u);
            const unsigned tg = og / nx;
            if (og + 1u == (tg + 1u) * nx) xb_add(&bar[XB_TOPGEN], 1u);
            else XB_SPIN(xb_ld(&bar[XB_TOPGEN]) == tg, bar);
            __builtin_amdgcn_fence(__ATOMIC_ACQUIRE, "agent");
            xb_add(&bar[XB_XGEN(b.x)], 1u);
            asm volatile("s_waitcnt vmcnt(0)" ::: "memory");
        } else {
            XB_SPIN(xb_ld(&bar[XB_XGEN(b.x)]) == gen, bar);
            __builtin_amdgcn_fence(__ATOMIC_ACQUIRE, "agent");
            asm volatile("s_waitcnt vmcnt(0)" ::: "memory");
        }
    }
    __syncthreads();
}

namespace pg8 {
#define PG8_LAS __attribute__((address_space(3)))
constexpr int BM = 256, BK = 64, HALF = 128, HTB = HALF * BK * 2, STAGE_BYTES = 8 * HTB, NXCD = 8, WGM = 8;
__host__ __device__ __forceinline__ int lds_byte(int r, int c) { const int st = (r >> 4) * 2 + (c >> 5), rr = r & 15, cc = c & 31, ob = rr * 64 + cc * 2; return st * 1024 + (ob ^ (((ob >> 9) & 1) << 5)); }
__host__ __device__ __forceinline__ void stage_rc(int b, int& R, int& C) { const int st = b / 1024, sb = b % 1024, swz = sb ^ (((sb >> 9) & 1) << 5); R = (st >> 1) * 16 + swz / 64; C = (st & 1) * 32 + (swz % 64) / 2; }
__host__ __device__ __forceinline__ int perm32(int rho) { const int n = rho >> 4, i = rho & 15; return 8 * (i >> 2) + 4 * n + (i & 3); }

struct Unit { const char* A; const char* B; int pm, pn, e, nvalid, slot; };

struct StaticOrder {
    const char* A; const char* B; int K;
    int nM, nN, nwg, G, c;
    __device__ void init(const void* A_, const void* B_, int M, int N, int K_, int G_, int c_) { A = (const char*)A_; B = (const char*)B_; K = K_; nM = M / BM; nN = N / BM; nwg = nM * nN; G = G_; c = c_; }
    __device__ bool next(int i, Unit& u) const {
        const long L = (long)i * G + c; if (L >= nwg) return false;
        int wgid = (int)L; { const int q = nwg / NXCD, r = nwg % NXCD, xcd = wgid % NXCD, off = wgid / NXCD; wgid = (xcd < r ? xcd * (q + 1) : r * (q + 1) + (xcd - r) * q) + off; }
        const int nig = WGM * nN, gid = wgid / nig, fm = gid * WGM, gsz = (nM - fm) < WGM ? (nM - fm) : WGM;
        u.pm = fm + ((wgid % nig) % gsz); u.pn = (wgid % nig) / gsz; u.e = 0; u.nvalid = BM; u.slot = 0;
        u.A = A + (size_t)u.pm * BM * K * 2; u.B = B + (size_t)u.pn * BM * K * 2; return true;
    }
    __device__ const PG8_LAS int* rowsA(int) const { return nullptr; }
};

__device__ __forceinline__ unsigned cvt_pk_bf16(float lo, float hi) { unsigned r; asm volatile("v_cvt_pk_bf16_f32 %0, %1, %2" : "=v"(r) : "v"(lo), "v"(hi)); return r; }

__device__ __forceinline__ f32x4 mma_bf16(v4u b, v4u a, f32x4 c) { return __builtin_amdgcn_mfma_f32_16x16x32_bf16(__builtin_bit_cast(bf16x8, b), __builtin_bit_cast(bf16x8, a), c, 0, 0, 0); }
__device__ __forceinline__ f32x4 mma_fp8(i32x8 B, i32x8 A, f32x4 c) {
    return __builtin_amdgcn_mfma_scale_f32_16x16x128_f8f6f4(B, A, c, 0, 0, 0, 0x7f7f7f7f, 0, 0x7f7f7f7f);
}
typedef int i32x4 __attribute__((ext_vector_type(4)));
template <class Epi, class Sched, bool ALIGN_EPI, bool GATHER = false, int ESZ = 2>
__device__ __forceinline__ void gemm_phase(PG8_LAS unsigned char* lds, const int K, const Sched& S, const Epi& E) {
    const int tid = threadIdx.x, wid = __builtin_amdgcn_readfirstlane(tid >> 6), lane = tid & 63, wr = wid >> 2, wc = wid & 3, fr = lane & 15, fq = lane >> 4;
    const int rb = K * ESZ; int nt = rb / (BK * 2);
    asm volatile("" : "+s"(nt));
    unsigned voffB[2]; int RA[2], CA[2];
#pragma unroll
    for (int i = 0; i < 2; ++i) { int R, C; stage_rc(tid * 16 + i * 8192, R, C); const int Rb = Epi::PERM ? ((R & ~31) + perm32(R & 31)) : R;
        const int Cb = (ESZ == 2) ? C * 2 : (((C >> 3) & 3) * 32 + (C >> 5) * 16);
        RA[i] = R; CA[i] = Cb; voffB[i] = (unsigned)(Rb * rb + Cb); }
    unsigned cvA0[2], cvA1[2];
#define PG8_SETVA(v0, v1, ui_) do { _Pragma("unroll") for (int _i = 0; _i < 2; ++_i) { \
        v0[_i] = (unsigned)(RA[_i] * rb + CA[_i]); v1[_i] = (unsigned)((HALF + RA[_i]) * rb + CA[_i]); } } while (0)
#define PG8_GVA(v, ui_, h_) do { unsigned _t = threadIdx.x; asm volatile("" : "+v"(_t)); const PG8_LAS int* _rows = S.rowsA(ui_); \
          \
        const unsigned _b = _t * 16u, _st = _b >> 10, _sb = _b & 1023u, _sw = _sb ^ (((_sb >> 9) & 1u) << 5), _R = (_st >> 1) * 16u + (_sw >> 6), _C = (_st & 1u) * 32u + ((_sw & 63u) >> 1); \
        const unsigned _cb = (ESZ == 2) ? _C * 2u : (((_C >> 3) & 3u) * 32u + (_C >> 5) * 16u); \
        _Pragma("unroll") for (int _i = 0; _i < 2; ++_i) v[_i] = (unsigned)(_rows[(h_) * HALF + _R + 64 * _i] * rb) + _cb; } while (0)
    const size_t kstep = (size_t)(BK * 2);
    const size_t hstep = (size_t)HALF * rb;
    const unsigned ldsw = (unsigned)wid * 1024u;
    const int aoff0 = lds_byte(wr * 64 + fr, fq * 8), boff0 = lds_byte(wc * 32 + fr, fq * 8);
    constexpr int CH1 = 1024;
#define PG8_SA(b, h) (((b) * 2 + (h)) * HTB)
#define PG8_SB(b, h) ((4 + (b) * 2 + (h)) * HTB)
#define PG8_STAGE(bufoff, gbase, voff) do { const char* _g = (const char*)(gbase); asm volatile("" : "+s"(_g));     \
        _Pragma("unroll") for (int _i = 0; _i < 2; ++_i) { unsigned _vo = (voff)[_i]; asm volatile("" : "+v"(_vo)); \
        __builtin_amdgcn_global_load_lds((const unsigned*)(_g + _vo), (PG8_LAS unsigned*)(lds + (bufoff) + ldsw + _i * 8192), 16, 0, 0); } } while (0)
#define PG8_LDF(lo_, hi_) __builtin_shufflevector(__builtin_bit_cast(i32x4, *(const PG8_LAS v4u*)(lo_)), __builtin_bit_cast(i32x4, *(const PG8_LAS v4u*)(hi_)), 0, 1, 2, 3, 4, 5, 6, 7)
#define PG8_LDA(dst, b, h) do { _Pragma("unroll") for (int m = 0; m < 4; ++m) dst[m] = PG8_LDF(lds + PG8_SA(b, h) + aoff0 + m * 2048, lds + PG8_SA(b, h) + aoff0 + m * 2048 + CH1); } while (0)
#define PG8_LDB(dst, b, h) do { _Pragma("unroll") for (int n = 0; n < 2; ++n) dst[n] = PG8_LDF(lds + PG8_SB(b, h) + boff0 + n * 2048, lds + PG8_SB(b, h) + boff0 + n * 2048 + CH1); } while (0)
#define PG8_LO(x) __builtin_bit_cast(v4u, __builtin_shufflevector(x, x, 0, 1, 2, 3))
#define PG8_HI(x) __builtin_bit_cast(v4u, __builtin_shufflevector(x, x, 4, 5, 6, 7))
#define PG8_MMA(ai, bj, At, Bt) do { __builtin_amdgcn_s_setprio(1); _Pragma("unroll") for (int m = 0; m < 4; ++m) _Pragma("unroll") for (int n = 0; n < 2; ++n) { \
        if constexpr (ESZ == 2) { acc[ai][bj][m][n] = mma_bf16(PG8_LO(Bt[n]), PG8_LO(At[m]), acc[ai][bj][m][n]); acc[ai][bj][m][n] = mma_bf16(PG8_HI(Bt[n]), PG8_HI(At[m]), acc[ai][bj][m][n]); } \
        else acc[ai][bj][m][n] = mma_fp8(Bt[n], At[m], acc[ai][bj][m][n]); } __builtin_amdgcn_s_setprio(0); } while (0)
#define PG8_MMA0(ai, bj, At, Bt) do { __builtin_amdgcn_s_setprio(1); _Pragma("unroll") for (int m = 0; m < 4; ++m) _Pragma("unroll") for (int n = 0; n < 2; ++n) { const f32x4 _z = {0.f, 0.f, 0.f, 0.f}; \
        if constexpr (ESZ == 2) { acc[ai][bj][m][n] = mma_bf16(PG8_LO(Bt[n]), PG8_LO(At[m]), _z); acc[ai][bj][m][n] = mma_bf16(PG8_HI(Bt[n]), PG8_HI(At[m]), acc[ai][bj][m][n]); } \
        else acc[ai][bj][m][n] = mma_fp8(Bt[n], At[m], _z); } __builtin_amdgcn_s_setprio(0); \
          \
        asm volatile("" : "+v"(acc[ai][bj][0][0]), "+v"(acc[ai][bj][0][1]), "+v"(acc[ai][bj][1][0]), "+v"(acc[ai][bj][1][1]), "+v"(acc[ai][bj][2][0]), "+v"(acc[ai][bj][2][1]), "+v"(acc[ai][bj][3][0]), "+v"(acc[ai][bj][3][1])); } while (0)
#define PG8_WAIT_V(n) asm volatile("s_waitcnt vmcnt(" #n ")" ::: "memory")
#define PG8_WAIT_L(n) asm volatile("s_waitcnt lgkmcnt(" #n ")" ::: "memory")
#define PG8_BAR __builtin_amdgcn_s_barrier()
#define PG8_SCHED __builtin_amdgcn_sched_barrier(0)
    Unit cur, nxt; int ui = 0;
    if (!S.next(0, cur)) return;
    f32x4 acc[2][2][4][2];
    if constexpr (!Epi::ONE_ITER && !Epi::PEEL) {
#pragma unroll
    for (int a = 0; a < 2; ++a)
#pragma unroll
        for (int b = 0; b < 2; ++b)
#pragma unroll
            for (int m = 0; m < 4; ++m)
#pragma unroll
                for (int n = 0; n < 2; ++n) acc[a][b][m][n] = (f32x4){0.f, 0.f, 0.f, 0.f};
    }
    i32x8 At[4], B0[2], B1[2];
    const char* cA = cur.A; const char* cB = cur.B;
    if constexpr (!GATHER) PG8_SETVA(cvA0, cvA1, 0);
#define PG8_STAGE_A(bufoff, gbase, h_, ui_) do { if constexpr (GATHER) { unsigned _v[2]; PG8_GVA(_v, ui_, h_); PG8_STAGE(bufoff, gbase, _v); } else { if ((h_) == 0) PG8_STAGE(bufoff, gbase, cvA0); else PG8_STAGE(bufoff, gbase, cvA1); } } while (0)
    PG8_STAGE(PG8_SB(0, 0), cB, voffB); PG8_STAGE(PG8_SB(0, 1), cB + hstep, voffB); PG8_STAGE_A(PG8_SA(0, 0), cA, 0, 0); PG8_STAGE_A(PG8_SA(0, 1), cA, 1, 0);
    if (wr == 1) PG8_BAR;
    PG8_WAIT_V(2); PG8_BAR;
    PG8_STAGE(PG8_SB(1, 0), cB + kstep, voffB); PG8_STAGE_A(PG8_SA(1, 0), cA + kstep, 0, 0); PG8_STAGE(PG8_SB(1, 1), cB + hstep + kstep, voffB);
    PG8_WAIT_V(6); PG8_BAR;
    for (;;) {
        const bool has_next = S.next(ui + 1, nxt);
        const char* nA = has_next ? nxt.A : cA; const char* nB = has_next ? nxt.B : cB;
#define PG8_PINZ(Z, ai, bj) do { if constexpr (Z) asm volatile("" : "+v"(acc[ai][bj][0][0]), "+v"(acc[ai][bj][0][1]), "+v"(acc[ai][bj][1][0]), "+v"(acc[ai][bj][1][1]), "+v"(acc[ai][bj][2][0]), "+v"(acc[ai][bj][2][1]), "+v"(acc[ai][bj][3][0]), "+v"(acc[ai][bj][3][1])); } while (0)
#define PG8_KBODY(Z) \
            const bool last = (t == nt - 2); \
            const char* a1 = cA + (size_t)(t + 1) * kstep; \
            const char* a2 = last ? nA : cA + (size_t)(t + 2) * kstep; const char* b2 = last ? nB : cB + (size_t)(t + 2) * kstep; \
            const char* a3 = a2 + kstep; const char* b3 = b2 + kstep; \
            const int un = (last && has_next) ? ui + 1 : ui; \
            PG8_LDB(B0, 0, 0); PG8_LDB(B1, 0, 1); PG8_SCHED; PG8_LDA(At, 0, 0); PG8_STAGE_A(PG8_SA(1, 1), a1, 1, ui); \
            PG8_WAIT_V(8); PG8_WAIT_L(0); PG8_BAR; if constexpr (Z) { PG8_MMA0(0, 0, At, B0); PG8_MMA0(0, 1, At, B1); } else { PG8_MMA(0, 0, At, B0); PG8_MMA(0, 1, At, B1); } PG8_BAR; PG8_SCHED; \
            PG8_LDA(At, 0, 1); PG8_STAGE(PG8_SB(0, 0), b2, voffB); PG8_STAGE(PG8_SB(0, 1), b2 + hstep, voffB); PG8_STAGE_A(PG8_SA(0, 0), a2, 0, un); \
            PG8_WAIT_V(8); PG8_WAIT_L(0); PG8_BAR; if constexpr (Z) { PG8_MMA0(1, 0, At, B0); PG8_MMA0(1, 1, At, B1); } else { PG8_MMA(1, 0, At, B0); PG8_MMA(1, 1, At, B1); } PG8_BAR; PG8_SCHED; \
            PG8_LDB(B0, 1, 0); PG8_LDB(B1, 1, 1); PG8_SCHED; PG8_LDA(At, 1, 0); PG8_STAGE_A(PG8_SA(0, 1), a2, 1, un); \
            PG8_WAIT_V(8); PG8_WAIT_L(0); PG8_BAR; PG8_MMA(0, 0, At, B0); PG8_MMA(0, 1, At, B1); PG8_PINZ(Z, 0, 0); PG8_PINZ(Z, 0, 1); PG8_BAR; PG8_SCHED; \
            PG8_LDA(At, 1, 1); PG8_STAGE(PG8_SB(1, 0), b3, voffB); PG8_STAGE(PG8_SB(1, 1), b3 + hstep, voffB); PG8_STAGE_A(PG8_SA(1, 0), a3, 0, un); \
            PG8_WAIT_V(8); PG8_WAIT_L(0); PG8_BAR; PG8_MMA(1, 0, At, B0); PG8_MMA(1, 1, At, B1); PG8_PINZ(Z, 1, 0); PG8_PINZ(Z, 1, 1); PG8_BAR; PG8_SCHED;
        int t = 0;
        if constexpr (Epi::PEEL) { { PG8_KBODY(true) } t = 2; }
#pragma unroll 1
        for (; t < nt; t += 2) { PG8_KBODY(Epi::ONE_ITER) }
#undef PG8_KBODY
#undef PG8_PINZ
        if constexpr (ALIGN_EPI) { if (wr == 0) PG8_BAR; }
        PG8_SCHED; asm volatile("s_nop 15\n\ts_nop 15"); PG8_SCHED;
        E(acc, cur, wr, wc, fr, fq);
        if (!has_next) break;
        if constexpr (!Epi::ONE_ITER && !Epi::PEEL) {
#pragma unroll
        for (int a = 0; a < 2; ++a)
#pragma unroll
            for (int b = 0; b < 2; ++b)
#pragma unroll
                for (int m = 0; m < 4; ++m)
#pragma unroll
                    for (int n = 0; n < 2; ++n) acc[a][b][m][n] = (f32x4){0.f, 0.f, 0.f, 0.f};
        }
        cur = nxt; cA = nA; cB = nB; ++ui;
        if constexpr (ALIGN_EPI) { if (wr == 1) PG8_BAR; }
    }
    PG8_WAIT_V(0);
    if constexpr (!ALIGN_EPI) { if (wr == 0) PG8_BAR; }
    PG8_BAR;
#undef PG8_SETVA
#undef PG8_GVA
#undef PG8_STAGE_A
#undef PG8_SA
#undef PG8_SB
#undef PG8_STAGE
#undef PG8_LDA
#undef PG8_LDF
#undef PG8_LO
#undef PG8_HI
#undef PG8_LDB
#undef PG8_MMA
#undef PG8_MMA0
#undef PG8_WAIT_V
#undef PG8_WAIT_L
#undef PG8_BAR
#undef PG8_SCHED
}

struct EpiVU {
    static constexpr bool PERM = true; static constexpr bool PEEL = true; static constexpr bool ONE_ITER = false;
    bf16* vu; bf16* ssmu;
    __device__ __forceinline__ void operator()(const f32x4 (&acc)[2][2][4][2], const Unit& u, int wr, int wc, int fr, int fq) const {
        const int row0 = u.pm * BM + wr * 64 + fr, cw = wc * 32 + 8 * fq;
#pragma unroll
        for (int ai = 0; ai < 2; ++ai)
#pragma unroll
            for (int m = 0; m < 4; ++m) { bf16* rowp = vu + (size_t)(row0 + ai * HALF + m * 16) * D;
                if (u.pn < 4) {
                    f32x4 a0 = acc[ai][0][m][0], a1 = acc[ai][0][m][1]; const f32x4 g0 = acc[ai][1][m][0], g1 = acc[ai][1][m][1];
#pragma unroll
                    for (int j = 0; j < 4; ++j) { a0[j] *= sigmoidf_(g0[j]); a1[j] *= sigmoidf_(g1[j]); }
                    v4u w; w.x = cvt_pk_bf16(a0[0], a0[1]); w.y = cvt_pk_bf16(a0[2], a0[3]); w.z = cvt_pk_bf16(a1[0], a1[1]); w.w = cvt_pk_bf16(a1[2], a1[3]);
                    *(v4u*)(rowp + u.pn * 128 + cw) = w;
                } else {
#pragma unroll
                    for (int bj = 0; bj < 2; ++bj) { const f32x4 v0 = acc[ai][bj][m][0], v1 = acc[ai][bj][m][1];
                        v4u w; w.x = cvt_pk_bf16(v0[0], v0[1]); w.y = cvt_pk_bf16(v0[2], v0[3]); w.z = cvt_pk_bf16(v1[0], v1[1]); w.w = cvt_pk_bf16(v1[2], v1[3]);
                        const int cs = (u.pn - 4) * 256 + bj * HALF + cw;
                        *(v4u*)(ssmu + ((size_t)(cs >> 4) * T + (size_t)(row0 + ai * HALF + m * 16)) * 16 + (cs & 15)) = w; }
                }
            }
    }
};
struct EpiBf16Plain {
    static constexpr bool PERM = true; static constexpr bool PEEL = true; static constexpr bool ONE_ITER = false;
    bf16* O; int ldc;
    __device__ __forceinline__ void operator()(const f32x4 (&acc)[2][2][4][2], const Unit& u, int wr, int wc, int fr, int fq) const {
        const int row0 = u.pm * BM + wr * 64 + fr, col0 = u.pn * BM + wc * 32 + 8 * fq;
#pragma unroll
        for (int ai = 0; ai < 2; ++ai)
#pragma unroll
            for (int m = 0; m < 4; ++m) { bf16* rowp = O + (size_t)(row0 + ai * HALF + m * 16) * ldc + col0;
#pragma unroll
                for (int bj = 0; bj < 2; ++bj) { const f32x4 v0 = acc[ai][bj][m][0], v1 = acc[ai][bj][m][1];
                    v4u w; w.x = cvt_pk_bf16(v0[0], v0[1]); w.y = cvt_pk_bf16(v0[2], v0[3]); w.z = cvt_pk_bf16(v1[0], v1[1]); w.w = cvt_pk_bf16(v1[2], v1[3]);
                    *(v4u*)(rowp + bj * HALF) = w; } }
    }
};

constexpr int MOE_TP_OFF = 131072, MOE_DESC_OFF = 131072 + 512, MOE_ROWS_OFF = 131072 + 1024, MOE_MAX_UNITS = 6, MOE_W_OFF = MOE_ROWS_OFF + MOE_MAX_UNITS * 1024;
struct MoeSched {
    const char* Abase; const char* Bbase; PG8_LAS unsigned char* lds; int nlocal, K, mode, esz;
    __device__ bool next(int i, Unit& u) const {
        if (i >= nlocal) return false;
        const int it = mode == 0 ? i : (i >> 1);
        const PG8_LAS int* d = (const PG8_LAS int*)(lds + MOE_DESC_OFF) + it * 8;
        u.e = __builtin_amdgcn_readfirstlane(d[0]); u.pm = __builtin_amdgcn_readfirstlane(d[1]); u.pn = __builtin_amdgcn_readfirstlane(d[2]); u.nvalid = __builtin_amdgcn_readfirstlane(d[3]); u.slot = it;
        if (mode == 0) { u.A = Abase; u.B = Bbase + ((size_t)u.e * 512 + (size_t)u.pn * 256) * 1024 * esz; }
        else { u.pn = 2 * u.pn + (i & 1); u.A = Abase + (size_t)u.pm * 256 * 256 * esz; u.B = Bbase + ((size_t)u.e * 1024 + (size_t)u.pn * 256) * 256 * esz; }
        return true;
    }
    __device__ const PG8_LAS int* rowsA(int i) const { return (const PG8_LAS int*)(lds + MOE_ROWS_OFF) + i * 256; }
};
struct EpiAct {
    static constexpr bool PERM = true; static constexpr bool PEEL = true; static constexpr bool ONE_ITER = false;
    unsigned char* act8; float isc;
    __device__ __forceinline__ void operator()(const f32x4 (&acc)[2][2][4][2], const Unit& u, int wr, int wc, int fr, int fq) const {
        const size_t row0 = (size_t)u.pm * BM + wr * 64 + fr; const int col0 = u.pn * 128 + wc * 32 + 8 * fq;
#pragma unroll
        for (int ai = 0; ai < 2; ++ai)
#pragma unroll
            for (int mp = 0; mp < 4; mp += 2) {
                unsigned pc[2][2];
#pragma unroll
                for (int mm = 0; mm < 2; ++mm) { const int m = mp + mm; float a[8];
#pragma unroll
                    for (int j = 0; j < 8; ++j) { const float ag = acc[ai][0][m][j >> 2][j & 3], au = acc[ai][1][m][j >> 2][j & 3];
                        const float sg = __builtin_amdgcn_rcpf(1.0f + __builtin_amdgcn_exp2f(ag * (-1.4426950408889634f * isc)));
                        a[j] = (ag * au) * (sg * (8.0f * isc * isc)); }
                    int lo = __builtin_amdgcn_cvt_pk_fp8_f32(a[0], a[1], 0, false); lo = __builtin_amdgcn_cvt_pk_fp8_f32(a[2], a[3], lo, true);
                    int hi = __builtin_amdgcn_cvt_pk_fp8_f32(a[4], a[5], 0, false); hi = __builtin_amdgcn_cvt_pk_fp8_f32(a[6], a[7], hi, true);
                    pc[mm][0] = (unsigned)lo; pc[mm][1] = (unsigned)hi; }
                const auto s0 = __builtin_amdgcn_permlane16_swap(pc[0][0], pc[1][0], false, false);
                const auto s1 = __builtin_amdgcn_permlane16_swap(pc[0][1], pc[1][1], false, false);
                const int odd = fq & 1;
                *(v4u*)(act8 + (row0 + ai * HALF + (mp + odd) * 16) * 256 + col0 - 8 * odd) = (v4u){s0[0], s1[0], s0[1], s1[1]};
                asm volatile("" ::: "memory");
            }
    }
};
struct EpiDown {
    static constexpr bool PERM = true; static constexpr bool PEEL = false; static constexpr bool ONE_ITER = true;
    unsigned char* yk8; unsigned char* ys8; PG8_LAS unsigned char* lds;
    __device__ __forceinline__ void operator()(const f32x4 (&acc)[2][2][4][2], const Unit& u, int wr_, int wc_, int fr_, int fq_) const {
        int t_ = threadIdx.x; asm volatile("" : "+v"(t_));
        const int fr = t_ & 15, fq = (t_ >> 4) & 3, wc = (t_ >> 6) & 3, wr = t_ >> 8;
        const PG8_LAS int* rows = (const PG8_LAS int*)(lds + MOE_ROWS_OFF) + u.slot * 256;
        const PG8_LAS float* wts = (const PG8_LAS float*)(lds + MOE_W_OFF) + u.slot * 256;
        const int col = u.pn * 256 + wc * 32 + 8 * fq;
        unsigned char* base = (u.e < 64) ? yk8 : ys8;
#pragma unroll
        for (int ai = 0; ai < 2; ++ai)
#pragma unroll
            for (int m = 0; m < 4; ++m) {
                const int id = rows[ai * HALF + wr * 64 + m * 16 + fr];
                const float w = wts[ai * HALF + wr * 64 + m * 16 + fr] * (16.0f / 128.0f);
                unsigned pc[2][2];
#pragma unroll
                for (int bj = 0; bj < 2; ++bj) { const f32x4 v0 = acc[ai][bj][m][0] * w, v1 = acc[ai][bj][m][1] * w;
                    int lo = __builtin_amdgcn_cvt_pk_fp8_f32(v0[0], v0[1], 0, false); lo = __builtin_amdgcn_cvt_pk_fp8_f32(v0[2], v0[3], lo, true);
                    int hi = __builtin_amdgcn_cvt_pk_fp8_f32(v1[0], v1[1], 0, false); hi = __builtin_amdgcn_cvt_pk_fp8_f32(v1[2], v1[3], hi, true);
                    pc[bj][0] = (unsigned)lo; pc[bj][1] = (unsigned)hi; }
                const auto s0 = __builtin_amdgcn_permlane16_swap(pc[0][0], pc[1][0], false, false);
                const auto s1 = __builtin_amdgcn_permlane16_swap(pc[0][1], pc[1][1], false, false);
                if (id >= 0) {
                    unsigned char* dst = base + ((unsigned)id * 1024u + (unsigned)col) + ((fq & 1) ? (HALF - 8) : 0);
                    *(v4u*)dst = (v4u){s0[0], s1[0], s0[1], s1[1]};
                }
            }
    }
};
}

struct Params {
    const float* in[34];
    float* out;
    unsigned char* ws;
    int ph_lo, ph_hi, li, flags;
};

__device__ __forceinline__ void transpose_item(const float* W, int ldw, bf16* WT, int ldt, LAS float* scr, int lane) {
#pragma unroll 8
    for (int i = 0; i < 32; ++i) { const int kk = 2 * i + (lane >> 5); scr[kk * 33 + (lane & 31)] = __builtin_nontemporal_load(W + (size_t)kk * ldw + (lane & 31)); }
    LDS_WAIT(); asm volatile("" ::: "memory");
    const int c = lane & 7;
#pragma unroll
    for (int j = 0; j < 4; ++j) { const int n = (lane >> 3) + 8 * j; const LAS float* s = scr + (8 * c) * 33 + n;
        v4u o; o.x = pk2(s[0 * 33], s[1 * 33]); o.y = pk2(s[2 * 33], s[3 * 33]); o.z = pk2(s[4 * 33], s[5 * 33]); o.w = pk2(s[6 * 33], s[7 * 33]);
        *(GAS v4u*)(WT + (size_t)n * ldt + 8 * c) = o; }
    LDS_WAIT(); asm volatile("" ::: "memory");
}

__device__ __forceinline__ void transpose_item_glu(const float* W, int k0, int n0, bf16* WF, LAS float* scr, int lane) {
#pragma unroll 8
    for (int i = 0; i < 32; ++i) { const int kk = 2 * i + (lane >> 5); scr[kk * 33 + (lane & 31)] = W[(size_t)(k0 + kk) * CC + n0 + (lane & 31)]; }
    LDS_WAIT(); asm volatile("" ::: "memory");
    const int c = lane & 7;
#pragma unroll
    for (int j = 0; j < 4; ++j) { const int nl = (lane >> 3) + 8 * j; const LAS float* s = scr + (8 * c) * 33 + nl;
        v4u o; o.x = pk2(s[0 * 33], s[1 * 33]); o.y = pk2(s[2 * 33], s[3 * 33]); o.z = pk2(s[4 * 33], s[5 * 33]); o.w = pk2(s[6 * 33], s[7 * 33]);
        const int n = n0 + nl, k = k0 + 8 * c;
        const int blk = (((n >> 6) * 16 + (k >> 5)) * 4 + ((n >> 4) & 3)), ln = ((k >> 3) & 3) * 16 + (n & 15);
        *(GAS v4u*)(WF + (size_t)blk * 512 + ln * 8) = o; }
    LDS_WAIT(); asm volatile("" ::: "memory");
}

__device__ __forceinline__ void transpose_item_rt(const float* W, int k0, int n0, bf16* WF, LAS float* scr, int lane) {
#pragma unroll 8
    for (int i = 0; i < 32; ++i) { const int kk = 2 * i + (lane >> 5); scr[kk * 33 + (lane & 31)] = W[(size_t)(k0 + kk) * NE + n0 + (lane & 31)]; }
    LDS_WAIT(); asm volatile("" ::: "memory");
    const int c = lane & 7;
#pragma unroll
    for (int j = 0; j < 4; ++j) { const int nl = (lane >> 3) + 8 * j; const LAS float* s = scr + (8 * c) * 33 + nl;
        v4u o; o.x = pk2(s[0 * 33], s[1 * 33]); o.y = pk2(s[2 * 33], s[3 * 33]); o.z = pk2(s[4 * 33], s[5 * 33]); o.w = pk2(s[6 * 33], s[7 * 33]);
        const int n = n0 + nl, k = k0 + 8 * c;
        const int blk = (n >> 4) * 32 + (k >> 5), ln = ((k >> 3) & 3) * 16 + (n & 15);
        *(GAS v4u*)(WF + (size_t)blk * 512 + ln * 8) = o; }
    LDS_WAIT(); asm volatile("" ::: "memory");
}

__device__ __forceinline__ void transpose_item8(const float* W, int ldw, unsigned char* WT8, int ldt, float sc, LAS float* scr, int lane) {
#pragma unroll 8
    for (int i = 0; i < 16; ++i) { const int kk = 8 * i + (lane >> 3);
        *(LAS f32x4*)(scr + kk * 32 + 4 * (lane & 7)) = __builtin_nontemporal_load((const f32x4*)(W + (size_t)kk * ldw + 4 * (lane & 7))); }
    LDS_WAIT(); asm volatile("" ::: "memory");
    const int n = lane & 31, h = lane >> 5;
    const LAS float* s = scr + (64 * h) * 32 + n;
    v4u pk[4];
#pragma unroll
    for (int q = 0; q < 4; ++q) {
        unsigned w[4];
#pragma unroll
        for (int d = 0; d < 4; ++d) { const int k = 16 * q + 4 * d;
            int v = __builtin_amdgcn_cvt_pk_fp8_f32(s[k * 32] * sc, s[(k + 1) * 32] * sc, 0, false);
            v = __builtin_amdgcn_cvt_pk_fp8_f32(s[(k + 2) * 32] * sc, s[(k + 3) * 32] * sc, v, true); w[d] = (unsigned)v; }
        pk[q] = (v4u){w[0], w[1], w[2], w[3]};
    }
    LDS_WAIT(); asm volatile("" ::: "memory");
    LAS unsigned char* st = (LAS unsigned char*)scr;
#pragma unroll
    for (int q = 0; q < 4; ++q) *(LAS v4u*)(st + n * 144 + 64 * h + 16 * q) = pk[q];
    LDS_WAIT(); asm volatile("" ::: "memory");
    const int c = lane & 7;
#pragma unroll
    for (int ps = 0; ps < 4; ++ps) { const int r = (lane >> 3) + 8 * ps;
        *(GAS v4u*)(WT8 + (size_t)r * ldt + 16 * c) = *(const LAS v4u*)(st + r * 144 + 16 * c); }
    LDS_WAIT(); asm volatile("" ::: "memory");
}
constexpr int IT_EG = 64 * 64, IT_EU = 64 * 64, IT_ED = 64 * 64, IT_SG = 64, IT_SU = 64, IT_SD = 64, IT_IN = 16 * 48, IT_OUT = 16 * 32, IT_GLU = 8 * 16, IT_RT = 16 * 2;
constexpr int NITEMS_DEF = 3680;
constexpr int NITEMS_DEF2 = 1024;
constexpr int NITEMS_T = IT_EG + IT_EU + IT_ED + IT_SG + IT_SU + IT_SD + IT_IN + IT_OUT + IT_GLU + IT_RT;

__device__ __forceinline__ void p0_convert_item(const Params& p, int it, LAS float* scr, int lane) {
    unsigned char* ws = p.ws;
    bf16* Wgu = (bf16*)(ws + WS_WGU_T); bf16* Wd = (bf16*)(ws + WS_WD_T);
    int r = it;
    if (r < IT_EG + IT_EU) {
        const int up = r >= IT_EG; if (up) r -= IT_EG;
        const int e = r >> 6, q = r & 63, kb = q >> 3, nb = q & 7, k0 = 128 * kb, n0 = 32 * nb;
        const float* src = (up ? p.in[29] : p.in[28]) + (size_t)e * D * DE + (size_t)k0 * DE + n0;
        const int drow = 256 * (n0 >> 7) + (n0 & 127) + (up ? 128 : 0);
        transpose_item8(src, DE, (unsigned char*)Wgu + (size_t)e * 512 * D + (size_t)drow * D + k0, D, 32.0f, scr, lane); return; }
    r -= IT_EG + IT_EU;
    if (r < IT_ED) {
        const int e = r >> 6, q = r & 63, kb = q >> 5, nb = q & 31, k0 = 128 * kb, n0 = 32 * nb;
        transpose_item8(p.in[30] + (size_t)e * DE * D + (size_t)k0 * D + n0, D, (unsigned char*)Wd + (size_t)e * D * DE + (size_t)n0 * DE + k0, DE, 16.0f, scr, lane); return; }
    r -= IT_ED;
    if (r < IT_SG + IT_SU) {
        const int up = r >= IT_SG; if (up) r -= IT_SG;
        const int kb = r >> 3, nb = r & 7, k0 = 128 * kb, n0 = 32 * nb;
        const float* src = (up ? p.in[32] : p.in[31]) + (size_t)k0 * DE + n0;
        const int drow = 256 * (n0 >> 7) + (n0 & 127) + (up ? 128 : 0);
        transpose_item8(src, DE, (unsigned char*)Wgu + (size_t)64 * 512 * D + (size_t)drow * D + k0, D, 32.0f, scr, lane); return; }
    r -= IT_SG + IT_SU;
    if (r < IT_SD) { const int kb = r >> 5, nb = r & 31, k0 = 128 * kb, n0 = 32 * nb;
        transpose_item8(p.in[33] + (size_t)k0 * D + n0, D, (unsigned char*)Wd + (size_t)64 * D * DE + (size_t)n0 * DE + k0, DE, 16.0f, scr, lane); return; }
    r -= IT_SD;
    if (r < IT_IN) { const int kb = r / 48, nb = r % 48, k0 = 64 * kb, n0 = 32 * nb;
        int drow; if (n0 < 512) drow = 256 * (n0 >> 7) + (n0 & 127); else if (n0 < 1024) { const int c = n0 - 512; drow = 256 * (c >> 7) + 128 + (c & 127); } else drow = n0;
        transpose_item(p.in[6] + (size_t)k0 * DIN + n0, DIN, (bf16*)(ws + WS_W_IN_T) + (size_t)drow * D + k0, D, scr, lane); return; }
    r -= IT_IN;
    if (r < IT_OUT) { const int kb = r >> 5, nb = r & 31, k0 = 64 * kb, n0 = 32 * nb;
        transpose_item(p.in[23] + (size_t)k0 * D + n0, D, (bf16*)(ws + WS_W_OUT_T) + (size_t)n0 * D + k0, D, scr, lane); return; }
    r -= IT_OUT;
    if (r < IT_GLU) { const int kb = r >> 4, nb = r & 15, k0 = 64 * kb, n0 = 32 * nb;
        transpose_item_glu(p.in[19], k0, n0, (bf16*)(ws + WS_W_GLU_T), scr, lane); return; }
    r -= IT_GLU;
    { const int kb = r >> 1, nb = r & 1, k0 = 64 * kb, n0 = 32 * nb;
      transpose_item_rt(p.in[26], k0, n0, (bf16*)(ws + WS_W_RT_T), scr, lane); }
}

__device__ __forceinline__ void p0_mod_item(const Params& p, int item, LAS float* red, int tid) {
    const int cg = tid & 7, kr = tid >> 3, j0 = item * 32 + cg * 4;
    const float* c = p.in[1]; const float* w = p.in[2];
    f32x4 a0 = {0.f, 0.f, 0.f, 0.f}, a1 = {0.f, 0.f, 0.f, 0.f};
    f32x4 w4[16]; float c0[16], c1[16];
#pragma unroll
    for (int ps = 0; ps < 16; ++ps) { const int k = ps * 64 + kr; w4[ps] = *(const f32x4*)(w + (size_t)k * 6 * D + j0); c0[ps] = c[k]; c1[ps] = c[D + k]; }
#pragma unroll
    for (int ps = 0; ps < 16; ++ps) { const float s0 = siluf_(c0[ps]), s1 = siluf_(c1[ps]); a0 += w4[ps] * s0; a1 += w4[ps] * s1; }
    LAS float* my = red + (kr * 8 + cg) * 8;
    my[0] = a0[0]; my[1] = a0[1]; my[2] = a0[2]; my[3] = a0[3]; my[4] = a1[0]; my[5] = a1[1]; my[6] = a1[2]; my[7] = a1[3];
    __syncthreads();
    if (tid < 64) { const int g = tid >> 3, q = tid & 7; float s = 0.f;
        for (int k2 = 0; k2 < 64; ++k2) s += red[(k2 * 8 + g) * 8 + q];
        const int b = q >> 2, j = item * 32 + g * 4 + (q & 3);
        ((float*)(p.ws + WS_MOD))[b * 6 * D + j] = s + p.in[3][j]; }
    __syncthreads();
}

__device__ __forceinline__ void p1_rows(const Params& p, int gw0, int NGW, int lane) {
    if (gw0 >= T) return;
    f32x4 vn[4];
    { const GAS f32x4* xr = (const GAS f32x4*)(p.in[0] + (size_t)gw0 * D) + lane;
#pragma unroll
      for (int j = 0; j < 4; ++j) vn[j] = __builtin_nontemporal_load(xr + 64 * j); }
    f32x4 g[4];
#pragma unroll
    for (int j = 0; j < 4; ++j) g[j] = *(const f32x4*)(p.in[4] + 4 * lane + 256 * j);
    for (int m = gw0; m < T; m += NGW) {
        f32x4 v[4]; float s = 0.f;
#pragma unroll
        for (int j = 0; j < 4; ++j) { v[j] = vn[j]; s += (v[j].x * v[j].x + v[j].y * v[j].y) + (v[j].z * v[j].z + v[j].w * v[j].w); }
        if (m + NGW < T) { const GAS f32x4* xr = (const GAS f32x4*)(p.in[0] + (size_t)(m + NGW) * D) + lane;
#pragma unroll
            for (int j = 0; j < 4; ++j) vn[j] = __builtin_nontemporal_load(xr + 64 * j); }
        const int b = m / SEQL;
        const float* mod = (const float*)(p.ws + WS_MOD) + b * 6 * D;
        const float rstd = rsqrtf(wave_sum(s) * (1.f / D) + EPS);
        GAS unsigned long long* o8 = (GAS unsigned long long*)((bf16*)(p.ws + WS_ABUF) + (size_t)m * D) + lane;
#pragma unroll
        for (int j = 0; j < 4; ++j) { const int n = 4 * lane + 256 * j;
            const f32x4 sc = *(const f32x4*)(mod + D + n), sh = *(const f32x4*)(mod + n);
            const f32x4 o = v[j] * rstd * g[j] * (sc + 1.0f) + sh;
            o8[64 * j] = (unsigned long long)pk2(o.x, o.y) | ((unsigned long long)pk2(o.z, o.w) << 32); }
    }
}

typedef float f32x16 __attribute__((ext_vector_type(16)));
__device__ __forceinline__ void p0_ssm_tables_gp(const Params& p, int q  ) {
    const int g = q >> 6;
    const double ar = p.in[11][q], ai = p.in[12][q], dt = exp((double)p.in[13][g]);
    const double mag = exp(ar * dt), lr = mag * cos(ai * dt), li = mag * sin(ai * dt);
    const double den = ar * ar + ai * ai, nr = lr - 1.0;
    const double kr = (nr * ar + li * ai) / den, ki = (li * ar - nr * ai) / den;
    ((f32x2*)(p.ws + WS_LAM))[q] = (f32x2){(float)lr, (float)li};
    double pr = lr, pi = li;
#pragma unroll
    for (int s = 0; s < 5; ++s) { const double nr2 = pr * pr - pi * pi, ni2 = 2.0 * pr * pi; pr = nr2; pi = ni2; }
    ((f32x2*)(p.ws + WS_LAM32))[q] = (f32x2){(float)pr, (float)pi};
    bf16* Bb = (bf16*)(p.ws + WS_BB);
    const int pp = q & 63;
    for (int h = 0; h < 16; ++h) { const double br = p.in[14][q * 16 + h], bi = p.in[15][q * 16 + h];
        Bb[((g * 2 + 0) * 64 + pp) * 16 + h] = (bf16)f2bf((float)(kr * br - ki * bi));
        Bb[((g * 2 + 1) * 64 + pp) * 16 + h] = (bf16)f2bf((float)(kr * bi + ki * br)); }
}
__device__ __forceinline__ void p0_ssm_tables_ct(const Params& p, int idx  ) {
    const int k = idx & 127, gh = idx >> 7;
    const float v = (k & 1) ? -p.in[17][gh * 64 + (k >> 1)] : p.in[16][gh * 64 + (k >> 1)];
    ((bf16*)(p.ws + WS_CT))[idx] = (bf16)f2bf(v);
}

__device__ __forceinline__ bf16x8 ssm_load_u(const bf16* ssmu, int tokA, int tokB, int g, int lane) {
    const int i = lane & 31, kh = lane >> 5;
    const int hf = (i >> 2) & 1, r = (i & 3) + 4 * (i >> 3);
    const int tok = (hf ? tokB : tokA) + r;
    return *(const bf16x8*)(ssmu + ((size_t)g * T + tok) * 16 + 8 * kh);
}
#define KEEP_V(x) asm volatile("" :: "v"(x))
#define MFMA_SETTLE1(x) asm volatile("s_nop 15\n\ts_nop 7" : "+v"(x))
#define MFMA_SETTLE_ALL() do { __builtin_amdgcn_sched_barrier(0); asm volatile("s_nop 15\n\ts_nop 15\n\ts_nop 15\n\ts_nop 15"); __builtin_amdgcn_sched_barrier(0); } while (0)
#define MFMA_SETTLE2(x, y) asm volatile("s_nop 15\n\ts_nop 7" : "+v"(x), "+v"(y))
__device__ __forceinline__ f32x16 mfma32(bf16x8 a, bf16x8 b, f32x16 c) { return __builtin_amdgcn_mfma_f32_32x32x16_bf16(a, b, c, 0, 0, 0); }
struct SsmGroup { bf16x8 bb[2][2]; f32x2 lam[2]; };
__device__ __forceinline__ void ssm_group_load(const unsigned char* ws, int g, int lane, SsmGroup& G) {
    const bf16* Bb = (const bf16*)(ws + WS_BB);
#pragma unroll
    for (int ri = 0; ri < 2; ++ri)
#pragma unroll
        for (int pb = 0; pb < 2; ++pb) G.bb[ri][pb] = *(const bf16x8*)(Bb + ((g * 2 + ri) * 64 + pb * 32 + (lane & 31)) * 16 + 8 * (lane >> 5));
#pragma unroll
    for (int pb = 0; pb < 2; ++pb) G.lam[pb] = ((const f32x2*)(ws + WS_LAM))[g * 64 + pb * 32 + (lane & 31)];
}

__device__ __forceinline__ void p3a_items(const Params& p, int gw0, int NGW, int lane) {
    const int g = gw0 & 31;
    const bf16* vu = (const bf16*)(p.ws + WS_SSMU);
    SsmGroup G; ssm_group_load(p.ws, g, lane, G);
    const f32x16 z16 = {0.f, 0.f, 0.f, 0.f, 0.f, 0.f, 0.f, 0.f, 0.f, 0.f, 0.f, 0.f, 0.f, 0.f, 0.f, 0.f};
    f32x2* E = (f32x2*)(p.ws + WS_E);
    bf16x8 an[2];
    { const int i0 = gw0 >> 5; an[0] = ssm_load_u(vu, 64 * i0, 64 * i0 + 32, g, lane); an[1] = ssm_load_u(vu, 64 * i0 + 16, 64 * i0 + 48, g, lane); }
    for (int item = gw0; item < 256 * 32; item += NGW) {
        const int i = item >> 5;
        bf16x8 a[2] = {an[0], an[1]};
        if (item + NGW < 256 * 32) { const int i1 = (item + NGW) >> 5; an[0] = ssm_load_u(vu, 64 * i1, 64 * i1 + 32, g, lane); an[1] = ssm_load_u(vu, 64 * i1 + 16, 64 * i1 + 48, g, lane); }
        float sr[2] = {0.f, 0.f}, si[2] = {0.f, 0.f};
#pragma unroll
        for (int blk = 0; blk < 2; ++blk) {
#pragma unroll
            for (int pb = 0; pb < 2; ++pb) {
                f32x16 bur = mfma32(a[blk], G.bb[0][pb], z16);
                f32x16 bui = mfma32(a[blk], G.bb[1][pb], z16);
                MFMA_SETTLE2(bur, bui);
                const float lr = G.lam[pb].x, li = G.lam[pb].y;
#pragma unroll
                for (int r = 0; r < 16; ++r) { float nsr = fmaf(lr, sr[pb], fmaf(-li, si[pb], bur[r])), nsi = fmaf(lr, si[pb], fmaf(li, sr[pb], bui[r])); asm volatile("" : "+v"(nsr)); asm volatile("" : "+v"(nsi)); sr[pb] = nsr; si[pb] = nsi; }
            }
        }
        const int sc = 2 * i + (lane >> 5);
#pragma unroll
        for (int pb = 0; pb < 2; ++pb) E[(size_t)sc * 2048 + g * 64 + pb * 32 + (lane & 31)] = (f32x2){sr[pb], si[pb]};
        asm volatile("" :: "v"(a[0]), "v"(a[1]) : "memory");
    }
    asm volatile("" :: "v"(G.bb[0][0]), "v"(G.bb[0][1]), "v"(G.bb[1][0]), "v"(G.bb[1][1]) : "memory");
}

__device__ __forceinline__ float wave_reduce_scatter16(const float (&v)[16], int lane) {
    float a[8], b[4], c[2], d;
    const bool s5 = (lane & 32) != 0, s4 = (lane & 16) != 0, s3 = (lane & 8) != 0, s2 = (lane & 4) != 0;
#pragma unroll
    for (int i = 0; i < 8; ++i) { const float mine = s5 ? v[8 + i] : v[i], theirs = s5 ? v[i] : v[8 + i]; a[i] = mine + __shfl_xor(theirs, 32); }
#pragma unroll
    for (int i = 0; i < 4; ++i) { const float mine = s4 ? a[4 + i] : a[i], theirs = s4 ? a[i] : a[4 + i]; b[i] = mine + __shfl_xor(theirs, 16); }
#pragma unroll
    for (int i = 0; i < 2; ++i) { const float mine = s3 ? b[2 + i] : b[i], theirs = s3 ? b[i] : b[2 + i]; c[i] = mine + __shfl_xor(theirs, 8); }
    { const float mine = s2 ? c[1] : c[0], theirs = s2 ? c[0] : c[1]; d = mine + __shfl_xor(theirs, 4); }
    d += __shfl_xor(d, 2); d += __shfl_xor(d, 1);
    return d;
}
__device__ __forceinline__ int rs16_token(int lane) { return ((lane >> 5) & 1) * 8 + ((lane >> 4) & 1) * 4 + ((lane >> 3) & 1) * 2 + ((lane >> 2) & 1); }

constexpr int CONV_ROWS = 62, CONV_RED_OFF = CONV_ROWS * 1024, CONV_STAT_OFF = CONV_RED_OFF + 1024, CONV_PART_OFF = CONV_STAT_OFF + 256;
struct ConvStage { v4u v[8]; };
__device__ __forceinline__ void conv_stage_load(const Params& p, int tile, int tid, ConvStage& S) {
    const int lane = tid & 63, wv = __builtin_amdgcn_readfirstlane(tid >> 6);
    const int t0 = tile * 32, tl0 = t0 % SEQL;
    const bf16* vu = (const bf16*)(p.ws + WS_BBUF);
#pragma unroll
    for (int i = 0; i < 8; ++i) { const int r = wv + NWAVES * i, rc = r < CONV_ROWS ? r : CONV_ROWS - 1; int tr = t0 + rc - 30; const bool ok = (tl0 + rc - 30 >= 0); if (!ok) tr = t0;
        const v4u v = *(const v4u*)(vu + (size_t)tr * D + lane * 8); S.v[i] = ok ? v : (v4u){0u, 0u, 0u, 0u}; }
}
__device__ __forceinline__ void p3_conv_tile(const Params& p, int tile, LAS unsigned char* lds, int tid, ConvStage& S, int next_tile) {
    const int lane = tid & 63, wave = tid >> 6, cp = tid & 255, th = tid >> 8;
    const int t0 = tile * 32;
    LAS unsigned char* vt = lds;
    LAS float* red = (LAS float*)(lds + CONV_RED_OFF);
    LAS float* stat = (LAS float*)(lds + CONV_STAT_OFF);
    { const int wv = __builtin_amdgcn_readfirstlane(wave);
#pragma unroll
      for (int i = 0; i < 8; ++i) { const int r = wv + NWAVES * i; if (r < CONV_ROWS) *(LAS v4u*)(vt + r * 1024 + lane * 16) = S.v[i]; } }
    if (next_tile >= 0) conv_stage_load(p, next_tile, tid, S);
    f32x2 w[31];
#pragma unroll
    for (int j = 0; j < 31; ++j) w[j] = *(const f32x2*)(p.in[7] + j * CC + 2 * cp);
    const f32x2 bias = *(const f32x2*)(p.in[8] + 2 * cp);
    __syncthreads();
    f32x2 acc[16];
#pragma unroll
    for (int o = 0; o < 16; ++o) acc[o] = bias;
#pragma unroll
    for (int s = 0; s < 46; ++s) {
        const unsigned pr = *(const LAS unsigned*)(vt + (16 * th + s) * 1024 + cp * 4);
        const f32x2 v = {bflo(pr), bfhi(pr)};
#pragma unroll
        for (int o = 0; o < 16; ++o) { const int j = s - o; if (j >= 0 && j <= 30) acc[o] += v * w[j]; }
    }
    LAS f32x2* part = (LAS f32x2*)(lds + CONV_PART_OFF);
#pragma unroll
    for (int o = 0; o < 16; ++o) part[(16 * th + o) * 257 + cp] = (f32x2){acc[o].x + acc[o].y, acc[o].x * acc[o].x + acc[o].y * acc[o].y};
    __syncthreads();
    { const int tk = tid >> 4, sub = tid & 15; float s = 0.f, q = 0.f;
#pragma unroll
      for (int i = 0; i < 16; ++i) { const f32x2 v = part[tk * 257 + sub + 16 * i]; s += v.x; q += v.y; }
#pragma unroll
      for (int o = 1; o < 16; o <<= 1) { s += __shfl_xor(s, o); q += __shfl_xor(q, o); }
      if (sub == 0) { const float mu = s * (1.f / CC), var = q * (1.f / CC) - mu * mu; stat[tk * 2] = mu; stat[tk * 2 + 1] = rsqrtf(var + EPS); } }
    __syncthreads();
    const f32x2 lg = *(const f32x2*)(p.in[9] + 2 * cp), lb = *(const f32x2*)(p.in[10] + 2 * cp);
#pragma unroll
    for (int o = 0; o < 16; ++o) { const float mu = stat[(16 * th + o) * 2], rs = stat[(16 * th + o) * 2 + 1];
        f32x2 y = (acc[o] - mu) * rs * lg + lb; y.x = siluf_(y.x); y.y = siluf_(y.y); acc[o] = y;
        part[(16 * th + o) * 257 + cp].x = y.x * y.x + y.y * y.y; }
    __syncthreads();
    { const int tk = tid >> 4, sub = tid & 15; float q = 0.f;
#pragma unroll
      for (int i = 0; i < 16; ++i) q += part[tk * 257 + sub + 16 * i].x;
#pragma unroll
      for (int o = 1; o < 16; o <<= 1) q += __shfl_xor(q, o);
      if (sub == 0) stat[tk * 2] = rsqrtf(q * (1.f / CC) + EPS); }
    __syncthreads();
    const f32x2 go = *(const f32x2*)(p.in[21] + 2 * cp);
    bf16* mixed = (bf16*)(p.ws + WS_ABUF);
#pragma unroll
    for (int o = 0; o < 16; ++o) { const float rs = stat[(16 * th + o) * 2]; const f32x2 y = acc[o] * rs * go;
        *(unsigned*)(mixed + (size_t)(t0 + 16 * th + o) * D + 2 * cp) = pk2(y.x, y.y); }
    __syncthreads();
}

__device__ __forceinline__ void p3b_block(const Params& p, int blk, LAS unsigned char* lds, int tid) {
    const int sl = tid & 15, seg = tid >> 4;
    const int idx = blk * 16 + sl, b = idx >> 11, q = idx & 2047;
    const f32x2 L = ((const f32x2*)(p.ws + WS_LAM32))[q];
    const f32x2* E = (const f32x2*)(p.ws + WS_E) + (size_t)b * 256 * 2048 + q + (size_t)(8 * seg) * 2048;
    f32x2* S = (f32x2*)(p.ws + WS_SINIT) + (size_t)b * 256 * 2048 + q + (size_t)(8 * seg) * 2048;
    f32x2 e[8];
#pragma unroll
    for (int j = 0; j < 8; ++j) e[j] = E[(size_t)j * 2048];
    float pr = L.x, pi = L.y;
#pragma unroll
    for (int s = 0; s < 3; ++s) { const float nr = pr * pr - pi * pi, ni = 2.0f * pr * pi; pr = nr; pi = ni; }
    float xr = 0.f, xi = 0.f;
#pragma unroll
    for (int j = 0; j < 8; ++j) { float nr = fmaf(L.x, xr, fmaf(-L.y, xi, e[j].x)), ni = fmaf(L.x, xi, fmaf(L.y, xr, e[j].y)); asm volatile("" : "+v"(nr)); asm volatile("" : "+v"(ni)); xr = nr; xi = ni; }
    LAS f32x2* xs = (LAS f32x2*)lds;
    xs[sl * 33 + seg] = (f32x2){xr, xi};
    __syncthreads();
    if (tid < 16) {
        f32x2 x[32];
#pragma unroll
        for (int k = 0; k < 32; ++k) x[k] = xs[tid * 33 + k];
        float cr = 0.f, ci = 0.f;
#pragma unroll
        for (int k = 0; k < 32; ++k) { xs[tid * 33 + k] = (f32x2){cr, ci};
            float nr = fmaf(pr, cr, fmaf(-pi, ci, x[k].x)), ni = fmaf(pr, ci, fmaf(pi, cr, x[k].y)); asm volatile("" : "+v"(nr)); asm volatile("" : "+v"(ni)); cr = nr; ci = ni; }
    }
    __syncthreads();
    const f32x2 in = xs[sl * 33 + seg];
    float sr = in.x, si = in.y;
#pragma unroll
    for (int j = 0; j < 8; ++j) { S[(size_t)j * 2048] = (f32x2){sr, si};
        float nr = fmaf(L.x, sr, fmaf(-L.y, si, e[j].x)), ni = fmaf(L.x, si, fmaf(L.y, sr, e[j].y)); asm volatile("" : "+v"(nr)); asm volatile("" : "+v"(ni)); sr = nr; si = ni; }
    __syncthreads();
}

constexpr int P3C_STILE = 32 * 272, P3C_G_OFF = 8 * P3C_STILE, P3C_G_STRIDE = 1040, P3C_RED_OFF = P3C_G_OFF + 64 * P3C_G_STRIDE;
__device__ __forceinline__ void p3c_chunk(const Params& p, int chunk, LAS unsigned char* lds, int tid) {
    const int lane = tid & 63, wave = __builtin_amdgcn_readfirstlane(tid >> 6);
    const int t0 = chunk * 64;
    const bf16* vu = (const bf16*)(p.ws + WS_SSMU);
    LAS unsigned char* st = lds + wave * P3C_STILE;
    LAS unsigned char* gt = lds + P3C_G_OFF;
    const int hf = lane >> 5, j = lane & 31;
    const f32x16 z16 = {0.f, 0.f, 0.f, 0.f, 0.f, 0.f, 0.f, 0.f, 0.f, 0.f, 0.f, 0.f, 0.f, 0.f, 0.f, 0.f};
    const bf16* Ct = (const bf16*)(p.ws + WS_CT);
    for (int gi = 0; gi < ((p.flags & 2) ? 0 : 4); ++gi) {
        const int g = wave * 4 + gi;
        SsmGroup G; ssm_group_load(p.ws, g, lane, G);
        float sr[2], si[2];
        { const f32x2* S0 = (const f32x2*)(p.ws + WS_SINIT) + (size_t)(2 * chunk + hf) * 2048 + g * 64 + j;
          const f32x2 s0 = S0[0], s1 = S0[32]; sr[0] = s0.x; si[0] = s0.y; sr[1] = s1.x; si[1] = s1.y; }
        bf16x8 cb[8];
#pragma unroll
        for (int ks = 0; ks < 8; ++ks) { bf16x8 v = {0, 0, 0, 0, 0, 0, 0, 0}; if (j < 16) v = *(const bf16x8*)(Ct + (size_t)(g * 16 + j) * 128 + ks * 16 + 8 * hf); cb[ks] = v; }
        bf16x8 db = {0, 0, 0, 0, 0, 0, 0, 0};
        if (j < 16 && (j >> 3) == hf) { const unsigned short dv = (unsigned short)f2bf(p.in[18][g * 16 + j]);
#pragma unroll
            for (int e = 0; e < 8; ++e) if ((j & 7) == e) db[e] = (short)dv; }
#pragma unroll
        for (int blk = 0; blk < 2; ++blk) {
            const bf16x8 a = ssm_load_u(vu, t0 + 16 * blk, t0 + 32 + 16 * blk, g, lane);
            f32x16 bur[2], bui[2];
#pragma unroll
            for (int pb = 0; pb < 2; ++pb) {
                bur[pb] = mfma32(a, G.bb[0][pb], z16);
                bui[pb] = mfma32(a, G.bb[1][pb], z16);
                MFMA_SETTLE2(bur[pb], bui[pb]);
            }
#pragma unroll
            for (int pb = 0; pb < 2; ++pb) {
                const float lr = G.lam[pb].x, li = G.lam[pb].y;
#pragma unroll
                for (int r = 0; r < 16; ++r) {
                    float nsr = fmaf(lr, sr[pb], fmaf(-li, si[pb], bur[pb][r])), nsi = fmaf(lr, si[pb], fmaf(li, sr[pb], bui[pb][r])); asm volatile("" : "+v"(nsr)); asm volatile("" : "+v"(nsi)); sr[pb] = nsr; si[pb] = nsi;
                    const int row = (r & 3) + 8 * (r >> 2) + 4 * hf;
                    const unsigned wri = pk2(nsr, nsi);
                    *(LAS unsigned*)(st + row * 272 + (pb * 32 + j) * 4) = wri;
                }
            }
            LDS_WAIT(); asm volatile("" ::: "memory");
            f32x16 y = mfma32(a, db, z16);
#pragma unroll
            for (int ks = 0; ks < 8; ++ks) { const bf16x8 sa = *(const LAS bf16x8*)(st + j * 272 + (ks * 16 + 8 * hf) * 2); y = mfma32(sa, cb[ks], y); KEEP_V(sa); }
            MFMA_SETTLE1(y);
            LDS_WAIT(); asm volatile("" ::: "memory");
#pragma unroll
            for (int r = 0; r < 16; ++r) { float yr = y[r]; asm volatile("" : "+v"(yr)); y[r] = yr; }
            KEEP_V(a);
            { float z[8];
#pragma unroll
              for (int r = 0; r < 8; ++r) { const float ya = y[r], yb = y[r + 8]; const unsigned ua = __float_as_uint(ya), ub = __float_as_uint(yb);
                  const auto sw = __builtin_amdgcn_permlane16_swap(ua, ub, false, false); z[r] = __uint_as_float(sw[0]); }
              const int ch = lane & 15, up = (lane >> 4) & 1;
#pragma unroll
              for (int r = 0; r < 8; r += 2) { const int tokl = 32 * hf + 16 * blk + r + 8 * up; const unsigned w2 = pk2(gelu_tanh(z[r]), gelu_tanh(z[r + 1]));
                  *(LAS unsigned short*)(gt + tokl * P3C_G_STRIDE + (g * 16 + ch) * 2) = (unsigned short)w2;
                  *(LAS unsigned short*)(gt + (tokl + 1) * P3C_G_STRIDE + (g * 16 + ch) * 2) = (unsigned short)(w2 >> 16); } }
            LDS_WAIT(); asm volatile("" ::: "memory");
        }
        KEEP_V(db); KEEP_V(G.bb[0][0]); KEEP_V(G.bb[0][1]); KEEP_V(G.bb[1][0]); KEEP_V(G.bb[1][1]);
#pragma unroll
        for (int ks = 0; ks < 8; ++ks) KEEP_V(cb[ks]);
    }
    __syncthreads();
    if (p.flags & 4) return;
    const int fr = lane & 15, fq = lane >> 4;
    f32x4 acc[4][4];
#pragma unroll
    for (int mf = 0; mf < 4; ++mf)
#pragma unroll
        for (int nf = 0; nf < 4; ++nf) acc[mf][nf] = (f32x4){0.f, 0.f, 0.f, 0.f};
    const bf16* Wg = (const bf16*)(p.ws + WS_W_GLU_T);
#pragma unroll 4
    for (int ks = 0; ks < 16; ++ks) {
        bf16x8 af[4], bfr[4];
#pragma unroll
        for (int nf = 0; nf < 4; ++nf) bfr[nf] = *(const bf16x8*)(Wg + (size_t)((wave * 16 + ks) * 4 + nf) * 512 + lane * 8);
#pragma unroll
        for (int mf = 0; mf < 4; ++mf) af[mf] = *(const LAS bf16x8*)(gt + (16 * mf + fr) * P3C_G_STRIDE + (32 * ks + 8 * fq) * 2);
#pragma unroll
        for (int mf = 0; mf < 4; ++mf)
#pragma unroll
            for (int nf = 0; nf < 4; ++nf) acc[mf][nf] = __builtin_amdgcn_mfma_f32_16x16x32_bf16(bfr[nf], af[mf], acc[mf][nf], 0, 0, 0);
    }
    MFMA_SETTLE_ALL();
    float ssq[4] = {0.f, 0.f, 0.f, 0.f};
#pragma unroll
    for (int nf = 0; nf < 4; ++nf) { const int n0 = 64 * wave + 16 * nf + 4 * fq; const f32x4 bg = *(const f32x4*)(p.in[20] + n0);
#pragma unroll
        for (int mf = 0; mf < 4; ++mf) { const v2u gw = *(const LAS v2u*)(gt + (16 * mf + fr) * P3C_G_STRIDE + n0 * 2);
            const f32x4 gv = {bflo(gw.x), bfhi(gw.x), bflo(gw.y), bfhi(gw.y)}; f32x4 o;
#pragma unroll
            for (int e = 0; e < 4; ++e) { o[e] = gv[e] * sigmoidf_(acc[mf][nf][e] + bg[e]); ssq[mf] += o[e] * o[e]; }
            acc[mf][nf] = o; } }
    LAS float* red = (LAS float*)(lds + P3C_RED_OFF);
#pragma unroll
    for (int mf = 0; mf < 4; ++mf) { float s = ssq[mf]; s += __shfl_xor(s, 16); s += __shfl_xor(s, 32); if (fq == 0) red[wave * 64 + 16 * mf + fr] = s; }
    __syncthreads();
    float rs[4];
#pragma unroll
    for (int mf = 0; mf < 4; ++mf) { float s = 0.f;
#pragma unroll
        for (int wv = 0; wv < 8; ++wv) s += red[wv * 64 + 16 * mf + fr];
        rs[mf] = rsqrtf(s * (1.f / CC) + EPS); }
    bf16* mixed = (bf16*)(p.ws + WS_ABUF);
#pragma unroll
    for (int nf = 0; nf < 4; ++nf) { const int n0 = 64 * wave + 16 * nf + 4 * fq; const f32x4 go = *(const f32x4*)(p.in[22] + n0);
#pragma unroll
        for (int mf = 0; mf < 4; ++mf) { const f32x4 o = acc[mf][nf] * rs[mf] * go;
            v2u w; w.x = pk2(o[0], o[1]); w.y = pk2(o[2], o[3]);
            *(v2u*)(mixed + (size_t)(t0 + 16 * mf + fr) * D + CC + n0) = w; } }
    __syncthreads();
}


constexpr int P4B_HSTRIDE = 2064, P4B_LOGIT_OFF = 32 * P4B_HSTRIDE;
__device__ __forceinline__ void p4b_tile(const Params& p, int tile, LAS unsigned char* lds, int tid) {
    const int lane = tid & 63, wave = __builtin_amdgcn_readfirstlane(tid >> 6);
    const int t0 = tile * 32, b = t0 / SEQL;
    const float* mod = (const float*)(p.ws + WS_MOD) + b * 6 * D;
    const bf16* obuf = (const bf16*)(p.ws + WS_BBUF);
    LAS unsigned char* ht = lds;
    LAS float* logits = (LAS float*)(lds + P4B_LOGIT_OFF);
    {
        const int nb = 4 * lane;
        f32x4 gp[4], gt[4], gq[4], sc[4], sh[4];
#pragma unroll
        for (int q = 0; q < 4; ++q) { const int n = nb + 256 * q;
            gp[q] = *(const f32x4*)(p.in[5] + n); gt[q] = *(const f32x4*)(mod + 2 * D + n); gq[q] = *(const f32x4*)(p.in[24] + n);
            sc[q] = *(const f32x4*)(mod + 4 * D + n) + 1.0f; sh[q] = *(const f32x4*)(mod + 3 * D + n); }
        for (int rr = 0; rr < 4; ++rr) {
            const int row = 4 * wave + rr; const size_t t = (size_t)(t0 + row);
            f32x4 ov[4], xv[4];
#pragma unroll
            for (int q = 0; q < 4; ++q) { const v2u o2 = *(const v2u*)(obuf + t * D + nb + 256 * q); ov[q] = (f32x4){bflo(o2.x), bfhi(o2.x), bflo(o2.y), bfhi(o2.y)}; }
#pragma unroll
            for (int q = 0; q < 4; ++q) xv[q] = __builtin_nontemporal_load((const f32x4*)(p.in[0] + t * D + nb + 256 * q));
            float ss = 0.f;
#pragma unroll
            for (int q = 0; q < 4; ++q) ss += (ov[q].x * ov[q].x + ov[q].y * ov[q].y) + (ov[q].z * ov[q].z + ov[q].w * ov[q].w);
            const float rstd = rsqrtf(wave_sum(ss) * (1.f / D) + EPS);
            float s2 = 0.f;
#pragma unroll
            for (int q = 0; q < 4; ++q) { xv[q] = xv[q] + gt[q] * (ov[q] * rstd * gp[q]); s2 += (xv[q].x * xv[q].x + xv[q].y * xv[q].y) + (xv[q].z * xv[q].z + xv[q].w * xv[q].w);
                __builtin_nontemporal_store((v2u){pk2(xv[q].x, xv[q].y), pk2(xv[q].z, xv[q].w)}, (v2u*)((bf16*)(p.ws + WS_X1B) + t * D + nb + 256 * q)); }
            const float r2 = rsqrtf(wave_sum(s2) * (1.f / D) + EPS);
            unsigned char* h8 = p.ws + WS_H8 + t * D;
#pragma unroll
            for (int q = 0; q < 4; ++q) { const f32x4 hv = xv[q] * r2 * gq[q] * sc[q] + sh[q];
                int a0 = __builtin_amdgcn_cvt_pk_fp8_f32(hv.x, hv.y, 0, false); a0 = __builtin_amdgcn_cvt_pk_fp8_f32(hv.z, hv.w, a0, true);
                *(unsigned*)(h8 + nb + 256 * q) = (unsigned)a0;
                *(LAS v2u*)(ht + row * P4B_HSTRIDE + (nb + 256 * q) * 2) = (v2u){pk2(hv.x, hv.y), pk2(hv.z, hv.w)}; }
        }
    }
    __syncthreads();
    {
        const int fr = lane & 15, fq = lane >> 4, mf = wave & 1, nf = wave >> 1;
        const bf16* Wr = (const bf16*)(p.ws + WS_W_RT_T);
        f32x4 acc = {0.f, 0.f, 0.f, 0.f};
#pragma unroll 16
        for (int ks = 0; ks < 32; ++ks) {
            const bf16x8 a = *(const LAS bf16x8*)(ht + (16 * mf + fr) * P4B_HSTRIDE + (32 * ks + 8 * fq) * 2);
            const bf16x8 bb = *(const bf16x8*)(Wr + (size_t)(nf * 32 + ks) * 512 + lane * 8);
            acc = __builtin_amdgcn_mfma_f32_16x16x32_bf16(a, bb, acc, 0, 0, 0);
        }
        MFMA_SETTLE1(acc);
#pragma unroll
        for (int r = 0; r < 4; ++r) logits[(16 * mf + 4 * fq + r) * 64 + 16 * nf + fr] = acc[r];
    }
    __syncthreads();
    {
        unsigned* cnt = (unsigned*)(p.ws + WS_CTL) + CW_CNT;
        int* list = (int*)(p.ws + WS_LIST);
        float* gate_w = (float*)(p.ws + WS_GATEW);
        LAS unsigned* lcnt = (LAS unsigned*)(lds + P4B_LOGIT_OFF + 8192);
        LAS int* lsel = (LAS int*)(lds + P4B_LOGIT_OFF + 8192 + 256);
        if (tid < 64) lcnt[tid] = 0u;
        __syncthreads();
        const float brt = p.in[27][lane];
        const float NEG = -3.0e38f;
        {
            float s[4], bsc[4], gs[4], masked[4], mysel[4], ssum[4]; int myidx[4];
            const int g = lane >> 3;
#pragma unroll
            for (int rr = 0; rr < 4; ++rr) { s[rr] = sigmoidf_(logits[(4 * wave + rr) * 64 + lane]); bsc[rr] = s[rr] + brt; myidx[rr] = 0; mysel[rr] = 0.f; ssum[rr] = 0.f; }
            float m1[4], m2[4];
#pragma unroll
            for (int rr = 0; rr < 4; ++rr) m1[rr] = group8_max(bsc[rr]);
#pragma unroll
            for (int rr = 0; rr < 4; ++rr) { const unsigned long long eq = __ballot(bsc[rr] == m1[rr]);
                const int first = __ffsll((long long)(eq & (0xFFull << (8 * g)))) - 1; m2[rr] = (lane == first) ? NEG : bsc[rr]; }
#pragma unroll
            for (int rr = 0; rr < 4; ++rr) m2[rr] = group8_max(m2[rr]);
#pragma unroll
            for (int rr = 0; rr < 4; ++rr) gs[rr] = m1[rr] + m2[rr];
            int rank[4] = {0, 0, 0, 0};
#pragma unroll
            for (int j = 0; j < 8; ++j) {
#pragma unroll
                for (int rr = 0; rr < 4; ++rr) { const float gj = lane_bcast(gs[rr], 8 * j); rank[rr] += (gj > gs[rr] || (gj == gs[rr] && j < g)) ? 1 : 0; } }
#pragma unroll
            for (int rr = 0; rr < 4; ++rr) masked[rr] = (rank[rr] < 4) ? bsc[rr] : NEG;
#pragma unroll
            for (int r = 0; r < 8; ++r) {
                float m[4];
#pragma unroll
                for (int rr = 0; rr < 4; ++rr) m[rr] = wave_max(masked[rr]);
#pragma unroll
                for (int rr = 0; rr < 4; ++rr) {
                    const unsigned long long eb = __ballot(masked[rr] == m[rr]);
                    const int idx = __ffsll((long long)eb) - 1;
                    const float sv = lane_bcast(s[rr], __builtin_amdgcn_readfirstlane(idx));
                    ssum[rr] += sv;
                    if (lane == r) { myidx[rr] = idx; mysel[rr] = sv; }
                    if (lane == idx) masked[rr] = NEG;
                }
            }
            if (lane < 8) {
#pragma unroll
                for (int rr = 0; rr < 4; ++rr) { const int row = 4 * wave + rr, t = t0 + row;
                    const float w = mysel[rr] / (ssum[rr] + 1e-20f) * 2.5f;
                    gate_w[t * 8 + lane] = w;
                    const unsigned lp = __hip_atomic_fetch_add(&lcnt[myidx[rr]], 1u, __ATOMIC_RELAXED, __HIP_MEMORY_SCOPE_WORKGROUP);
                    lsel[row * 8 + lane] = myidx[rr] | ((int)lp << 8); }
            }
        }
        __syncthreads();
        if (tid < 64) { const unsigned c = lcnt[tid]; unsigned base = 0u; if (c) base = atomicAdd(&cnt[tid * CNT_STRIDE], c); lcnt[tid] = base; }
        __syncthreads();
        if (tid < 256) { const int v = lsel[tid], e = v & 255, lp = v >> 8; list[(size_t)e * T + lcnt[e] + lp] = (t0 + (tid >> 3)) * 8 + (tid & 7); }
    }
    __syncthreads();
}


__device__ __forceinline__ int moe_build_units(const Params& p, LAS unsigned char* lds, int tid, int bid, int G, int mode) {
    LAS int* tp = (LAS int*)(lds + pg8::MOE_TP_OFF);
    LAS int* desc = (LAS int*)(lds + pg8::MOE_DESC_OFF);
    LAS int* rows = (LAS int*)(lds + pg8::MOE_ROWS_OFF);
    const unsigned* cnt = (const unsigned*)(p.ws + WS_CTL) + CW_CNT;
    if (tid < 64) {
        const int nt_e = ((int)cnt[tid * CNT_STRIDE] + 255) >> 8; int s = nt_e;
#pragma unroll
        for (int o = 1; o < 64; o <<= 1) { const int v = __shfl_up(s, o); if (tid >= o) s += v; }
        tp[tid] = s - nt_e; if (tid == 63) { tp[64] = s; tp[65] = s + 64; } }
    __syncthreads();
    const int NU = tp[65] * 2;
    const int slot = (G % 8 == 0) ? (bid & 7) * (G >> 3) + (bid >> 3) : bid;
    int nlocal = 0; for (int u = slot; u < NU; u += G) ++nlocal;
    if (nlocal > pg8::MOE_MAX_UNITS) nlocal = pg8::MOE_MAX_UNITS;
    if (tid < nlocal) { const int u = slot + tid * G, ti = u >> 1, pn = u & 1;
        int e = 0;
#pragma unroll
        for (int step = 64; step >= 1; step >>= 1) if (e + step <= 64 && tp[e + step] <= ti) e += step;
        const int tile = ti - tp[e], n = (e < 64) ? (int)cnt[e * CNT_STRIDE] : T, nv = n - tile * 256;
        desc[tid * 8 + 0] = e; desc[tid * 8 + 1] = ti; desc[tid * 8 + 2] = pn; desc[tid * 8 + 3] = nv > 256 ? 256 : nv; desc[tid * 8 + 4] = tile; }
    __syncthreads();
    const int* list = (const int*)(p.ws + WS_LIST);
    for (int q = tid; q < nlocal * 256; q += NTHREADS) { const int s = q >> 8, r = q & 255;
        const int e = desc[s * 8], tile = desc[s * 8 + 4], nv = desc[s * 8 + 3];
        int id = -1;
        if (r < nv) id = (e < 64) ? list[(size_t)e * T + tile * 256 + r] : tile * 256 + r;
        rows[q] = (mode == 0) ? (id < 0 ? 0 : (e < 64 ? (id >> 3) : id)) : id;
        if (mode == 1) ((LAS float*)(lds + pg8::MOE_W_OFF))[q] = (id >= 0 && e < 64) ? ((const float*)(p.ws + WS_GATEW))[id] : 1.0f; }
    __syncthreads();
    return nlocal;
}

struct CombLoads { unsigned q[9][4]; v2u x1[4]; };
__device__ __forceinline__ void moe_combine_load(const Params& p, int t, int lane, CombLoads& L) {
    const unsigned char* yk8 = p.ws + WS_WGU_T;
    const unsigned char* ys8 = p.ws + WS_ABUF;
#pragma unroll
    for (int k = 0; k < 8; ++k)
#pragma unroll
        for (int j = 0; j < 4; ++j) L.q[k][j] = *(const unsigned*)(yk8 + ((size_t)t * 8 + k) * 1024 + 4 * lane + 256 * j);
#pragma unroll
    for (int j = 0; j < 4; ++j) L.q[8][j] = *(const unsigned*)(ys8 + (size_t)t * 1024 + 4 * lane + 256 * j);
    const float* o = p.out + (size_t)t * D + 4 * lane;
#pragma unroll
    for (int j = 0; j < 4; ++j) L.x1[j] = __builtin_nontemporal_load((const v2u*)((const bf16*)(p.ws + WS_X1B) + (size_t)t * D + 4 * lane + 256 * j));
}
__device__ __forceinline__ void moe_combine_rows(const Params& p, int gw0, int NGW, int lane) {
    if (gw0 >= T) return;
    f32x4 g[4];
#pragma unroll
    for (int j = 0; j < 4; ++j) g[j] = *(const f32x4*)(p.in[25] + 4 * lane + 256 * j);
    CombLoads N; moe_combine_load(p, gw0, lane, N);
    for (int t = gw0; t < T; t += NGW) {
        CombLoads L = N;
        if (t + NGW < T) moe_combine_load(p, t + NGW, lane, N);
        f32x4 a[4]; float ss = 0.f;
#pragma unroll
        for (int j = 0; j < 4; ++j) { f32x4 r = {0.f, 0.f, 0.f, 0.f};
#pragma unroll
            for (int k = 0; k < 9; ++k) { const f32x2 lo = __builtin_amdgcn_cvt_pk_f32_fp8((int)L.q[k][j], false), hi = __builtin_amdgcn_cvt_pk_f32_fp8((int)L.q[k][j], true);
                r.x += lo.x; r.y += lo.y; r.z += hi.x; r.w += hi.y; }
            a[j] = r * (1.0f / 16.0f); ss += (a[j].x * a[j].x + a[j].y * a[j].y) + (a[j].z * a[j].z + a[j].w * a[j].w); }
        const float rstd = rsqrtf(wave_sum(ss) * (1.f / D) + EPS);
        const int b = t / SEQL;
        const float* gtf = (const float*)(p.ws + WS_MOD) + b * 6 * D + 5 * D + 4 * lane;
        float* o = p.out + (size_t)t * D + 4 * lane;
#pragma unroll
        for (int j = 0; j < 4; ++j) { const f32x4 gt = *(const f32x4*)(gtf + 256 * j);
            const f32x4 x1 = {bflo(L.x1[j].x), bfhi(L.x1[j].x), bflo(L.x1[j].y), bfhi(L.x1[j].y)};
            __builtin_nontemporal_store(x1 + gt * (a[j] * rstd * g[j]), (f32x4*)(o + 256 * j)); }
    }
}

__global__ void __launch_bounds__(NTHREADS, 2) mega(Params p) {
    extern __shared__ __attribute__((aligned(16))) unsigned char lds_raw[];
    LAS unsigned char* lds = (LAS unsigned char*)lds_raw;
    volatile LAS unsigned* MISC = (volatile LAS unsigned*)(lds + MISC_OFF);
    const int tid = threadIdx.x, lane = tid & 63, wave = __builtin_amdgcn_readfirstlane(tid >> 6);
    const int G = gridDim.x, bid = blockIdx.x;
    if (tid < 32) MISC[tid] = 0u;
    __syncthreads();
    unsigned* ctl = (unsigned*)(p.ws + WS_CTL);
    XcdBarrier bar = xcd_barrier_post(ctl + CW_BAR + p.li * XCD_BAR_WORDS, MISC + 8);
    const int gw = bid * NWAVES + wave, NGW = G * NWAVES;

    if (RUN(0)) {
    if (bid < 192) p0_mod_item(p, bid, (LAS float*)lds, tid);
    else {
        if (bid < 196) p0_ssm_tables_gp(p, (bid - 192) * NTHREADS + tid);
        for (int idx = (bid - 192) * NTHREADS + tid; idx < 65536; idx += (G - 192) * NTHREADS) p0_ssm_tables_ct(p, idx);
    }
    {
        LAS float* scr = (LAS float*)(lds + wave * 16384);
        for (int j = gw; j < NITEMS_T - NITEMS_DEF - NITEMS_DEF2; j += NGW) { int it = NITEMS_DEF + j; if (it >= IT_EG + IT_EU) it += NITEMS_DEF2;
            p0_convert_item(p, it, scr, lane); }
    }
    }
    xcd_barrier(bar);
    if (RUN(1)) p1_rows(p, gw, NGW, lane);
    xcd_barrier(bar);
    if (RUN(2)) {
        pg8::StaticOrder S; S.init(p.ws + WS_ABUF, p.ws + WS_W_IN_T, T, DIN, D, G, bid);
        pg8::EpiVU E{(bf16*)(p.ws + WS_BBUF), (bf16*)(p.ws + WS_SSMU)};
        pg8::gemm_phase<pg8::EpiVU, pg8::StaticOrder, true>(lds, D, S, E);
        if (bid >= 384 - G && G > 128) {
            __syncthreads();
            LAS float* scr = (LAS float*)(lds + wave * 16384);
            const int nb = 2 * G - 384;
            for (int it = (bid - (384 - G)) * NWAVES + wave; it < NITEMS_DEF; it += nb * NWAVES) p0_convert_item(p, it, scr, lane);
        }
    }
    xcd_barrier(bar);
    if (RUN(3)) {
    p3a_items(p, gw, NGW, lane);
    __syncthreads();
    if (!(p.flags & 8)) { ConvStage cs; if (bid < T / 32) conv_stage_load(p, bid, tid, cs);
        for (int tile = bid; tile < T / 32; tile += G) p3_conv_tile(p, tile, lds, tid, cs, tile + G < T / 32 ? tile + G : -1); }
    }
    xcd_barrier(bar);
    if (RUN(4)) for (int blk = bid; blk < 256; blk += G) p3b_block(p, blk, lds, tid);
    xcd_barrier(bar);
    if (RUN(5)) for (int c = bid; c < T / 64; c += G) p3c_chunk(p, c, lds, tid);
    xcd_barrier(bar);
    if (RUN(6)) {
        pg8::StaticOrder S; S.init(p.ws + WS_ABUF, p.ws + WS_W_OUT_T, T, D, D, G, bid);
        pg8::EpiBf16Plain E{(bf16*)(p.ws + WS_BBUF), D};
        pg8::gemm_phase<pg8::EpiBf16Plain, pg8::StaticOrder, true>(lds, D, S, E);
    }
    xcd_barrier(bar);
    if (RUN(7)) for (int tile = bid; tile < T / 32; tile += G) p4b_tile(p, tile, lds, tid);
    xcd_barrier(bar);
    if (RUN(8)) {
        const int nl = moe_build_units(p, lds, tid, bid, G, 0);
        pg8::MoeSched S{(const char*)(p.ws + WS_H8), (const char*)(p.ws + WS_WGU_T), lds, nl, D, 0, 1};
        pg8::EpiAct E{p.ws + WS_ACT, 1.0f / 32.0f};
        pg8::gemm_phase<pg8::EpiAct, pg8::MoeSched, true, true, 1>(lds, D, S, E);
        {
            int t8 = threadIdx.x; asm volatile("" : "+v"(t8));
            const int lane8 = t8 & 63, wave8 = __builtin_amdgcn_readfirstlane(t8 >> 6);
            const unsigned* cnt = (const unsigned*)(p.ws + WS_CTL) + CW_CNT;
            int nu = 64; for (int e = 0; e < 64; ++e) nu += ((int)cnt[e * CNT_STRIDE] + 255) >> 8;
            nu *= 2;
            const int slot = (G % 8 == 0) ? (bid & 7) * (G >> 3) + (bid >> 3) : bid;
            const int maxnl = (nu + G - 1) / G, r = nu - (maxnl - 1) * G, ns = G - r;
            int n1 = ns * NWAVES * 2; if (n1 > NITEMS_DEF2) n1 = NITEMS_DEF2;
            __syncthreads();
            LAS float* scr = (LAS float*)(lds + wave8 * 16384);
            if (slot >= r) for (int it = (slot - r) * NWAVES + wave8; it < n1; it += ns * NWAVES) p0_convert_item(p, IT_EG + IT_EU + it, scr, lane8);
            for (int it = n1 + bid * NWAVES + wave8; it < NITEMS_DEF2; it += G * NWAVES) p0_convert_item(p, IT_EG + IT_EU + it, scr, lane8);
        }
    }
    xcd_barrier(bar);
    if (RUN(9)) {
        const int nl = moe_build_units(p, lds, tid, bid, G, 1);
        pg8::MoeSched S{(const char*)(p.ws + WS_ACT), (const char*)(p.ws + WS_WD_T), lds, 2 * nl, DE, 1, 1};
        pg8::EpiDown E{p.ws + WS_WGU_T, p.ws + WS_ABUF, lds};
        pg8::gemm_phase<pg8::EpiDown, pg8::MoeSched, true, false, 1>(lds, DE, S, E);
    }
    xcd_barrier(bar);
    if (RUN(10)) { int l10 = threadIdx.x; asm volatile("" : "+v"(l10)); l10 &= 63;
        moe_combine_rows(p, gw, NGW, l10); }
}

extern "C" void kernel_launch(void* const* d_in, const int* in_sizes, int n_in, void* d_out, int out_size, void* d_ws, size_t ws_size, hipStream_t stream) {
    static int grid = 0;
    if (grid == 0) {
        int dev = 0, cus = 0;
        if (n_in != 34 || out_size != T * D || ws_size < WS_END) { grid = -1; return; }
        if (hipGetDevice(&dev) != hipSuccess || hipDeviceGetAttribute(&cus, hipDeviceAttributeMultiprocessorCount, dev) != hipSuccess) { grid = -1; return; }
        if (hipFuncSetAttribute((const void*)mega, hipFuncAttributeMaxDynamicSharedMemorySize, LDS_BYTES) != hipSuccess) { grid = -1; return; }
        (void)hipGetLastError();
        grid = cus;
    }
    if (grid < 0) return;
    (void)hipMemsetAsync((char*)d_ws + WS_CTL, 0, CTL_ZERO_BYTES, stream);
    Params p{};
    for (int i = 0; i < 34; ++i) p.in[i] = (const float*)d_in[i];
    p.out = (float*)d_out; p.ws = (unsigned char*)d_ws; p.ph_lo = 0; p.ph_hi = 99;
    hipLaunchKernelGGL(mega, dim3(grid), dim3(NTHREADS), LDS_BYTES, stream, p);
    if (PROBE_K >= 0 && PROBE_K < 60) { Params q = p; q.ph_lo = PROBE_K; q.ph_hi = PROBE_K + 1; q.li = 1; q.flags = PROBE_FLAGS; hipLaunchKernelGGL(mega, dim3(grid), dim3(NTHREADS), LDS_BYTES, stream, q); }

}
```
